# Optimizing an MI355X kernel written in HIP

```python
import jax, jax.numpy as jnp
from jax import lax
import numpy as np

D_MODEL = 1024
BATCH = 8
SEQ = 2048
DEPTH = 4
DEC_BATCH = 128
DEC_SEQ = 1
PAST_LEN = 8192
PAGE_SIZE = 128

N_A_LAYERS = DEPTH // 2
N_B_LAYERS = DEPTH - N_A_LAYERS
HG_HEAD_K = 128
HG_HEADS = D_MODEL // HG_HEAD_K
HG_HEAD_V = D_MODEL // HG_HEADS
HG_KEY_DIM = HG_HEADS * HG_HEAD_K
HG_VAL_DIM = HG_HEADS * HG_HEAD_V
HG_CHUNK = 64
ATT_HEAD_DIM = 64
ATT_Q_HEADS = D_MODEL // ATT_HEAD_DIM
ATT_KV_HEADS = max(1, ATT_Q_HEADS // 8)
ATT_GROUP = ATT_Q_HEADS // ATT_KV_HEADS
ATT_Q_DIM = ATT_Q_HEADS * ATT_HEAD_DIM
WINDOW = 128
ATT_BLOCK = WINDOW
ROPE_THETA = 500000.0
ROT_DIM = ATT_HEAD_DIM // 4
NORM_EPS = 1e-6
MASK_VALUE = -1e30

kernel_name = 'yoco_hgrn2_swa_sink_decode_step'

F32 = jnp.float32


def _rmsnorm(x, g):
    xf = x.astype(F32)
    r = lax.rsqrt(jnp.mean(xf * xf, axis=-1, keepdims=True) + NORM_EPS)
    return (xf * r * g.astype(F32)).astype(x.dtype)


def _rope(x, pos):
    half = ROT_DIM // 2
    inv_freq = 1.0 / (ROPE_THETA ** (jnp.arange(half, dtype=F32) * 2.0 / ROT_DIM))
    ang = pos.astype(F32)[:, None] * inv_freq[None, :]
    cos = jnp.cos(ang)[None, :, None, :]
    sin = jnp.sin(ang)[None, :, None, :]
    xf = x.astype(F32)
    x1, x2, rest = xf[..., :half], xf[..., half:ROT_DIM], xf[..., ROT_DIM:]
    out = jnp.concatenate([x1 * cos - x2 * sin, x2 * cos + x1 * sin, rest], axis=-1)
    return out.astype(x.dtype)


def _chunked_gated_recurrence(q, k, v, log_f, s0):
    B, T, H, _ = q.shape
    dv = v.shape[-1]
    C = min(HG_CHUNK, T)
    pad = (-T) % C
    n = (T + pad) // C

    def blocks(a):
        a = jnp.pad(a, ((0, 0), (0, pad), (0, 0), (0, 0)))
        return a.reshape(B, n, C, H, a.shape[-1]).transpose(1, 0, 3, 2, 4)

    causal = jnp.tril(jnp.ones((C, C), dtype=bool))[:, :, None]

    def step(S, inp):
        qc, kc, vc, lc = inp
        b = jnp.cumsum(lc, axis=2)
        o = jnp.einsum('bhtd,bhde->bhte', qc * jnp.exp(b), S)
        diff = b[:, :, :, None, :] - b[:, :, None, :, :]
        decay = jnp.where(causal, jnp.exp(jnp.where(causal, diff, 0.0)), 0.0)
        a = jnp.einsum('bhtd,bhsd,bhtsd->bhts', qc, kc, decay)
        o = o + jnp.einsum('bhts,bhse->bhte', a, vc)
        b_end = b[:, :, -1:, :]
        S = (jnp.exp(b_end[:, :, 0, :])[..., None] * S
             + jnp.einsum('bhsd,bhse->bhde', kc * jnp.exp(b_end - b), vc))
        return S, o

    s_fin, o = lax.scan(step, s0, (blocks(q), blocks(k), blocks(v), blocks(log_f)))
    o = o.transpose(1, 0, 3, 2, 4).reshape(B, n * C, H, dv)[:, :T]
    return o, s_fin


def _hgrn2_layer(h, s0, norm_g, w_in, lb, gnorm, w_out):
    B, T, _ = h.shape
    u = _rmsnorm(h, norm_g) @ w_in
    q, f, i, g = jnp.split(u, [HG_KEY_DIM, 2 * HG_KEY_DIM, 2 * HG_KEY_DIM + HG_VAL_DIM], axis=-1)
    q = jax.nn.silu(q.astype(F32)).reshape(B, T, HG_HEADS, HG_HEAD_K)
    f = f.astype(F32).reshape(B, T, HG_HEADS, HG_HEAD_K)
    lb = lb.astype(F32).reshape(HG_HEADS, HG_HEAD_K)
    log_f = jax.nn.log_sigmoid(f) + jnp.log1p(lb * jnp.exp(-f))
    k = (1.0 - lb) * jax.nn.sigmoid(-f)
    v = i.astype(F32).reshape(B, T, HG_HEADS, HG_HEAD_V)
    o, s_new = _chunked_gated_recurrence(q, k, v, log_f, s0.astype(F32))
    o = _rmsnorm(o, gnorm).reshape(B, T, HG_VAL_DIM)
    y = (o * jax.nn.silu(g.astype(F32))).astype(h.dtype) @ w_out
    return h + y, s_new.astype(s0.dtype)


def _shared_kv(h, kv_norm, w_kv, pos):
    B, T, _ = h.shape
    u = _rmsnorm(h, kv_norm) @ w_kv
    k, v = jnp.split(u, 2, axis=-1)
    k = _rope(k.reshape(B, T, ATT_KV_HEADS, ATT_HEAD_DIM), pos)
    v = v.reshape(B, T, ATT_KV_HEADS, ATT_HEAD_DIM)
    return k, v


def _sink_attention(q, k, v, mask, sinks):
    scale = ATT_HEAD_DIM ** -0.5
    s = jnp.einsum('bnqkgd,bnskd->bnkgqs', q.astype(F32), k.astype(F32)) * scale
    valid = mask[None, :, None, None]
    s = jnp.where(valid, s, MASK_VALUE)
    sink = sinks.astype(F32)[None, None, :, :, None, None]
    m = jnp.maximum(jnp.max(s, axis=-1, keepdims=True), sink)
    p = jnp.where(valid, jnp.exp(s - m), 0.0)
    denom = jnp.sum(p, axis=-1, keepdims=True) + jnp.exp(sink - m)
    return jnp.einsum('bnkgqs,bnskd->bnqkgd', p / denom, v.astype(F32))


def _swa_layer(h, k, v, pos, past_k, past_v, norm_g, w_in, sinks, w_out):
    B, T, _ = h.shape
    u = _rmsnorm(h, norm_g) @ w_in
    q, gate = jnp.split(u, [ATT_Q_DIM], axis=-1)
    q = _rope(q.reshape(B, T, ATT_Q_HEADS, ATT_HEAD_DIM), pos)
    q = q.reshape(B, T, ATT_KV_HEADS, ATT_GROUP, ATT_HEAD_DIM)
    sinks_g = sinks.reshape(ATT_KV_HEADS, ATT_GROUP)
    if past_k is None:
        nb = T // ATT_BLOCK
        qb = q.reshape(B, nb, ATT_BLOCK, ATT_KV_HEADS, ATT_GROUP, ATT_HEAD_DIM)

        def band(a):
            ab = a.reshape(B, nb, ATT_BLOCK, ATT_KV_HEADS, ATT_HEAD_DIM)
            prev = jnp.concatenate([jnp.zeros_like(ab[:, :1]), ab[:, :-1]], axis=1)
            return jnp.concatenate([prev, ab], axis=2)

        tq = jnp.arange(ATT_BLOCK)[:, None]
        j = jnp.arange(2 * ATT_BLOCK)[None, :]
        rel = tq + ATT_BLOCK - j
        mask = ((rel >= 0) & (rel <= WINDOW))[None]
        mask = mask & ((jnp.arange(nb)[:, None, None] > 0) | (j[None] >= ATT_BLOCK))
        o = _sink_attention(qb, band(k), band(v), mask, sinks_g)
    else:
        w = past_k.shape[1]
        kk = jnp.concatenate([past_k.astype(k.dtype), k], axis=1)[:, None]
        vv = jnp.concatenate([past_v.astype(v.dtype), v], axis=1)[:, None]
        kpos = jnp.concatenate([pos[0] - w + jnp.arange(w, dtype=pos.dtype), pos])
        rel = pos[:, None] - kpos[None, :]
        mask = ((rel >= 0) & (rel <= WINDOW))[None]
        o = _sink_attention(q[:, None], kk, vv, mask, sinks_g)
    o = o.reshape(B, T, ATT_Q_DIM)
    y = (o * jax.nn.silu(gate.astype(F32))).astype(h.dtype) @ w_out
    return h + y


def _trunk(x, pos, s0, past_k, past_v, a_norm, a_w_in, a_lb_logits, a_gnorm, a_w_out,
           kv_norm, w_kv, b_norm, b_w_in, b_sinks, b_w_out, final_norm):
    p = jax.nn.softmax(a_lb_logits.astype(F32), axis=0)
    lbs = jnp.cumsum(p, axis=0) - p[0:1]
    h = x
    new_states = []
    k = v = None
    for layer in range(DEPTH):
        if layer < N_A_LAYERS:
            h, s = _hgrn2_layer(h, s0[layer], a_norm[layer], a_w_in[layer], lbs[layer],
                                a_gnorm[layer], a_w_out[layer])
            new_states.append(s)
        else:
            if layer == N_A_LAYERS:
                k, v = _shared_kv(h, kv_norm, w_kv, pos)
            j = layer - N_A_LAYERS
            h = _swa_layer(h, k, v, pos, past_k, past_v, b_norm[j], b_w_in[j], b_sinks[j], b_w_out[j])
    return _rmsnorm(h, final_norm), jnp.stack(new_states), k, v


def setup_inputs(seed: int = 0) -> dict:
    key = jax.random.key(seed)
    ks = jax.random.split(key, 20)
    D = D_MODEL
    w_rows = min(WINDOW, PAST_LEN)
    a_in = 2 * HG_KEY_DIM + 2 * HG_VAL_DIM
    b_in = 2 * ATT_Q_DIM
    kv_out = 2 * ATT_KV_HEADS * ATT_HEAD_DIM
    nrm = jax.random.normal
    return {
        'x_prompt': nrm(ks[0], (BATCH, SEQ, D), F32),
        'x_sample': nrm(ks[1], (DEC_BATCH, DEC_SEQ, D), F32),
        'state_hgrn': 0.5 * nrm(ks[2], (N_A_LAYERS, DEC_BATCH, HG_HEADS, HG_HEAD_K, HG_HEAD_V), F32),
        'cache_k_win': nrm(ks[3], (DEC_BATCH, w_rows, ATT_KV_HEADS, ATT_HEAD_DIM), F32),
        'cache_v_win': nrm(ks[4], (DEC_BATCH, w_rows, ATT_KV_HEADS, ATT_HEAD_DIM), F32),
        'a_norm': 1.0 + 0.05 * nrm(ks[5], (N_A_LAYERS, D), F32),
        'a_w_in': nrm(ks[6], (N_A_LAYERS, D, a_in), F32) * D ** -0.5,
        'a_lb_logits': nrm(ks[7], (N_A_LAYERS, HG_KEY_DIM), F32),
        'a_gnorm': 1.0 + 0.05 * nrm(ks[8], (N_A_LAYERS, HG_HEAD_V), F32),
        'a_w_out': nrm(ks[9], (N_A_LAYERS, HG_VAL_DIM, D), F32) * HG_VAL_DIM ** -0.5,
        'kv_norm': 1.0 + 0.05 * nrm(ks[10], (D,), F32),
        'w_kv': nrm(ks[11], (D, kv_out), F32) * D ** -0.5,
        'b_norm': 1.0 + 0.05 * nrm(ks[12], (N_B_LAYERS, D), F32),
        'b_w_in': nrm(ks[13], (N_B_LAYERS, D, b_in), F32) * D ** -0.5,
        'b_sinks': nrm(ks[14], (N_B_LAYERS, ATT_Q_HEADS), F32),
        'b_w_out': nrm(ks[15], (N_B_LAYERS, ATT_Q_DIM, D), F32) * ATT_Q_DIM ** -0.5,
        'final_norm': 1.0 + 0.05 * nrm(ks[16], (D,), F32),
    }


def reference(x_prompt, x_sample, state_hgrn, cache_k_win, cache_v_win, a_norm, a_w_in,
              a_lb_logits, a_gnorm, a_w_out, kv_norm, w_kv, b_norm, b_w_in, b_sinks,
              b_w_out, final_norm):
    bp, tp, _ = x_prompt.shape
    ts = x_sample.shape[1]
    s0_prompt = jnp.zeros((N_A_LAYERS, bp, HG_HEADS, HG_HEAD_K, HG_HEAD_V), x_prompt.dtype)
    pos_p = jnp.arange(tp, dtype=jnp.int32)
    pos_s = PAST_LEN + jnp.arange(ts, dtype=jnp.int32)
    y_prompt, st_p, k_p, v_p = _trunk(x_prompt, pos_p, s0_prompt, None, None,
                                      a_norm, a_w_in, a_lb_logits, a_gnorm, a_w_out,
                                      kv_norm, w_kv, b_norm, b_w_in, b_sinks, b_w_out, final_norm)
    y_sample, st_s, k_s, v_s = _trunk(x_sample, pos_s, state_hgrn, cache_k_win, cache_v_win,
                                      a_norm, a_w_in, a_lb_logits, a_gnorm, a_w_out,
                                      kv_norm, w_kv, b_norm, b_w_in, b_sinks, b_w_out, final_norm)
    w_keep = min(WINDOW, tp)
    return (y_prompt, y_sample, st_p, st_s, k_p[:, -w_keep:], v_p[:, -w_keep:], k_s, v_s)
```

```cpp
#include <hip/hip_runtime.h>
#include <cstdio>
#include <cstdint>

#define LAS __attribute__((address_space(3)))
#define GAS __attribute__((address_space(1)))
typedef unsigned short bf16_t;
typedef short bf16x8 __attribute__((ext_vector_type(8)));
typedef short s16x4 __attribute__((ext_vector_type(4)));
typedef float f32x4 __attribute__((ext_vector_type(4)));
typedef float f32x2 __attribute__((ext_vector_type(2)));
typedef unsigned u32x4 __attribute__((ext_vector_type(4)));
typedef unsigned u32x2 __attribute__((ext_vector_type(2)));

constexpr int DM = 1024;
constexpr int TP = 16384;
constexpr int TS = 128;
constexpr int MT = 16640;
constexpr int SEQ = 2048;
constexpr float NORM_EPS = 1e-6f;
constexpr size_t O_YP = 0, O_YS = 16777216, O_STP = 16908288, O_STS = 19005440, O_KWP = 52559872, O_VWP = 52690944, O_KNS = 52822016, O_VNS = 52838400;
constexpr size_t MiB = 1u << 20;
constexpr size_t WS_CTL = 0, CTL_ZERO_BYTES = 65536;
constexpr size_t WS_LB1 = 1 * MiB, WS_ROPE = 1 * MiB + 8192, WS_SSQS = 1 * MiB + 262144;
constexpr size_t WS_WIN0 = 2 * MiB, WS_WIN1 = 10 * MiB, WS_WOUT0 = 18 * MiB, WS_WOUT1 = 20 * MiB, WS_WINB0 = 22 * MiB, WS_WINB1 = 27 * MiB, WS_WOUTB0 = 31 * MiB, WS_WOUTB1 = 33 * MiB;
constexpr size_t WS_SSQ = 35 * MiB, WS_HB = 37 * MiB, WS_H = 70 * MiB, WS_Q = 136 * MiB, WS_K = 169 * MiB, WS_V = 202 * MiB, WS_G = 235 * MiB, WS_LF = 268 * MiB;
constexpr size_t WS_DS = 334 * MiB, WS_LAM = 398 * MiB, WS_KA = 399 * MiB, WS_VA = 404 * MiB, WS_END = 409 * MiB;
constexpr int CW_BAR = 4096;
constexpr size_t WS_DUM0 = 409 * MiB, WS_DUM1 = 442 * MiB;
#ifndef DUP_MASK
#define DUP_MASK 0
#endif
#define NREP(id) (((DUP_MASK >> (id)) & 1) ? 2 : 1)
#define DUMMY(id, rep) (((DUP_MASK >> (id)) & 1) && (rep) == 0)

typedef float f32x2_t __attribute__((ext_vector_type(2))); typedef __bf16 bf16x2_t __attribute__((ext_vector_type(2)));
__device__ __forceinline__ unsigned pk2(float lo, float hi) { f32x2_t v = {lo, hi}; bf16x2_t b = __builtin_convertvector(v, bf16x2_t); return __builtin_bit_cast(unsigned, b); }
__device__ __forceinline__ unsigned f2bf(float f) { return pk2(f, f) & 0xffffu; }
__device__ __forceinline__ float bflo(unsigned w) { return __builtin_bit_cast(float, w << 16); }
__device__ __forceinline__ float bfhi(unsigned w) { return __builtin_bit_cast(float, w & 0xffff0000u); }
__device__ __forceinline__ float bf1(bf16_t b) { return __builtin_bit_cast(float, (unsigned)b << 16); }
__device__ __forceinline__ float fast_rcp(float x) { return __builtin_amdgcn_rcpf(x); }
__device__ __forceinline__ float silu_f(float u) { return u * fast_rcp(1.0f + __expf(-u)); }
__device__ __forceinline__ float wave_sum(float v) {
#pragma unroll
    for (int o = 1; o < 64; o <<= 1) v += __shfl_xor(v, o);
    return v;
}
__device__ __forceinline__ float wave_max(float v) {
#pragma unroll
    for (int o = 1; o < 64; o <<= 1) v = fmaxf(v, __shfl_xor(v, o));
    return v;
}
#define LDS_WAIT() asm volatile("s_waitcnt lgkmcnt(0)" ::: "memory")
#define VM_WAIT() asm volatile("s_waitcnt vmcnt(0)" ::: "memory")
#define MFMA16(a, b, c) __builtin_amdgcn_mfma_f32_16x16x32_bf16((a), (b), (c), 0, 0, 0)

namespace pg8 {
constexpr int BM = 256, BK = 64, HALF = 128, HTB = HALF * BK * 2, STAGE_BYTES = 8 * HTB, NXCD = 8, WGM = 8;
__host__ __device__ __forceinline__ int lds_byte(int r, int c) { const int st = (r >> 4) * 2 + (c >> 5), rr = r & 15, cc = c & 31, ob = rr * 64 + cc * 2; return st * 1024 + (ob ^ (((ob >> 9) & 1) << 5)); }
__host__ __device__ __forceinline__ void stage_rc(int b, int& R, int& C) { const int st = b / 1024, sb = b % 1024, swz = sb ^ (((sb >> 9) & 1) << 5); R = (st >> 1) * 16 + swz / 64; C = (st & 1) * 32 + (swz % 64) / 2; }
__host__ __device__ __forceinline__ int perm32(int rho) { const int n = rho >> 4, i = rho & 15; return 8 * (i >> 2) + 4 * n + (i & 3); }
struct Unit { int pm, pn, hs; };
struct Gemm { const bf16_t* A; const bf16_t* Bt; int M, N, K; };
struct StaticOrder {
    int nM, nN, nwg, G, c;
    __host__ __device__ void init(int M, int N, int G_, int c_) { nM = M / BM; nN = N / BM; nwg = nM * nN; G = G_; c = c_; }
    __host__ __device__ __forceinline__ bool next(int i, Unit& u) const {
        const long L = (long)i * G + c; if (L >= nwg) return false;
        int wgid = (int)L; { const int q = nwg / NXCD, r = nwg % NXCD, xcd = wgid % NXCD, off = wgid / NXCD; wgid = (xcd < r ? xcd * (q + 1) : r * (q + 1) + (xcd - r) * q) + off; }
        const int nig = WGM * nN, gid = wgid / nig, fm = gid * WGM, gsz = (nM - fm) < WGM ? (nM - fm) : WGM;
        u.pm = fm + ((wgid % nig) % gsz); u.pn = (wgid % nig) / gsz; u.hs = 0; return true;
    }
    __device__ __forceinline__ void a_ready(const Unit&) const {}
    __device__ __forceinline__ void done(const Unit&) const {}
};
struct HeadPairOrder {
    int pm, hp, nu, rot;
    __device__ __forceinline__ bool next(int i, Unit& u) const { if (i >= nu) return false; u.pm = pm; u.pn = hp + 4 * ((i + rot) & 3); u.hs = 0; return true; }
    __device__ __forceinline__ void a_ready(const Unit&) const {}
    __device__ __forceinline__ void done(const Unit&) const {}
};
struct PmOrder {
    int pm, q, nN;
    __device__ __forceinline__ bool next(int i, Unit& u) const {
        u.pm = pm; u.hs = 0;
        if (i < 2) { u.pn = q + 4 * i; return true; }
        if (i == 2 && nN == 9 && q < 2) { u.pn = 8; u.hs = q + 1; return true; }
        return false; }
    __device__ __forceinline__ void a_ready(const Unit&) const {}
    __device__ __forceinline__ void done(const Unit&) const {}
};
template <class Epi, class Sched, bool ALIGN_EPI = false, bool SP2 = false, bool HALFN = false>
__device__ __forceinline__ void gemm_phase(LAS unsigned char* lds, const Gemm g, const Sched& S, const Epi& E, const int tid) {
    const int wid = __builtin_amdgcn_readfirstlane(tid >> 6), lane = tid & 63, wr = wid >> 2, wc = wid & 3, fr = lane & 15, fq = lane >> 4;
    const int K = g.K, nt = K / BK;
    unsigned voffA[2], voffB[2];
#pragma unroll
    for (int i = 0; i < 2; ++i) { int R, C; stage_rc(tid * 16 + i * 8192, R, C); const int Rb = Epi::PERM ? ((R & ~31) + perm32(R & 31)) : R;
        voffA[i] = (unsigned)(R * K + C) * 2u; voffB[i] = (unsigned)(Rb * K + C) * 2u; }
    const size_t kstep = (size_t)(BK * 2);
    const size_t hstep = (size_t)HALF * K * 2;
    const size_t tstep = 2 * hstep;
    const unsigned ldsw = (unsigned)wid * 1024u;
    const int aoff = lds_byte(wr * 64 + fr, fq * 8), boff = lds_byte(wc * 32 + fr, fq * 8);
#define PG8_SA(b, h) (((b) * 2 + (h)) * HTB)
#define PG8_SB(b, h) ((4 + (b) * 2 + (h)) * HTB)
#define PG8_STAGE(bufoff, gbase, voff) do { _Pragma("unroll") for (int _i = 0; _i < 2; ++_i) \
        __builtin_amdgcn_global_load_lds((const unsigned*)((const char*)(gbase) + (voff)[_i]), (LAS unsigned*)(lds + (bufoff) + ldsw + _i * 8192), 16, 0, 0); } while (0)
#define PG8_LDA(dst, b, h) do { _Pragma("unroll") for (int m = 0; m < 4; ++m) _Pragma("unroll") for (int k = 0; k < 2; ++k) dst[m][k] = *(const LAS bf16x8*)(lds + PG8_SA(b, h) + aoff + m * 2048 + k * 1024); } while (0)
#define PG8_LDB(dst, b, h) do { _Pragma("unroll") for (int n = 0; n < 2; ++n) _Pragma("unroll") for (int k = 0; k < 2; ++k) dst[n][k] = *(const LAS bf16x8*)(lds + PG8_SB(b, h) + boff + n * 2048 + k * 1024); } while (0)
#define PG8_MMA(ai, bj, At, Bt) do { __builtin_amdgcn_s_setprio(1); _Pragma("unroll") for (int m = 0; m < 4; ++m) _Pragma("unroll") for (int n = 0; n < 2; ++n) _Pragma("unroll") for (int k = 0; k < 2; ++k) \
        acc[ai][bj][m][n] = __builtin_amdgcn_mfma_f32_16x16x32_bf16(Bt[n][k], At[m][k], acc[ai][bj][m][n], 0, 0, 0); __builtin_amdgcn_s_setprio(0); } while (0)
#define PG8_MMA2(ai) do { if constexpr (HALFN) { if (cur.hs != 2) PG8_MMA(ai, 0, At, B0); if (cur.hs != 1) PG8_MMA(ai, 1, At, B1); } else { PG8_MMA(ai, 0, At, B0); PG8_MMA(ai, 1, At, B1); } } while (0)
#define PG8_WAIT_V(n) asm volatile("s_waitcnt vmcnt(" #n ")" ::: "memory")
#define PG8_WAIT_L(n) asm volatile("s_waitcnt lgkmcnt(" #n ")" ::: "memory")
#define PG8_BAR __builtin_amdgcn_s_barrier()
#define PG8_SCHED __builtin_amdgcn_sched_barrier(0)
    Unit cur, nxt; int ui = 0;
    if (!S.next(0, cur)) return;
    f32x4 acc[2][2][4][2];
#pragma unroll
    for (int a = 0; a < 2; ++a)
#pragma unroll
        for (int b = 0; b < 2; ++b)
#pragma unroll
            for (int m = 0; m < 4; ++m)
#pragma unroll
                for (int n = 0; n < 2; ++n) acc[a][b][m][n] = (f32x4){0.f, 0.f, 0.f, 0.f};
    bf16x8 At[4][2], B0[2][2], B1[2][2];
    const char* cA = (const char*)g.A + (size_t)cur.pm * tstep; const char* cB = (const char*)g.Bt + (size_t)cur.pn * tstep;
    S.a_ready(cur);
    if constexpr (SP2) {
        PG8_STAGE(PG8_SB(0, 0), cB, voffB); PG8_STAGE(PG8_SB(0, 1), cB + hstep, voffB); PG8_STAGE(PG8_SA(0, 0), cA, voffA); PG8_STAGE(PG8_SA(0, 1), cA + hstep, voffA);
        if (wr == 1) PG8_BAR;
        PG8_WAIT_V(2); PG8_BAR;
        PG8_STAGE(PG8_SB(1, 0), cB + kstep, voffB); PG8_STAGE(PG8_SA(1, 0), cA + kstep, voffA); PG8_STAGE(PG8_SB(1, 1), cB + hstep + kstep, voffB);
        PG8_WAIT_V(6); PG8_BAR;
    } else {
        PG8_STAGE(PG8_SB(0, 0), cB, voffB); PG8_STAGE(PG8_SA(0, 0), cA, voffA); PG8_STAGE(PG8_SB(0, 1), cB + hstep, voffB); PG8_STAGE(PG8_SA(0, 1), cA + hstep, voffA);
        if (wr == 1) PG8_BAR;
        PG8_WAIT_V(4); PG8_BAR;
        PG8_STAGE(PG8_SB(1, 0), cB + kstep, voffB); PG8_STAGE(PG8_SA(1, 0), cA + kstep, voffA); PG8_STAGE(PG8_SB(1, 1), cB + hstep + kstep, voffB);
        PG8_WAIT_V(6); PG8_BAR;
    }
    for (;;) {
        const bool has_next = S.next(ui + 1, nxt);
        const char* nA = has_next ? (const char*)g.A + (size_t)nxt.pm * tstep : cA; const char* nB = has_next ? (const char*)g.Bt + (size_t)nxt.pn * tstep : cB;
        for (int t = 0; t < nt; t += 2) {
            const bool last = (t == nt - 2);
            const char* a1 = cA + (size_t)(t + 1) * kstep;
            const char* a2 = last ? nA : cA + (size_t)(t + 2) * kstep; const char* b2 = last ? nB : cB + (size_t)(t + 2) * kstep;
            const char* a3 = a2 + kstep; const char* b3 = b2 + kstep;
            if (last && has_next) S.a_ready(nxt);
            if constexpr (SP2) {
            PG8_LDB(B0, 0, 0); PG8_LDB(B1, 0, 1); PG8_SCHED; PG8_LDA(At, 0, 0); PG8_STAGE(PG8_SA(1, 1), a1 + hstep, voffA);
            PG8_WAIT_V(8); PG8_WAIT_L(0); PG8_BAR; PG8_MMA2(0); PG8_BAR; PG8_SCHED;
            PG8_LDA(At, 0, 1); PG8_STAGE(PG8_SB(0, 0), b2, voffB); PG8_STAGE(PG8_SB(0, 1), b2 + hstep, voffB); PG8_STAGE(PG8_SA(0, 0), a2, voffA);
            PG8_WAIT_V(8); PG8_WAIT_L(0); PG8_BAR; PG8_MMA2(1); PG8_BAR; PG8_SCHED;
            PG8_LDB(B0, 1, 0); PG8_LDB(B1, 1, 1); PG8_SCHED; PG8_LDA(At, 1, 0); PG8_STAGE(PG8_SA(0, 1), a2 + hstep, voffA);
            PG8_WAIT_V(8); PG8_WAIT_L(0); PG8_BAR; PG8_MMA2(0); PG8_BAR; PG8_SCHED;
            PG8_LDA(At, 1, 1); PG8_STAGE(PG8_SB(1, 0), b3, voffB); PG8_STAGE(PG8_SB(1, 1), b3 + hstep, voffB); PG8_STAGE(PG8_SA(1, 0), a3, voffA);
            PG8_WAIT_V(8); PG8_WAIT_L(0); PG8_BAR; PG8_MMA2(1); PG8_BAR; PG8_SCHED;
            } else {
            PG8_LDB(B0, 0, 0); PG8_SCHED; PG8_LDA(At, 0, 0); PG8_STAGE(PG8_SA(1, 1), a1 + hstep, voffA);
            PG8_WAIT_L(8); PG8_BAR; PG8_WAIT_L(0); PG8_MMA(0, 0, At, B0); PG8_BAR; PG8_SCHED;
            PG8_LDB(B1, 0, 1); PG8_STAGE(PG8_SB(0, 0), b2, voffB);
            PG8_BAR; PG8_WAIT_L(0); PG8_MMA(0, 1, At, B1); PG8_BAR;
            PG8_LDA(At, 0, 1); PG8_STAGE(PG8_SA(0, 0), a2, voffA);
            PG8_BAR; PG8_WAIT_L(0); PG8_MMA(1, 0, At, B0); PG8_BAR; PG8_SCHED;
            PG8_STAGE(PG8_SB(0, 1), b2 + hstep, voffB);
            PG8_WAIT_V(6); PG8_BAR; PG8_MMA(1, 1, At, B1); PG8_BAR;
            PG8_LDB(B0, 1, 0); PG8_SCHED; PG8_LDA(At, 1, 0); PG8_STAGE(PG8_SA(0, 1), a2 + hstep, voffA);
            PG8_WAIT_L(8); PG8_BAR; PG8_WAIT_L(0); PG8_MMA(0, 0, At, B0); PG8_BAR; PG8_SCHED;
            PG8_LDB(B1, 1, 1); PG8_STAGE(PG8_SB(1, 0), b3, voffB);
            PG8_BAR; PG8_WAIT_L(0); PG8_MMA(0, 1, At, B1); PG8_BAR;
            PG8_LDA(At, 1, 1); PG8_STAGE(PG8_SA(1, 0), a3, voffA);
            PG8_BAR; PG8_WAIT_L(0); PG8_MMA(1, 0, At, B0); PG8_BAR; PG8_SCHED;
            PG8_STAGE(PG8_SB(1, 1), b3 + hstep, voffB);
            PG8_WAIT_V(6); PG8_BAR; PG8_MMA(1, 1, At, B1); PG8_BAR;
            }
        }
        if constexpr (ALIGN_EPI) { if (wr == 0) PG8_BAR; }
        E(acc, cur, wr, wc, fr, fq);
        if (!has_next) break;
#pragma unroll
        for (int a = 0; a < 2; ++a)
#pragma unroll
            for (int b = 0; b < 2; ++b)
#pragma unroll
                for (int m = 0; m < 4; ++m)
#pragma unroll
                    for (int n = 0; n < 2; ++n) acc[a][b][m][n] = (f32x4){0.f, 0.f, 0.f, 0.f};
        cur = nxt; cA = nA; cB = nB; ++ui;
        if constexpr (ALIGN_EPI) { if (wr == 1) PG8_BAR; }
    }
    PG8_WAIT_V(0);
    if constexpr (!ALIGN_EPI) { if (wr == 0) PG8_BAR; }
    PG8_BAR;
#undef PG8_SA
#undef PG8_SB
#undef PG8_STAGE
#undef PG8_LDA
#undef PG8_LDB
#undef PG8_MMA
#undef PG8_MMA2
#undef PG8_WAIT_V
#undef PG8_WAIT_L
#undef PG8_BAR
#undef PG8_SCHED
}
}
#ifndef PG8_SP2
#define PG8_SP2 true
#endif
#ifndef PG8_ALIGN
#define PG8_ALIGN true
#endif

__device__ __forceinline__ float row_rstd(const float* ssq, int row) {
    const f32x4* p = (const f32x4*)(ssq + (size_t)row * 16);
    const f32x4 a = p[0], b = p[1], c = p[2], d = p[3];
    const float s = ((a.x + a.y) + (a.z + a.w)) + ((b.x + b.y) + (b.z + b.w)) + ((c.x + c.y) + (c.z + c.w)) + ((d.x + d.y) + (d.z + d.w));
    return rsqrtf(s * (1.0f / DM) + NORM_EPS);
}
__device__ __forceinline__ float row_rstd_s(const float* ssqs, int n) {
    const f32x4* p = (const f32x4*)(ssqs + (size_t)n * 64); float s = 0.f;
#pragma unroll
    for (int i = 0; i < 16; ++i) { const f32x4 a = p[i]; s += (a.x + a.y) + (a.z + a.w); }
    return rsqrtf(s * (1.0f / DM) + NORM_EPS);
}
struct SsqQ { f32x4 s[4]; };
__device__ __forceinline__ SsqQ ssqs_quarter(const float* ssqs, int n, int fq) { SsqQ r; const f32x4* p = (const f32x4*)(ssqs + (size_t)n * 64 + 16 * fq);
#pragma unroll
    for (int i = 0; i < 4; ++i) r.s[i] = p[i];
    return r; }
__device__ __forceinline__ float ssqs_rstd(const SsqQ& r) {
    float s = 0.f;
#pragma unroll
    for (int i = 0; i < 4; ++i) s += (r.s[i].x + r.s[i].y) + (r.s[i].z + r.s[i].w);
    s += __shfl_xor(s, 16); s += __shfl_xor(s, 32);
    return rsqrtf(s * (1.0f / DM) + NORM_EPS);
}
__device__ __forceinline__ u32x4 pack8(const float (&v)[8]) { u32x4 w; w.x = pk2(v[0], v[1]); w.y = pk2(v[2], v[3]); w.z = pk2(v[4], v[5]); w.w = pk2(v[6], v[7]); return w; }

struct EpiHgrnIn {
    static constexpr bool PERM = true;
    unsigned char* ws; int layer; const LAS float* rstd_lds;
#define EHI_PTRS const float* ssq = (const float*)(ws + WS_SSQ); bf16_t* Q = (bf16_t*)(ws + WS_Q); bf16_t* Kb = (bf16_t*)(ws + WS_K); bf16_t* LF = (bf16_t*)(ws + WS_LF); bf16_t* V = (bf16_t*)(ws + WS_V); bf16_t* G = (bf16_t*)(ws + WS_G); \
    const float* lb = layer == 0 ? (const float*)nullptr : (const float*)(ws + WS_LB1); const float* ssqs = (const float*)(ws + WS_SSQS); (void)ssq; (void)Q; (void)Kb; (void)LF; (void)V; (void)G; (void)lb; (void)ssqs
    struct Pre { SsqQ q; f32x4 l4; };
    __device__ __forceinline__ Pre sample_pre(int row, int col, int fq) const {
        EHI_PTRS; Pre p; p.q = ssqs_quarter(ssqs, row - TP, fq); p.l4 = (f32x4){0.f, 0.f, 0.f, 0.f};
        if ((col >> 10) == 1 && lb) p.l4 = *(const f32x4*)(lb + (col & 1023));
        return p; }
    __device__ __forceinline__ void sample(const f32x4 a, int row, int col, int u, int fq, const Pre& pre) const {
        EHI_PTRS;
        const float rs = ssqs_rstd(pre.q); const int sec = col >> 10, ch = col & 1023; const size_t idx = (size_t)row * DM + ch;
        float v[4] = {a[0] * rs, a[1] * rs, a[2] * rs, a[3] * rs};
        if (sec == 0) {
#pragma unroll
            for (int j = 0; j < 4; ++j) v[j] = silu_f(v[j]);
            u32x2 w; w.x = pk2(v[0], v[1]); w.y = pk2(v[2], v[3]); *(u32x2*)(Q + idx) = w;
        } else if (sec == 1) {
            const f32x4 l4 = pre.l4;
            float lf[4];
#pragma unroll
            for (int j = 0; j < 4; ++j) { const float e = __expf(-v[j]); const float s = fast_rcp(1.0f + e); lf[j] = __logf(l4[j] + (1.0f - l4[j]) * s); }
            { u32x2 wl; wl.x = pk2(lf[0], lf[1]); wl.y = pk2(lf[2], lf[3]); *(u32x2*)(LF + idx) = wl; }
        } else if (sec == 2) {
            u32x2 w; w.x = pk2(v[0], v[1]); w.y = pk2(v[2], v[3]); *(u32x2*)(V + idx) = w;
        } else {
#pragma unroll
            for (int j = 0; j < 4; ++j) v[j] = silu_f(v[j]);
            u32x2 w; w.x = pk2(v[0], v[1]); w.y = pk2(v[2], v[3]); *(u32x2*)(G + idx) = w;
        }
    }
    __device__ __forceinline__ void operator()(const f32x4 (&acc)[2][2][4][2], const pg8::Unit& u, int wr, int wc, int fr_, int fq_) const {
        int fr = fr_, fq = fq_; asm volatile("" : "+v"(fr), "+v"(fq));
        EHI_PTRS;
        const int sec = u.pn >> 2;
        const int colb = (u.pn & 3) * 256 + wc * 32 + 8 * fq;
        float lbu[2][8];
#pragma unroll
        for (int bj = 0; bj < 2; ++bj) {
            if (sec == 1 && lb) { const f32x4 l0 = *(const f32x4*)(lb + colb + bj * 128), l1 = *(const f32x4*)(lb + colb + bj * 128 + 4); lbu[bj][0] = l0.x; lbu[bj][1] = l0.y; lbu[bj][2] = l0.z; lbu[bj][3] = l0.w; lbu[bj][4] = l1.x; lbu[bj][5] = l1.y; lbu[bj][6] = l1.z; lbu[bj][7] = l1.w; }
            else {
#pragma unroll
                for (int j = 0; j < 8; ++j) lbu[bj][j] = 0.f; }
        }
#pragma unroll
        for (int ai = 0; ai < 2; ++ai)
#pragma unroll
            for (int m = 0; m < 4; ++m) {
                const int row = u.pm * 256 + ai * 128 + wr * 64 + m * 16 + fr;
                const float rs = rstd_lds[ai * 128 + wr * 64 + m * 16 + fr];
#pragma unroll
                for (int bj = 0; bj < 2; ++bj) {
                    const int col = colb + bj * 128; const size_t idx = (size_t)row * DM + col;
                    float v[8];
#pragma unroll
                    for (int j = 0; j < 4; ++j) { v[j] = acc[ai][bj][m][0][j] * rs; v[4 + j] = acc[ai][bj][m][1][j] * rs; }
                    if (sec == 0) {
#pragma unroll
                        for (int j = 0; j < 8; ++j) v[j] = silu_f(v[j]);
                        *(u32x4*)(Q + idx) = pack8(v);
                    } else if (sec == 1) {
                        float lbv[8];
#pragma unroll
                        for (int j = 0; j < 8; ++j) lbv[j] = lbu[bj][j];
                        float lf[8];
#pragma unroll
                        for (int j = 0; j < 8; ++j) { const float e = __expf(-v[j]); const float s = fast_rcp(1.0f + e); lf[j] = __logf(lbv[j] + (1.0f - lbv[j]) * s); }
                        *(u32x4*)(LF + idx) = pack8(lf);
                    } else if (sec == 2) {
                        *(u32x4*)(V + idx) = pack8(v);
                    } else {
#pragma unroll
                        for (int j = 0; j < 8; ++j) v[j] = silu_f(v[j]);
                        *(u32x4*)(G + idx) = pack8(v);
                    }
                }
            }
    }
};

struct EpiResid {
    static constexpr bool PERM = true;
    unsigned char* ws;
#define ERS_PTRS const bf16_t* Hold = (const bf16_t*)(ws + WS_HB); bf16_t* HB = (bf16_t*)(ws + WS_HB); float* ssq = (float*)(ws + WS_SSQ); float* ssqs = (float*)(ws + WS_SSQS); (void)ssq; (void)ssqs
    struct Pre { u32x2 hw; };
    __device__ __forceinline__ Pre sample_pre(int row, int col, int fq) const { ERS_PTRS; Pre p; p.hw = *(const u32x2*)(Hold + (size_t)row * DM + col); return p; }
    __device__ __forceinline__ void sample(const f32x4 a, int row, int col, int u, int fq, const Pre& pre) const {
        ERS_PTRS;
        const size_t idx = (size_t)row * DM + col;
        const u32x2 hw = pre.hw;
        f32x4 o = {bflo(hw.x), bfhi(hw.x), bflo(hw.y), bfhi(hw.y)}; o += a;
        u32x2 w; w.x = pk2(o.x, o.y); w.y = pk2(o.z, o.w); *(u32x2*)(HB + idx) = w;
        float part = (o.x * o.x + o.y * o.y) + (o.z * o.z + o.w * o.w);
        part += __shfl_xor(part, 16); part += __shfl_xor(part, 32);
        if (fq == 0) ssqs[(size_t)(row - TP) * 64 + u] = part;
    }
    __device__ __forceinline__ void operator()(const f32x4 (&acc)[2][2][4][2], const pg8::Unit& u, int wr, int wc, int fr_, int fq_) const {
        int fr = fr_, fq = fq_; asm volatile("" : "+v"(fr), "+v"(fq));
        ERS_PTRS;
        const int col0 = u.pn * 256 + wc * 32 + 8 * fq;
#pragma unroll
        for (int ai = 0; ai < 2; ++ai) {
        u32x4 hpre[4][2];
#pragma unroll
            for (int m = 0; m < 4; ++m)
#pragma unroll
                for (int bj = 0; bj < 2; ++bj) hpre[m][bj] = *(const u32x4*)(Hold + (size_t)(u.pm * 256 + ai * 128 + wr * 64 + m * 16 + fr) * DM + col0 + bj * 128);
        __builtin_amdgcn_sched_barrier(0);
#pragma unroll
            for (int m = 0; m < 4; ++m) {
                const int row = u.pm * 256 + ai * 128 + wr * 64 + m * 16 + fr;
                float part = 0.f;
#pragma unroll
                for (int bj = 0; bj < 2; ++bj) {
                    const int col = col0 + bj * 128; const size_t idx = (size_t)row * DM + col;
                    const u32x4 hw = hpre[m][bj];
                    f32x4 o0 = {bflo(hw.x), bfhi(hw.x), bflo(hw.y), bfhi(hw.y)}, o1 = {bflo(hw.z), bfhi(hw.z), bflo(hw.w), bfhi(hw.w)};
                    o0 += acc[ai][bj][m][0]; o1 += acc[ai][bj][m][1];
                    u32x4 w; w.x = pk2(o0.x, o0.y); w.y = pk2(o0.z, o0.w); w.z = pk2(o1.x, o1.y); w.w = pk2(o1.z, o1.w);
                    *(u32x4*)(HB + idx) = w;
                    part += (o0.x * o0.x + o0.y * o0.y) + (o0.z * o0.z + o0.w * o0.w) + (o1.x * o1.x + o1.y * o1.y) + (o1.z * o1.z + o1.w * o1.w);
                }
                part += __shfl_xor(part, 16); part += __shfl_xor(part, 32);
                if (fq == 0) ssq[(size_t)row * 16 + u.pn * 4 + wc] = part;
            }
        }
    }
};

struct EpiSwaIn {
    static constexpr bool PERM = true;
    unsigned char* ws; float* out; const LAS float* rstd_lds; const LAS float* rope_lds;
#define ESI_PTRS const float* ssq = (const float*)(ws + WS_SSQ); const float* rope = (const float*)(ws + WS_ROPE); bf16_t* QA = (bf16_t*)(ws + WS_Q); bf16_t* GA = (bf16_t*)(ws + WS_G); bf16_t* KA = (bf16_t*)(ws + WS_KA); bf16_t* VA = (bf16_t*)(ws + WS_VA); \
    const float* ssqs = (const float*)(ws + WS_SSQS); (void)ssq; (void)rope; (void)QA; (void)GA; (void)KA; (void)VA; (void)ssqs
    struct Pre { SsqQ q; f32x4 c4, s4; };
    __device__ __forceinline__ Pre sample_pre(int row, int col, int fq) const {
        ESI_PTRS; Pre p; p.q = ssqs_quarter(ssqs, row - TP, fq);
        const float* rp = rope + (size_t)SEQ * 16 + ((4 * fq) & 7); p.c4 = *(const f32x4*)rp; p.s4 = *(const f32x4*)(rp + 8);
        return p; }
    __device__ __forceinline__ void sample(const f32x4 a, int row, int col, int u, int fq, const Pre& pre) const {
        ESI_PTRS;
        const float rs = ssqs_rstd(pre.q);
        float v[4] = {a[0] * rs, a[1] * rs, a[2] * rs, a[3] * rs};
        const int sec = col < 1024 ? 0 : col < 2048 ? 1 : col < 2176 ? 2 : 3;
        if ((sec == 0 || sec == 2) && ((16 * u) & 63) == 0) {
#pragma unroll
            for (int r = 0; r < 4; ++r) { const float pr = __shfl_xor(v[r], 32); const float c = pre.c4[r], s = pre.s4[r];
                v[r] = fq < 2 ? v[r] * c - pr * s : v[r] * c + pr * s; }
        }
        if (sec == 0) {
#pragma unroll
            for (int j = 0; j < 4; ++j) v[j] *= 0.18033688011112042f;
            u32x2 w; w.x = pk2(v[0], v[1]); w.y = pk2(v[2], v[3]); *(u32x2*)(QA + (size_t)row * DM + col) = w;
        } else if (sec == 1) {
#pragma unroll
            for (int j = 0; j < 4; ++j) v[j] = silu_f(v[j]);
            u32x2 w; w.x = pk2(v[0], v[1]); w.y = pk2(v[2], v[3]); *(u32x2*)(GA + (size_t)row * DM + (col - 1024)) = w;
        } else {
            const int kc = sec == 2 ? col - 2048 : col - 2176;
            u32x2 w; w.x = pk2(v[0], v[1]); w.y = pk2(v[2], v[3]); *(u32x2*)((sec == 2 ? KA : VA) + (size_t)row * 128 + kc) = w;
            *(f32x4*)(out + (sec == 2 ? O_KNS : O_VNS) + (size_t)(row - TP) * 128 + kc) = (f32x4){v[0], v[1], v[2], v[3]};
        }
    }
    __device__ __forceinline__ void operator()(const f32x4 (&acc)[2][2][4][2], const pg8::Unit& u, int wr, int wc, int fr_, int fq_) const {
        int fr = fr_, fq = fq_; asm volatile("" : "+v"(fr), "+v"(fq));
        ESI_PTRS;
        const int sec = u.pn >> 2;
        const int colb = (u.pn & 3) * 256 + wc * 32 + 8 * fq;
        const bool rot_wave = (wc & 1) == 0;
#pragma unroll
        for (int ai = 0; ai < 2; ++ai)
#pragma unroll
            for (int m = 0; m < 4; ++m) {
                const int row = u.pm * 256 + ai * 128 + wr * 64 + m * 16 + fr;
                const int rl = ai * 128 + wr * 64 + m * 16 + fr;
                const float rs = rstd_lds[rl];
                float cs[8], sn[8];
                if (sec != 1 && rot_wave) {
                    const LAS f32x4* rp = (const LAS f32x4*)(rope_lds + rl * 16);
                    const f32x4 c0 = rp[0], c1 = rp[1], s0 = rp[2], s1 = rp[3];
                    cs[0] = c0.x; cs[1] = c0.y; cs[2] = c0.z; cs[3] = c0.w; cs[4] = c1.x; cs[5] = c1.y; cs[6] = c1.z; cs[7] = c1.w;
                    sn[0] = s0.x; sn[1] = s0.y; sn[2] = s0.z; sn[3] = s0.w; sn[4] = s1.x; sn[5] = s1.y; sn[6] = s1.z; sn[7] = s1.w;
                }
#pragma unroll
                for (int bj = 0; bj < 2; ++bj) {
                    if (u.hs != 0 && bj != u.hs - 1) continue;
                    float v[8];
#pragma unroll
                    for (int j = 0; j < 4; ++j) { v[j] = acc[ai][bj][m][0][j] * rs; v[4 + j] = acc[ai][bj][m][1][j] * rs; }
                    if (sec == 0) {
                        const int col = colb + bj * 128; const size_t idx = (size_t)row * DM + col;
                        if (rot_wave) {
                            float pr[8];
#pragma unroll
                            for (int j = 0; j < 8; ++j) pr[j] = __shfl_xor(v[j], 16);
                            if (fq < 2) { const float sg = fq == 0 ? -1.0f : 1.0f;
#pragma unroll
                                for (int j = 0; j < 8; ++j) v[j] = v[j] * cs[j] + sg * pr[j] * sn[j]; }
                        }
#pragma unroll
                        for (int j = 0; j < 8; ++j) v[j] *= 0.18033688011112042f;
                        *(u32x4*)(QA + idx) = pack8(v);
                    } else if (sec == 1) {
                        const int col = colb + bj * 128; const size_t idx = (size_t)row * DM + col;
#pragma unroll
                        for (int j = 0; j < 8; ++j) v[j] = silu_f(v[j]);
                        *(u32x4*)(GA + idx) = pack8(v);
                    } else {
                        const int kc = wc * 32 + 8 * fq;
                        const size_t idx = (size_t)row * 128 + kc;
                        if (bj == 0 && rot_wave) {
                            float pr[8];
#pragma unroll
                            for (int j = 0; j < 8; ++j) pr[j] = __shfl_xor(v[j], 16);
                            if (fq < 2) { const float sg = fq == 0 ? -1.0f : 1.0f;
#pragma unroll
                                for (int j = 0; j < 8; ++j) v[j] = v[j] * cs[j] + sg * pr[j] * sn[j]; }
                        }
                        *(u32x4*)((bj == 0 ? KA : VA) + idx) = pack8(v);
                        float* dst = nullptr;
                        if (row < TP) { const int t = row & (SEQ - 1); if (t >= SEQ - 128) dst = out + (bj == 0 ? O_KWP : O_VWP) + ((size_t)((row >> 11) * 128 + (t - (SEQ - 128))) * 128 + kc); }
                        else if (row < TP + TS) dst = out + (bj == 0 ? O_KNS : O_VNS) + ((size_t)(row - TP) * 128 + kc);
                        if (dst) { *(f32x4*)dst = (f32x4){v[0], v[1], v[2], v[3]}; *(f32x4*)(dst + 4) = (f32x4){v[4], v[5], v[6], v[7]}; }
                    }
                }
            }
    }
};

#define LDS_BARRIER() asm volatile("s_waitcnt lgkmcnt(0)\n\ts_barrier" ::: "memory")
template <int ROWS, int COLS, class Epi>
__device__ __forceinline__ void sgemm_unit(LAS unsigned char* lds, const bf16_t* HBs, const bf16_t* Bt, int u, const Epi& E, int wave, int lane, const int tid) {
    constexpr int KC = 256, NCH = 1024 / KC;
    constexpr int XP = KC * 2 + 16, XBUF = (ROWS + COLS) * XP;
    constexpr int NLX = ROWS / 16, NLW = (COLS * 32 + 511) / 512;
    constexpr int NRG = 128 / ROWS;
    const int cgu = u / NRG, row0 = ROWS * (u % NRG), col0 = COLS * cgu;
    const int fr = lane & 15, fq = lane >> 4;
    const int rt = COLS == 16 ? wave : (wave & 3), ct = COLS == 16 ? 0 : (wave >> 2);
    const int lr = tid >> 5, lc = tid & 31;
    const bool wl = COLS * 32 >= 512 || tid < COLS * 32;
    const bf16_t* xa = HBs + (size_t)(row0 + lr) * DM + lc * 8;
    const bf16_t* wa = Bt + (size_t)(col0 + (lr & (COLS - 1))) * DM + lc * 8;
    u32x4 xr[NCH][NLX], wv[NCH][NLW];
#pragma unroll
    for (int c = 0; c < NCH; ++c) {
#pragma unroll
        for (int i = 0; i < NLX; ++i) xr[c][i] = *(const u32x4*)(xa + (size_t)16 * i * DM + KC * c);
#pragma unroll
        for (int i = 0; i < NLW; ++i) { if (wl) wv[c][i] = *(const u32x4*)(wa + (size_t)16 * i * DM + KC * c); }
    }
    const int srow = TP + row0 + 16 * rt + fr, scol = col0 + 16 * ct + 4 * fq;
    typename Epi::Pre pre;
    if (16 * rt < ROWS) pre = E.sample_pre(srow, scol, fq);
    f32x4 acc = {0.f, 0.f, 0.f, 0.f};
#pragma unroll
    for (int c = 0; c < NCH; ++c) {
        LAS unsigned char* buf = lds + (c & 1) * XBUF;
#pragma unroll
        for (int i = 0; i < NLX; ++i) *(LAS u32x4*)(buf + (lr + 16 * i) * XP + lc * 16) = xr[c][i];
#pragma unroll
        for (int i = 0; i < NLW; ++i) { if (wl) *(LAS u32x4*)(buf + (ROWS + lr + 16 * i) * XP + lc * 16) = wv[c][i]; }
        LDS_BARRIER();
        if (16 * rt < ROWS) {
#pragma unroll
            for (int ks = 0; ks < KC / 32; ++ks) {
                const bf16x8 x = *(const LAS bf16x8*)(buf + (16 * rt + fr) * XP + (32 * ks + 8 * fq) * 2);
                const bf16x8 w = *(const LAS bf16x8*)(buf + (ROWS + 16 * ct + fr) * XP + (32 * ks + 8 * fq) * 2);
                acc = MFMA16(w, x, acc); }
        }
    }
    LDS_BARRIER();
    if (16 * rt < ROWS) E.sample(acc, srow, scol, (col0 >> 4) + ct, fq, pre);
}

#define XB_TMO      128
#define XB_XCNT(j)  (256  + 64 * (j))
#define XB_XSUB(j)  (1280 + 64 * (j))
#define XB_XGEN(j)  (2304 + 64 * (j))
#define XB_TOP      3328
#define XB_TOPGEN   3392
#define XCD_BAR_WORDS 3456
#define XB_SPIN_CAP (1u << 18)
__device__ __forceinline__ unsigned xb_ld(unsigned* p)              { return __hip_atomic_load(p, __ATOMIC_RELAXED, __HIP_MEMORY_SCOPE_AGENT); }
__device__ __forceinline__ unsigned xb_add(unsigned* p, unsigned v) { return __hip_atomic_fetch_add(p, v, __ATOMIC_RELAXED, __HIP_MEMORY_SCOPE_AGENT); }
__device__ __forceinline__ unsigned xb_xcc_id() { return (unsigned)__builtin_amdgcn_s_getreg((3 << 11) | 20) & 0xFu; }
#define XB_SPIN(cond, bar) do { unsigned _sp = 0; while (cond) { __builtin_amdgcn_s_sleep(1); \
    if ((++_sp & 255u) == 0u) { if (xb_ld(&(bar)[XB_TMO])) break; if (_sp > XB_SPIN_CAP) { atomicAdd(&(bar)[XB_TMO], 1u); break; } } } } while (0)
struct XcdBarrier { unsigned* bar; unsigned x; volatile LAS unsigned* st; };
__device__ __forceinline__ XcdBarrier xcd_barrier_post(unsigned* bar, volatile LAS unsigned* st) {
    XcdBarrier b; b.bar = bar; b.x = xb_xcc_id(); b.st = st;
    if (threadIdx.x == 0) (void)xb_add(&bar[XB_XCNT(b.x)], 1u);
    return b;
}
__device__ __forceinline__ void xcd_barrier_complete(unsigned* bar, unsigned x, unsigned& nloc, unsigned& nx) {
    const unsigned G = gridDim.x * gridDim.y * gridDim.z;
    unsigned sum, cnt, mine, sp = 0u;
    for (;;) {
        sum = 0u; cnt = 0u; mine = 0u;
#pragma unroll
        for (unsigned j = 0; j < 16; ++j) { const unsigned c = xb_ld(&bar[XB_XCNT(j)]); sum += c; cnt += (c > 0u) ? 1u : 0u; mine = (j == x) ? c : mine; }
        if (sum == G) break;
        __builtin_amdgcn_s_sleep(1);
        if ((++sp & 255u) == 0u) { if (xb_ld(&bar[XB_TMO])) break; if (sp > XB_SPIN_CAP) { atomicAdd(&bar[XB_TMO], 1u); break; } }
    }
    nloc = mine > 0u ? mine : 1u; nx = cnt > 0u ? cnt : 1u;
}
__device__ __forceinline__ void xcd_barrier(const XcdBarrier& b) {
    asm volatile("s_waitcnt vmcnt(0)" ::: "memory");
    __syncthreads();
    if (threadIdx.x == 0) {
        unsigned* bar = b.bar;
        __builtin_amdgcn_s_waitcnt(0);
        unsigned nloc = b.st[0], nx = b.st[1];
        if (nloc == 0u) { xcd_barrier_complete(bar, b.x, nloc, nx); b.st[0] = nloc; b.st[1] = nx; }
        const unsigned old = xb_add(&bar[XB_XSUB(b.x)], 1u);
        const unsigned gen = old / nloc;
        if (old + 1u == (gen + 1u) * nloc) {
            __builtin_amdgcn_fence(__ATOMIC_RELEASE, "agent");
            asm volatile("s_waitcnt vmcnt(0)" ::: "memory");
            const unsigned og = xb_add(&bar[XB_TOP], 1u);
            const unsigned tg = og / nx;
            if (og + 1u == (tg + 1u) * nx) xb_add(&bar[XB_TOPGEN], 1u);
            else XB_SPIN(xb_ld(&bar[XB_TOPGEN]) == tg, bar);
            __builtin_amdgcn_fence(__ATOMIC_ACQUIRE, "agent");
            xb_add(&bar[XB_XGEN(b.x)], 1u);
            asm volatile("s_waitcnt vmcnt(0)" ::: "memory");
        } else {
            XB_SPIN(xb_ld(&bar[XB_XGEN(b.x)]) == gen, bar);
            __builtin_amdgcn_fence(__ATOMIC_ACQUIRE, "agent");
            asm volatile("s_waitcnt vmcnt(0)" ::: "memory");
        }
    }
    __syncthreads();
}

constexpr int RING_OFF = 0, RING_BYTES = 131072;
constexpr int LDSCTL_OFF = RING_BYTES, MISC_OFF = LDSCTL_OFF + 320;
constexpr int RSTD_OFF = 131584, ROPEL_OFF = 132608;
constexpr int LDS_BYTES = 155648;
constexpr int NWAVES = 8;

struct Args {
    const float* in[17]; float* out; unsigned char* ws; int ph_lo, ph_hi;
};
typedef const Args __attribute__((address_space(4)))* KArgPtr;
__device__ __forceinline__ KArgPtr kargs() { KArgPtr p = (KArgPtr)__builtin_amdgcn_kernarg_segment_ptr(); asm volatile("" : "+s"(p)); return p; }
__device__ __forceinline__ int fresh_tid() { int t = threadIdx.x; asm volatile("" : "+v"(t)); return t; }

__device__ __forceinline__ void stage_row_tables(unsigned char* ws, int pm, LAS unsigned char* lds, bool with_rope, const int tid) {
    if (tid < 256) ((LAS float*)(lds + RSTD_OFF))[tid] = row_rstd((const float*)(ws + WS_SSQ), pm * 256 + tid);
    if (with_rope) {
        const f32x4* rope = (const f32x4*)(ws + WS_ROPE);
#pragma unroll
        for (int i = 0; i < 2; ++i) { const int v = tid + 512 * i, r = v >> 2, part = v & 3; ((LAS f32x4*)(lds + ROPEL_OFF))[v] = rope[(size_t)((pm * 256 + r) & (SEQ - 1)) * 4 + part]; }
    }
    __syncthreads();
}

__device__ __forceinline__ void p0_transpose_item(const float* W, const float* scale, int smask, int K, int N, bf16_t* WT, int row_off, LAS float* scr, int item, int lane) {
    const int nblk = N / 32, kb = item / nblk, nb = item % nblk, k0 = 64 * kb, n0 = 32 * nb;
#pragma unroll 8
    for (int i = 0; i < 32; ++i) { const int kk = 2 * i + (lane >> 5); const float sc = scale ? scale[(k0 + kk) & smask] : 1.0f;
        scr[kk * 33 + (lane & 31)] = __builtin_nontemporal_load(W + (size_t)(k0 + kk) * N + n0 + (lane & 31)) * sc; }
    LDS_WAIT(); asm volatile("" ::: "memory");
    const int c = lane & 7;
#pragma unroll
    for (int j = 0; j < 4; ++j) { const int n = (lane >> 3) + 8 * j; const LAS float* s = scr + (8 * c) * 33 + n;
        u32x4 o; o.x = pk2(s[0 * 33], s[1 * 33]); o.y = pk2(s[2 * 33], s[3 * 33]); o.z = pk2(s[4 * 33], s[5 * 33]); o.w = pk2(s[6 * 33], s[7 * 33]);
        *(u32x4*)(WT + (size_t)(row_off + n0 + n) * K + k0 + 8 * c) = o; }
    LDS_WAIT(); asm volatile("" ::: "memory");
}

__device__ __forceinline__ void p0_prologue(KArgPtr Ap, LAS unsigned char* lds, int wave, int lane) {
    unsigned char* ws = Ap->ws;
    LAS float* scr = (LAS float*)(lds + RING_OFF + wave * 16384);
    const int G = gridDim.x, gw = blockIdx.x * NWAVES + wave, NGW = G * NWAVES;
    constexpr int I_AIN = 16 * 128, I_SQ = 16 * 32, I_BIN = 16 * 64, I_KV = 16 * 8;
    constexpr int NITEMS = 2 * I_AIN + 2 * I_SQ + 2 * I_BIN + I_KV + 2 * I_SQ;
    for (int it = gw; it < NITEMS; it += NGW) {
        int r = it;
        if (r < I_AIN) { p0_transpose_item(Ap->in[6], Ap->in[5], 1023, 1024, 4096, (bf16_t*)(ws + WS_WIN0), 0, scr, r, lane); continue; } r -= I_AIN;
        if (r < I_AIN) { p0_transpose_item(Ap->in[6] + (size_t)1024 * 4096, Ap->in[5] + 1024, 1023, 1024, 4096, (bf16_t*)(ws + WS_WIN1), 0, scr, r, lane); continue; } r -= I_AIN;
        if (r < I_SQ) { p0_transpose_item(Ap->in[9], Ap->in[8], 127, 1024, 1024, (bf16_t*)(ws + WS_WOUT0), 0, scr, r, lane); continue; } r -= I_SQ;
        if (r < I_SQ) { p0_transpose_item(Ap->in[9] + (size_t)1024 * 1024, Ap->in[8] + 128, 127, 1024, 1024, (bf16_t*)(ws + WS_WOUT1), 0, scr, r, lane); continue; } r -= I_SQ;
        if (r < I_BIN) { p0_transpose_item(Ap->in[13], Ap->in[12], 1023, 1024, 2048, (bf16_t*)(ws + WS_WINB0), 0, scr, r, lane); continue; } r -= I_BIN;
        if (r < I_BIN) { p0_transpose_item(Ap->in[13] + (size_t)1024 * 2048, Ap->in[12] + 1024, 1023, 1024, 2048, (bf16_t*)(ws + WS_WINB1), 0, scr, r, lane); continue; } r -= I_BIN;
        if (r < I_KV) { p0_transpose_item(Ap->in[11], Ap->in[10], 1023, 1024, 256, (bf16_t*)(ws + WS_WINB0), 2048, scr, r, lane); continue; } r -= I_KV;
        if (r < I_SQ) { p0_transpose_item(Ap->in[15], nullptr, 0, 1024, 1024, (bf16_t*)(ws + WS_WOUTB0), 0, scr, r, lane); continue; } r -= I_SQ;
        p0_transpose_item(Ap->in[15] + (size_t)1024 * 1024, nullptr, 0, 1024, 1024, (bf16_t*)(ws + WS_WOUTB1), 0, scr, r, lane);
    }
    bf16_t* HB = (bf16_t*)(ws + WS_HB); float* SSQ = (float*)(ws + WS_SSQ);
    float* SSQS = (float*)(ws + WS_SSQS);
    for (int m = gw; m < TP + TS; m += NGW) {
        f32x4 v[4]; float s = 0.f;
        if (m < TP + TS) {
            const f32x4* xr = (const f32x4*)(m < TP ? Ap->in[0] + (size_t)m * DM : Ap->in[1] + (size_t)(m - TP) * DM) + lane;
#pragma unroll
            for (int j = 0; j < 4; ++j) { v[j] = __builtin_nontemporal_load(xr + 64 * j); s += (v[j].x * v[j].x + v[j].y * v[j].y) + (v[j].z * v[j].z + v[j].w * v[j].w); }
        } else {
#pragma unroll
            for (int j = 0; j < 4; ++j) v[j] = (f32x4){0.f, 0.f, 0.f, 0.f};
        }
        s = wave_sum(s);
        u32x2* o8 = (u32x2*)(HB + (size_t)m * DM) + lane;
#pragma unroll
        for (int j = 0; j < 4; ++j) { u32x2 w; w.x = pk2(v[j].x, v[j].y); w.y = pk2(v[j].z, v[j].w); o8[64 * j] = w; }
        if (m < TP) { if (lane < 16) SSQ[(size_t)m * 16 + lane] = lane == 0 ? s : 0.f; }
        else SSQS[(size_t)(m - TP) * 64 + lane] = lane == 0 ? s : 0.f;
    }
    const int gt = blockIdx.x * (NWAVES * 64) + threadIdx.x, NGT = G * NWAVES * 64;
    float* LB1 = (float*)(ws + WS_LB1); float* ROPE = (float*)(ws + WS_ROPE);
    for (int i = gt; i < 1024; i += NGT) { const float l0 = Ap->in[7][i], l1 = Ap->in[7][1024 + i]; LB1[i] = 1.0f / (1.0f + expf(l0 - l1)); }
    for (int i = gt; i < (SEQ + 1) * 8; i += NGT) {
        const int p = i >> 3, j = i & 7; const double pos = p < SEQ ? (double)p : 8192.0;
        const double invf[8] = {1.0, 0.19392274474868576, 0.03760603093086393, 0.007292664737217109, 0.001414213562373095, 0.0002742481756762073, 5.318295896944988e-05, 1.031338537721246e-05};
        double fr_ = invf[0];
#pragma unroll
        for (int q = 1; q < 8; ++q) fr_ = (j == q) ? invf[q] : fr_;
        const double x = pos * fr_;
        const double qd = __builtin_rint(x * 0.6366197723675814);
        const double r = (x - qd * 1.5707963267948966) - qd * 6.123233995736766e-17;
        const double r2 = r * r;
        const double sr = r * (1.0 + r2 * (-1.0 / 6 + r2 * (1.0 / 120 + r2 * (-1.0 / 5040 + r2 * (1.0 / 362880 + r2 * (-1.0 / 39916800 + r2 * (1.0 / 6227020800.0)))))));
        const double cr = 1.0 + r2 * (-0.5 + r2 * (1.0 / 24 + r2 * (-1.0 / 720 + r2 * (1.0 / 40320 + r2 * (-1.0 / 3628800 + r2 * (1.0 / 479001600.0 + r2 * (-1.0 / 87178291200.0)))))));
        const int qi = ((int)((long long)qd)) & 3;
        const double sv = (qi == 0) ? sr : (qi == 1) ? cr : (qi == 2) ? -sr : -cr;
        const double cv = (qi == 0) ? cr : (qi == 1) ? -sr : (qi == 2) ? -cr : sr;
        ROPE[(size_t)p * 16 + j] = (float)cv; ROPE[(size_t)p * 16 + 8 + j] = (float)sv;
    }
}

constexpr int CP = 288, LFI_OFF = 0, QI_OFF = 18432, KI2_OFF = 36864, VI2_OFF = 55296, AM_OFF = 73728, BETA_OFF = 82944, EM_OFF = 83456, LAM1_OFF = 83968;
__device__ __forceinline__ s16x4 tr_read(const LAS unsigned char* p) { return __builtin_bit_cast(s16x4, __builtin_amdgcn_ds_read_tr16_b64_v4i16((LAS s16x4*)p)); }
struct ChunkIn { u32x4 lw[2], qv[2], vv[2]; };
__device__ __forceinline__ void chunk_load(ChunkIn& r, int unit, const bf16_t* Q, const bf16_t* Kb, const bf16_t* LF, const bf16_t* V, const int tid) {
    const int c = unit & 31, bh = unit >> 5, h = bh & 7, b = bh >> 3;
    const size_t g = ((size_t)b * SEQ + (size_t)c * 64 + (tid >> 3)) * DM + h * 128 + (tid & 7) * 8;
#pragma unroll
    for (int i = 0; i < 2; ++i) { r.lw[i] = *(const u32x4*)(LF + g + 64 * i); r.qv[i] = *(const u32x4*)(Q + g + 64 * i); r.vv[i] = *(const u32x4*)(V + g + 64 * i); }
}
__device__ __forceinline__ bf16x8 tr_frag(const LAS unsigned char* img, int kk, int col0, int fr, int fq) {
    const LAS unsigned char* p = img + (32 * kk + 4 * fq + (fr >> 2)) * CP + (col0 + 4 * (fr & 3)) * 2;
    const s16x4 lo = tr_read(p), hi = tr_read(p + 16 * CP);
    return (bf16x8){lo[0], lo[1], lo[2], lo[3], hi[0], hi[1], hi[2], hi[3]};
}
__device__ __forceinline__ void chunk_stepA(LAS unsigned char* lds, int unit, const int pos, float (&lam0)[4], const ChunkIn& r, bf16_t* Qo, float* LAM, int wave, int lane, const int tid) {
    const int c = unit & 31, bh = unit >> 5, h = bh & 7, b = bh >> 3;
    const size_t row0 = (size_t)b * SEQ + (size_t)c * 64;
    const int fr = lane & 15, fq = lane >> 4;
    LAS unsigned char* LFI = lds + LFI_OFF; LAS unsigned char* QI = lds + QI_OFF; LAS unsigned char* KI = lds + KI2_OFF; LAS unsigned char* VI = lds + VI2_OFF;
    LAS float* BETA = (LAS float*)(lds + BETA_OFF); LAS float* EM = (LAS float*)(lds + EM_OFF); LAS float* LAM1 = (LAS float*)(lds + LAM1_OFF);
    { const int lo = (tid >> 3) * CP + (tid & 7) * 16;
#pragma unroll
      for (int i = 0; i < 2; ++i) { *(LAS u32x4*)(LFI + lo + 128 * i) = r.lw[i]; *(LAS u32x4*)(QI + lo + 128 * i) = r.qv[i]; *(LAS u32x4*)(VI + lo + 128 * i) = r.vv[i]; } }
    LDS_BARRIER();
    f32x4 bt[4];
#pragma unroll
    for (int tt = 0; tt < 4; ++tt) {
        f32x4 acc = {0.f, 0.f, 0.f, 0.f};
#pragma unroll
        for (int kk = 0; kk < 2; ++kk) if (32 * kk <= 16 * tt + 15) {
            const bf16x8 a = tr_frag(LFI, kk, 16 * wave, fr, fq);
            const int t = 16 * tt + fr, s0 = 32 * kk + 4 * fq;
            bf16x8 tri;
#pragma unroll
            for (int jj = 0; jj < 8; ++jj) tri[jj] = (s0 + (jj < 4 ? jj : 12 + jj)) <= t ? (short)0x3F80 : (short)0;
            acc = MFMA16(a, tri, acc);
        }
        bt[tt] = acc;
    }
    float bmid[4], em[4];
#pragma unroll
    for (int j = 0; j < 4; ++j) {
        bmid[j] = __shfl(bt[1][j], (lane & 48) | 15);
        const float bend = __shfl(bt[3][j], (lane & 48) | 15);
        em[j] = __expf(bmid[j]);
        const float lam = __expf(bend);
        const int d = 16 * wave + 4 * fq + j;
        if (fr == 0) { BETA[d] = __expf(bend - bmid[j]); if (pos > 0) { EM[d] = em[j]; LAM1[d] = lam; } if (pos == 3) LAM[(size_t)(((unit >> 5) << 3) + ((unit & 31) >> 2)) * 128 + d] = lam0[j] * lam; }
        if (pos > 0) { em[j] *= lam0[j]; lam0[j] *= lam; } else lam0[j] = lam;
    }
#pragma unroll
    for (int tt = 0; tt < 4; ++tt) {
        const int ao = (16 * tt + fr) * CP + (16 * wave + 4 * fq) * 2;
        const u32x2 qw = *(const LAS u32x2*)(QI + ao), lw = *(const LAS u32x2*)(LFI + ao);
        const float qf[4] = {bflo(qw.x), bfhi(qw.x), bflo(qw.y), bfhi(qw.y)};
        const float kf[4] = {1.0f - __expf(bflo(lw.x)), 1.0f - __expf(bfhi(lw.x)), 1.0f - __expf(bflo(lw.y)), 1.0f - __expf(bfhi(lw.y))};
        float qt[4], kt[4], qh[4];
#pragma unroll
        for (int j = 0; j < 4; ++j) { const float e1 = __expf(bt[tt][j] - bmid[j]), e2 = __expf(bmid[j] - bt[tt][j]); qt[j] = qf[j] * e1; kt[j] = kf[j] * e2; qh[j] = qt[j] * em[j]; }
        u32x2 w; w.x = pk2(qt[0], qt[1]); w.y = pk2(qt[2], qt[3]); *(LAS u32x2*)(QI + ao) = w;
        w.x = pk2(kt[0], kt[1]); w.y = pk2(kt[2], kt[3]); *(LAS u32x2*)(KI + ao) = w;
        w.x = pk2(qh[0], qh[1]); w.y = pk2(qh[2], qh[3]); *(u32x2*)(Qo + (row0 + 16 * tt + fr) * DM + h * 128 + 16 * wave + 4 * fq) = w;
    }
    LDS_BARRIER();
}
__device__ __forceinline__ void chunk_stepBC(LAS unsigned char* lds, int unit, const int pos, f32x4 (&ds0)[8], bf16_t* LFo, bf16_t* DS, int wave, int lane) {
    const int c = unit & 31, bh = unit >> 5, h = bh & 7, b = bh >> 3;
    const size_t row0 = (size_t)b * SEQ + (size_t)c * 64;
    const int fr = lane & 15, fq = lane >> 4;
    LAS unsigned char* QI = lds + QI_OFF; LAS unsigned char* KI = lds + KI2_OFF; LAS unsigned char* VI = lds + VI2_OFF;
    LAS bf16_t* AM = (LAS bf16_t*)(lds + AM_OFF); LAS float* BETA = (LAS float*)(lds + BETA_OFF); LAS float* EM = (LAS float*)(lds + EM_OFF); LAS float* LAM1 = (LAS float*)(lds + LAM1_OFF);
#pragma unroll
    for (int ii = 0; ii < 2; ++ii) {
        const int idx = 2 * wave + ii, st = idx >> 2, tt = idx & 3;
        f32x4 acc = {0.f, 0.f, 0.f, 0.f};
        if (st <= tt) {
#pragma unroll
            for (int kk = 0; kk < 4; ++kk) {
                const bf16x8 a = *(const LAS bf16x8*)(KI + (16 * st + fr) * CP + (32 * kk + 8 * fq) * 2);
                const bf16x8 bq = *(const LAS bf16x8*)(QI + (16 * tt + fr) * CP + (32 * kk + 8 * fq) * 2);
                acc = MFMA16(a, bq, acc);
            }
        }
        const int t = 16 * tt + fr, s0 = 16 * st + 4 * fq;
        float m0 = (s0 + 0 <= t) ? acc[0] : 0.f, m1 = (s0 + 1 <= t) ? acc[1] : 0.f, m2 = (s0 + 2 <= t) ? acc[2] : 0.f, m3 = (s0 + 3 <= t) ? acc[3] : 0.f;
        u32x2 w; w.x = pk2(m0, m1); w.y = pk2(m2, m3);
        *(LAS u32x2*)(AM + t * 72 + s0) = w;
    }
    LDS_BARRIER();
    bf16x8 va[2];
#pragma unroll
    for (int kk = 0; kk < 2; ++kk) va[kk] = tr_frag(VI, kk, 16 * wave, fr, fq);
    bf16x8 sf[4];
    if (pos > 0) {
#pragma unroll
        for (int kk = 0; kk < 4; ++kk) {
            const f32x4 e0 = *(const LAS f32x4*)(EM + 32 * kk + 4 * fq), e1 = *(const LAS f32x4*)(EM + 32 * kk + 16 + 4 * fq);
            const f32x4 x0 = ds0[2 * kk] * e0, x1 = ds0[2 * kk + 1] * e1;
            u32x4 w; w.x = pk2(x0[0], x0[1]); w.y = pk2(x0[2], x0[3]); w.z = pk2(x1[0], x1[1]); w.w = pk2(x1[2], x1[3]);
            sf[kk] = __builtin_bit_cast(bf16x8, w);
        }
    }
#pragma unroll
    for (int tt = 0; tt < 4; ++tt) {
        f32x4 acc = {0.f, 0.f, 0.f, 0.f};
        if (pos > 0) {
#pragma unroll
            for (int kk = 0; kk < 4; ++kk) {
                const LAS unsigned char* qp = QI + (16 * tt + fr) * CP + (32 * kk + 4 * fq) * 2;
                const u32x2 lo = *(const LAS u32x2*)qp, hi = *(const LAS u32x2*)(qp + 32);
                u32x4 w; w.x = lo.x; w.y = lo.y; w.z = hi.x; w.w = hi.y;
                acc = MFMA16(sf[kk], __builtin_bit_cast(bf16x8, w), acc);
            }
        }
#pragma unroll
        for (int kk = 0; kk < 2; ++kk) {
            const LAS bf16_t* ap = AM + (16 * tt + fr) * 72 + 32 * kk + 4 * fq;
            const u32x2 lo = *(const LAS u32x2*)ap, hi = *(const LAS u32x2*)(ap + 16);
            u32x4 w; w.x = lo.x; w.y = lo.y; w.z = hi.x; w.w = hi.y;
            acc = MFMA16(va[kk], __builtin_bit_cast(bf16x8, w), acc);
        }
        { u32x2 wo; wo.x = pk2(acc[0], acc[1]); wo.y = pk2(acc[2], acc[3]); *(u32x2*)(LFo + (row0 + 16 * tt + fr) * DM + h * 128 + 16 * wave + 4 * fq) = wo; }
    }
#pragma unroll
    for (int dt = 0; dt < 8; ++dt) {
        f32x4 acc = {0.f, 0.f, 0.f, 0.f};
#pragma unroll
        for (int kk = 0; kk < 2; ++kk) { const bf16x8 ak = tr_frag(KI, kk, 16 * dt, fr, fq); acc = MFMA16(ak, va[kk], acc); }
        const f32x4 be = *(const LAS f32x4*)(BETA + 16 * dt + 4 * fq);
        acc *= be;
        if (pos > 0) acc += ds0[dt] * *(const LAS f32x4*)(LAM1 + 16 * dt + 4 * fq);
        if (pos == 3) {
            u32x2 w; w.x = pk2(acc[0], acc[1]); w.y = pk2(acc[2], acc[3]);
            *(u32x2*)(DS + (((size_t)(((unit >> 5) << 3) + ((unit & 31) >> 2)) * 64 + dt * 8 + wave) * 64 + lane) * 4) = w;
        } else ds0[dt] = acc;
    }
    LDS_BARRIER();
}

constexpr int C2_SETB = 64512, C2_QI = 0, C2_KI = 18432, C2_VI = 36864, C2_AM = 55296, C2_SM0 = 129024, C2_SM1 = 150016, C2_LFI = 131584;
__device__ __forceinline__ LAS unsigned char* c2_set(LAS unsigned char* lds, int s) { return lds + s * C2_SETB; }
__device__ __forceinline__ LAS float* c2_small(LAS unsigned char* lds, int s) { return (LAS float*)(lds + (s ? C2_SM1 : C2_SM0)); }
__device__ __forceinline__ void chunk_A1(LAS unsigned char* lds, int s, const ChunkIn& r, const int tid) {
    LAS unsigned char* sb = c2_set(lds, s); LAS unsigned char* LFI = lds + C2_LFI;
    const int lo = (tid >> 3) * CP + (tid & 7) * 16;
#pragma unroll
    for (int i = 0; i < 2; ++i) { *(LAS u32x4*)(LFI + lo + 128 * i) = r.lw[i]; *(LAS u32x4*)(sb + C2_QI + lo + 128 * i) = r.qv[i]; *(LAS u32x4*)(sb + C2_VI + lo + 128 * i) = r.vv[i]; }
}
__device__ __forceinline__ void chunk_A2(LAS unsigned char* lds, int s, int unit, const int pos, float (&lam0)[4], bf16_t* Qo, float* LAM, int wave, int lane) {
    const int c = unit & 31, bh = unit >> 5, h = bh & 7, b = bh >> 3;
    const size_t row0 = (size_t)b * SEQ + (size_t)c * 64;
    const int fr = lane & 15, fq = lane >> 4;
    LAS unsigned char* sb = c2_set(lds, s); LAS unsigned char* LFI = lds + C2_LFI; LAS unsigned char* QI = sb + C2_QI; LAS unsigned char* KI = sb + C2_KI;
    LAS float* BETA = c2_small(lds, s); LAS float* EM = BETA + 128; LAS float* LAM1 = BETA + 256;
    f32x4 bt[4];
#pragma unroll
    for (int tt = 0; tt < 4; ++tt) {
        f32x4 acc = {0.f, 0.f, 0.f, 0.f};
#pragma unroll
        for (int kk = 0; kk < 2; ++kk) if (32 * kk <= 16 * tt + 15) {
            const bf16x8 a = tr_frag(LFI, kk, 16 * wave, fr, fq);
            const int t = 16 * tt + fr, s0 = 32 * kk + 4 * fq;
            bf16x8 tri;
#pragma unroll
            for (int jj = 0; jj < 8; ++jj) tri[jj] = (s0 + (jj < 4 ? jj : 12 + jj)) <= t ? (short)0x3F80 : (short)0;
            acc = MFMA16(a, tri, acc);
        }
        bt[tt] = acc;
    }
    float bmid[4], em[4];
#pragma unroll
    for (int j = 0; j < 4; ++j) {
        bmid[j] = __shfl(bt[1][j], (lane & 48) | 15);
        const float bend = __shfl(bt[3][j], (lane & 48) | 15);
        em[j] = __expf(bmid[j]);
        const float lam = __expf(bend);
        const int d = 16 * wave + 4 * fq + j;
        if (fr == 0) { BETA[d] = __expf(bend - bmid[j]); if (pos > 0) { EM[d] = em[j]; LAM1[d] = lam; } if (pos == 3) LAM[(size_t)(((unit >> 5) << 3) + ((unit & 31) >> 2)) * 128 + d] = lam0[j] * lam; }
        if (pos > 0) { em[j] *= lam0[j]; lam0[j] *= lam; } else lam0[j] = lam;
    }
#pragma unroll
    for (int tt = 0; tt < 4; ++tt) {
        const int ao = (16 * tt + fr) * CP + (16 * wave + 4 * fq) * 2;
        const u32x2 qw = *(const LAS u32x2*)(QI + ao), lw = *(const LAS u32x2*)(LFI + ao);
        const float qf[4] = {bflo(qw.x), bfhi(qw.x), bflo(qw.y), bfhi(qw.y)};
        const float kf[4] = {1.0f - __expf(bflo(lw.x)), 1.0f - __expf(bfhi(lw.x)), 1.0f - __expf(bflo(lw.y)), 1.0f - __expf(bfhi(lw.y))};
        float qt[4], kt[4], qh[4];
#pragma unroll
        for (int j = 0; j < 4; ++j) { const float e1 = __expf(bt[tt][j] - bmid[j]), e2 = __expf(bmid[j] - bt[tt][j]); qt[j] = qf[j] * e1; kt[j] = kf[j] * e2; qh[j] = qt[j] * em[j]; }
        u32x2 w; w.x = pk2(qt[0], qt[1]); w.y = pk2(qt[2], qt[3]); *(LAS u32x2*)(QI + ao) = w;
        w.x = pk2(kt[0], kt[1]); w.y = pk2(kt[2], kt[3]); *(LAS u32x2*)(KI + ao) = w;
        w.x = pk2(qh[0], qh[1]); w.y = pk2(qh[2], qh[3]); *(u32x2*)(Qo + (row0 + 16 * tt + fr) * DM + h * 128 + 16 * wave + 4 * fq) = w;
    }
}
__device__ __forceinline__ void chunk_B(LAS unsigned char* lds, int s, int wave, int lane) {
    const int fr = lane & 15, fq = lane >> 4;
    LAS unsigned char* sb = c2_set(lds, s); LAS unsigned char* QI = sb + C2_QI; LAS unsigned char* KI = sb + C2_KI; LAS bf16_t* AM = (LAS bf16_t*)(sb + C2_AM);
#pragma unroll
    for (int ii = 0; ii < 2; ++ii) {
        const int idx = 2 * wave + ii, st = idx >> 2, tt = idx & 3;
        f32x4 acc = {0.f, 0.f, 0.f, 0.f};
        if (st <= tt) {
#pragma unroll
            for (int kk = 0; kk < 4; ++kk) {
                const bf16x8 a = *(const LAS bf16x8*)(KI + (16 * st + fr) * CP + (32 * kk + 8 * fq) * 2);
                const bf16x8 bq = *(const LAS bf16x8*)(QI + (16 * tt + fr) * CP + (32 * kk + 8 * fq) * 2);
                acc = MFMA16(a, bq, acc);
            }
        }
        const int t = 16 * tt + fr, s0 = 16 * st + 4 * fq;
        float m0 = (s0 + 0 <= t) ? acc[0] : 0.f, m1 = (s0 + 1 <= t) ? acc[1] : 0.f, m2 = (s0 + 2 <= t) ? acc[2] : 0.f, m3 = (s0 + 3 <= t) ? acc[3] : 0.f;
        u32x2 w; w.x = pk2(m0, m1); w.y = pk2(m2, m3);
        *(LAS u32x2*)(AM + t * 72 + s0) = w;
    }
}
__device__ __forceinline__ void chunk_C(LAS unsigned char* lds, int s, int unit, const int pos, f32x4 (&ds0)[8], bf16_t* LFo, bf16_t* DS, int wave, int lane) {
    const int c = unit & 31, bh = unit >> 5, h = bh & 7, b = bh >> 3;
    const size_t row0 = (size_t)b * SEQ + (size_t)c * 64;
    const int fr = lane & 15, fq = lane >> 4;
    LAS unsigned char* sb = c2_set(lds, s); LAS unsigned char* QI = sb + C2_QI; LAS unsigned char* KI = sb + C2_KI; LAS unsigned char* VI = sb + C2_VI; LAS bf16_t* AM = (LAS bf16_t*)(sb + C2_AM);
    LAS float* BETA = c2_small(lds, s); LAS float* EM = BETA + 128; LAS float* LAM1 = BETA + 256;
    bf16x8 va[2];
#pragma unroll
    for (int kk = 0; kk < 2; ++kk) va[kk] = tr_frag(VI, kk, 16 * wave, fr, fq);
    bf16x8 sf[4];
    if (pos > 0) {
#pragma unroll
        for (int kk = 0; kk < 4; ++kk) {
            const f32x4 e0 = *(const LAS f32x4*)(EM + 32 * kk + 4 * fq), e1 = *(const LAS f32x4*)(EM + 32 * kk + 16 + 4 * fq);
            const f32x4 x0 = ds0[2 * kk] * e0, x1 = ds0[2 * kk + 1] * e1;
            u32x4 w; w.x = pk2(x0[0], x0[1]); w.y = pk2(x0[2], x0[3]); w.z = pk2(x1[0], x1[1]); w.w = pk2(x1[2], x1[3]);
            sf[kk] = __builtin_bit_cast(bf16x8, w);
        }
    }
#pragma unroll
    for (int tt = 0; tt < 4; ++tt) {
        f32x4 acc = {0.f, 0.f, 0.f, 0.f};
        if (pos > 0) {
#pragma unroll
            for (int kk = 0; kk < 4; ++kk) {
                const LAS unsigned char* qp = QI + (16 * tt + fr) * CP + (32 * kk + 4 * fq) * 2;
                const u32x2 lo = *(const LAS u32x2*)qp, hi = *(const LAS u32x2*)(qp + 32);
                u32x4 w; w.x = lo.x; w.y = lo.y; w.z = hi.x; w.w = hi.y;
                acc = MFMA16(sf[kk], __builtin_bit_cast(bf16x8, w), acc);
            }
        }
#pragma unroll
        for (int kk = 0; kk < 2; ++kk) {
            const LAS bf16_t* ap = AM + (16 * tt + fr) * 72 + 32 * kk + 4 * fq;
            const u32x2 lo = *(const LAS u32x2*)ap, hi = *(const LAS u32x2*)(ap + 16);
            u32x4 w; w.x = lo.x; w.y = lo.y; w.z = hi.x; w.w = hi.y;
            acc = MFMA16(va[kk], __builtin_bit_cast(bf16x8, w), acc);
        }
        { u32x2 wo; wo.x = pk2(acc[0], acc[1]); wo.y = pk2(acc[2], acc[3]); *(u32x2*)(LFo + (row0 + 16 * tt + fr) * DM + h * 128 + 16 * wave + 4 * fq) = wo; }
    }
#pragma unroll
    for (int dt = 0; dt < 8; ++dt) {
        f32x4 acc = {0.f, 0.f, 0.f, 0.f};
#pragma unroll
        for (int kk = 0; kk < 2; ++kk) { const bf16x8 ak = tr_frag(KI, kk, 16 * dt, fr, fq); acc = MFMA16(ak, va[kk], acc); }
        const f32x4 be = *(const LAS f32x4*)(BETA + 16 * dt + 4 * fq);
        acc *= be;
        if (pos > 0) acc += ds0[dt] * *(const LAS f32x4*)(LAM1 + 16 * dt + 4 * fq);
        if (pos == 3) {
            u32x2 w; w.x = pk2(acc[0], acc[1]); w.y = pk2(acc[2], acc[3]);
            *(u32x2*)(DS + (((size_t)(((unit >> 5) << 3) + ((unit & 31) >> 2)) * 64 + dt * 8 + wave) * 64 + lane) * 4) = w;
        } else ds0[dt] = acc;
    }
}

__device__ __forceinline__ void hgrn_scan_phase(const bf16_t* DS, bf16_t* SCo, const float* LAM, float* stp_layer, int gt, int ngt) {
    for (int item = gt; item < 64 * 4096; item += ngt) {
        const int bh = item >> 12, tl = item & 4095, tile = tl >> 6, ln = tl & 63, dt = tile >> 3, et = tile & 7, fq = ln >> 4, fr = ln & 15;
        float S0 = 0.f, S1 = 0.f, S2 = 0.f, S3 = 0.f;
        const size_t boff = ((size_t)bh * 32768 + tile * 64 + ln) * 4;
        const float* lbase = LAM + (size_t)bh * 8 * 128 + 16 * dt + 4 * fq;
#pragma unroll 1
        for (int c0 = 0; c0 < 8; c0 += 8) {
            u32x2 dw[8]; f32x4 lam[8];
#pragma unroll
            for (int j = 0; j < 8; ++j) { dw[j] = *(const u32x2*)(DS + boff + (size_t)(c0 + j) * 16384); lam[j] = *(const f32x4*)(lbase + (c0 + j) * 128); }
#pragma unroll
            for (int j = 0; j < 8; ++j) {
                u32x2 sc; sc.x = pk2(S0, S1); sc.y = pk2(S2, S3); *(u32x2*)(SCo + boff + (size_t)(c0 + j) * 16384) = sc;
                S0 = S0 * lam[j].x + bflo(dw[j].x); S1 = S1 * lam[j].y + bfhi(dw[j].x); S2 = S2 * lam[j].z + bflo(dw[j].y); S3 = S3 * lam[j].w + bfhi(dw[j].y);
            }
        }
        float* o = stp_layer + (size_t)bh * 16384 + (size_t)(16 * dt + 4 * fq) * 128 + 16 * et + fr;
        o[0] = S0; o[128] = S1; o[256] = S2; o[384] = S3;
    }
}

struct InterIn { u32x4 q[2], o[2], g[2]; };
struct InterSc { u32x2 sc[8]; };
__device__ __forceinline__ void inter_load(InterIn& r, int unit, const bf16_t* Q, const bf16_t* OI, const bf16_t* G, const bf16_t* SC, int wave, int lane, const int tid) {
    const int c = unit & 31, bh = unit >> 5, h = bh & 7, b = bh >> 3;
    const size_t g0 = ((size_t)b * SEQ + (size_t)c * 64 + (tid >> 3)) * DM + h * 128 + (tid & 7) * 8;
#pragma unroll
    for (int i = 0; i < 2; ++i) { r.q[i] = *(const u32x4*)(Q + g0 + 64 * i); r.o[i] = *(const u32x4*)(OI + g0 + 64 * i); r.g[i] = *(const u32x4*)(G + g0 + 64 * i); }
}
__device__ __forceinline__ void inter_load_sc(InterSc& s, int unit, const bf16_t* SC, int wave, int lane) {
    const size_t su = (size_t)(((unit >> 5) << 3) + ((unit & 31) >> 2));
#pragma unroll
    for (int dt = 0; dt < 8; ++dt) s.sc[dt] = *(const u32x2*)(SC + ((su * 64 + dt * 8 + wave) * 64 + lane) * 4);
}
__device__ __forceinline__ void quad_prefix(LAS unsigned char* lds, InterSc& sc0, InterSc& sc1, int bh0, int bh1, int qp, const bf16_t* DS, const float* LAM, float* stp_layer, int wave, int lane, const int tid) {
    LAS float* lam_l = (LAS float*)lds;
    const int last_bh = qp == 7 ? bh0 : (qp == 0 ? bh1 : -1);
#define QP_SU(i_) ((i_) < 7 ? ((i_) < qp ? bh0 * 8 + (i_) : bh1 * 8 + (i_) - qp) : (last_bh >= 0 ? last_bh * 8 + 7 : bh1 * 8 + 6 - qp + (qp == 7 ? 8 * (bh0 - bh1) + 7 : 0)))
#pragma unroll
    for (int r = 0; r < 2; ++r) { const int v = tid + 512 * r, i = v >> 7, d = v & 127; lam_l[v] = LAM[(size_t)QP_SU(i) * 128 + d]; }
#define QP_LOAD(dst, i_) do { const size_t su_ = (size_t)QP_SU(i_); _Pragma("unroll") for (int dt = 0; dt < 8; ++dt) dst.sc[dt] = *(const u32x2*)(DS + ((su_ * 64 + dt * 8 + wave) * 64 + lane) * 4); } while (0)
    InterSc dq[8];
#pragma unroll
    for (int i = 0; i < 8; ++i) QP_LOAD(dq[i], i);
    __syncthreads();
    const int fq = lane >> 4, fr = lane & 15;
    f32x4 S[8];
#pragma unroll
    for (int dt = 0; dt < 8; ++dt) { S[dt] = (f32x4){0.f, 0.f, 0.f, 0.f}; sc0.sc[dt].x = 0u; sc0.sc[dt].y = 0u; }
#pragma unroll
    for (int i = 0; i < 7; ++i) {
        if (i == qp) {
#pragma unroll
            for (int dt = 0; dt < 8; ++dt) { sc0.sc[dt].x = pk2(S[dt][0], S[dt][1]); sc0.sc[dt].y = pk2(S[dt][2], S[dt][3]); S[dt] = (f32x4){0.f, 0.f, 0.f, 0.f}; }
        }
#pragma unroll
        for (int dt = 0; dt < 8; ++dt) { const f32x4 lm = *(const LAS f32x4*)(lam_l + i * 128 + 16 * dt + 4 * fq);
            S[dt] = S[dt] * lm + (f32x4){bflo(dq[i].sc[dt].x), bfhi(dq[i].sc[dt].x), bflo(dq[i].sc[dt].y), bfhi(dq[i].sc[dt].y)}; }
    }
#pragma unroll
    for (int dt = 0; dt < 8; ++dt) {
        const unsigned wx = pk2(S[dt][0], S[dt][1]), wy = pk2(S[dt][2], S[dt][3]);
        if (qp == 7) { sc0.sc[dt].x = wx; sc0.sc[dt].y = wy; sc1.sc[dt].x = 0u; sc1.sc[dt].y = 0u; } else { sc1.sc[dt].x = wx; sc1.sc[dt].y = wy; }
    }
    if (last_bh >= 0) {
        float* o = stp_layer + (size_t)last_bh * 16384 + 16 * wave + fr;
#pragma unroll
        for (int dt = 0; dt < 8; ++dt) { const f32x4 lm = *(const LAS f32x4*)(lam_l + 7 * 128 + 16 * dt + 4 * fq);
            const f32x4 e = S[dt] * lm + (f32x4){bflo(dq[7].sc[dt].x), bfhi(dq[7].sc[dt].x), bflo(dq[7].sc[dt].y), bfhi(dq[7].sc[dt].y)};
#pragma unroll
            for (int r = 0; r < 4; ++r) o[(size_t)(16 * dt + 4 * fq + r) * 128] = e[r]; }
    }
#undef QP_SU
#undef QP_LOAD
    __syncthreads();
}
__device__ __forceinline__ void inter_compute(LAS unsigned char* lds, int unit, int par, const InterIn& r, const InterSc& s, bf16_t* Qo, int wave, int lane, const int tid) {
    const int c = unit & 31, bh = unit >> 5, h = bh & 7, b = bh >> 3, fr = lane & 15, fq = lane >> 4;
    LAS bf16_t* QH = (LAS bf16_t*)(lds + par * 52224); LAS bf16_t* OT = QH + 8704; LAS bf16_t* GT = OT + 8704;
    LAS float* red = (LAS float*)(lds + 104448 + par * 2048);
    const int so = (tid >> 3) * 136 + (tid & 7) * 8;
#pragma unroll
    for (int i = 0; i < 2; ++i) { *(LAS u32x4*)(QH + so + 64 * i) = r.q[i]; *(LAS u32x4*)(OT + so + 64 * i) = r.o[i]; *(LAS u32x4*)(GT + so + 64 * i) = r.g[i]; }
    LDS_BARRIER();
    f32x4 o[4];
#pragma unroll
    for (int tt = 0; tt < 4; ++tt) { const u32x2 ow = *(const LAS u32x2*)(OT + (16 * tt + fr) * 136 + 16 * wave + 4 * fq); o[tt] = (f32x4){bflo(ow.x), bfhi(ow.x), bflo(ow.y), bfhi(ow.y)}; }
#pragma unroll
    for (int kk = 0; kk < 4; ++kk) {
        u32x4 aw; aw.x = s.sc[2 * kk].x; aw.y = s.sc[2 * kk].y; aw.z = s.sc[2 * kk + 1].x; aw.w = s.sc[2 * kk + 1].y;
        const bf16x8 af = __builtin_bit_cast(bf16x8, aw);
#pragma unroll
        for (int tt = 0; tt < 4; ++tt) {
            const LAS bf16_t* qp = QH + (16 * tt + fr) * 136 + 32 * kk + 4 * fq;
            const u32x2 lo = *(const LAS u32x2*)qp, hi = *(const LAS u32x2*)(qp + 16);
            u32x4 w; w.x = lo.x; w.y = lo.y; w.z = hi.x; w.w = hi.y;
            o[tt] = MFMA16(af, __builtin_bit_cast(bf16x8, w), o[tt]);
        }
    }
#pragma unroll
    for (int tt = 0; tt < 4; ++tt) {
        float p = (o[tt][0] * o[tt][0] + o[tt][1] * o[tt][1]) + (o[tt][2] * o[tt][2] + o[tt][3] * o[tt][3]);
        p += __shfl_xor(p, 16); p += __shfl_xor(p, 32);
        if (fq == 0) red[wave * 64 + 16 * tt + fr] = p;
    }
    LDS_BARRIER();
#pragma unroll
    for (int tt = 0; tt < 4; ++tt) {
        float tot = 0.f;
#pragma unroll
        for (int w2 = 0; w2 < 8; ++w2) tot += red[w2 * 64 + 16 * tt + fr];
        const float rs = rsqrtf(tot * (1.0f / 128.0f) + NORM_EPS);
        const int po = (16 * tt + fr) * 136 + 16 * wave + 4 * fq;
        const u32x2 gw = *(const LAS u32x2*)(GT + po);
        u32x2 w; w.x = pk2(o[tt][0] * rs * bflo(gw.x), o[tt][1] * rs * bfhi(gw.x)); w.y = pk2(o[tt][2] * rs * bflo(gw.y), o[tt][3] * rs * bfhi(gw.y));
        *(LAS u32x2*)(OT + po) = w;
    }
    LDS_BARRIER();
    const size_t g0 = ((size_t)b * SEQ + (size_t)c * 64 + (tid >> 3)) * DM + h * 128 + (tid & 7) * 8;
#pragma unroll
    for (int i = 0; i < 2; ++i) *(u32x4*)(Qo + g0 + 64 * i) = *(const LAS u32x4*)(OT + so + 64 * i);
}

struct SampleIn { f32x4 sv[4]; u32x2 vw; bf16_t q, lf, g; };
__device__ __forceinline__ void sample_load(SampleIn& r, int unit, int half, const bf16_t* Q, const bf16_t* Kb, const bf16_t* LF, const bf16_t* V, const bf16_t* G, const float* s0, const int tid) {
    const int n = unit >> 3, h = unit & 7;
    const size_t rb = (size_t)(TP + n) * DM + h * 128;
    const int dg = tid >> 5, e4 = (tid & 31) * 4;
#pragma unroll
    for (int dd = 0; dd < 4; ++dd) r.sv[dd] = __builtin_nontemporal_load((const f32x4*)(s0 + (size_t)(dg * 8 + half * 4 + dd) * 128 + e4));
    r.vw = *(const u32x2*)(V + rb + e4);
    const int t7 = tid & 127;
    r.q = Q[rb + t7]; r.lf = LF[rb + t7]; r.g = G[rb + t7];
}
__device__ __forceinline__ void sample_compute(LAS unsigned char* lds, int unit, int half, const SampleIn& r, bf16_t* Qo, float* s1, const int tid) {
    const int n = unit >> 3, h = unit & 7;
    const size_t rb = (size_t)(TP + n) * DM + h * 128;
    LAS float* qs = (LAS float*)lds; LAS float* ks = qs + 128; LAS float* fs = qs + 256; LAS float* part = qs + 384;
    LAS float* redw = qs + 384 + 4096;
    if (half == 0) {
        if (tid < 128) { const float f = __expf(bf1(r.lf)); qs[tid] = bf1(r.q); ks[tid] = 1.0f - f; fs[tid] = f; }
        LDS_BARRIER();
    }
    const int dg = tid >> 5, e4 = (tid & 31) * 4;
    const f32x4 v4 = {bflo(r.vw.x), bfhi(r.vw.x), bflo(r.vw.y), bfhi(r.vw.y)};
    f32x4 o4 = {0.f, 0.f, 0.f, 0.f};
#pragma unroll
    for (int dd = 0; dd < 4; ++dd) {
        const int d = dg * 8 + half * 4 + dd;
        const f32x4 sn = r.sv[dd] * fs[d] + v4 * ks[d];
        __builtin_nontemporal_store(sn, (f32x4*)(s1 + (size_t)d * 128 + e4));
        o4 += sn * qs[d];
    }
    *(LAS f32x4*)(part + (dg * 2 + half) * 128 + e4) = o4;
    if (half == 1) {
        LDS_BARRIER();
        float o = 0.f;
        if (tid < 128) {
#pragma unroll
            for (int i = 0; i < 32; ++i) o += part[i * 128 + tid];
        }
        float sq = wave_sum(o * o);
        if ((tid & 63) == 0) redw[tid >> 6] = sq;
        LDS_BARRIER();
        if (tid < 128) {
            const float tot = redw[0] + redw[1];
            const float rs = rsqrtf(tot * (1.0f / 128.0f) + NORM_EPS);
            Qo[rb + tid] = (bf16_t)f2bf(o * rs * bf1(r.g));
        }
    }
}

__device__ __forceinline__ void sample_rec_units(LAS unsigned char* lds, unsigned char* ws, const float* st_in, float* st_out, int bx, int G, const int tid) {
    const bf16_t* Qp = (const bf16_t*)(ws + WS_Q); const bf16_t* Kp = (const bf16_t*)(ws + WS_K); const bf16_t* Lp = (const bf16_t*)(ws + WS_LF); const bf16_t* Vp = (const bf16_t*)(ws + WS_V); const bf16_t* Gp = (const bf16_t*)(ws + WS_G);
    bf16_t* Qo = (bf16_t*)(ws + WS_Q);
    SampleIn c0, c1, n0, n1;
    sample_load(c0, bx, 0, Qp, Kp, Lp, Vp, Gp, st_in + (size_t)bx * 16384, tid); sample_load(c1, bx, 1, Qp, Kp, Lp, Vp, Gp, st_in + (size_t)bx * 16384, tid);
#pragma unroll 1
    for (int k = 0; k < 4; ++k) {
        const int su = bx + G * k, sn = k < 3 ? su + G : su;
        sample_load(n0, sn, 0, Qp, Kp, Lp, Vp, Gp, st_in + (size_t)sn * 16384, tid); sample_load(n1, sn, 1, Qp, Kp, Lp, Vp, Gp, st_in + (size_t)sn * 16384, tid);
        sample_compute(lds + 112640, su, 0, c0, Qo, st_out + (size_t)su * 16384, tid);
        sample_compute(lds + 112640, su, 1, c1, Qo, st_out + (size_t)su * 16384, tid);
        c0 = n0; c1 = n1;
    }
    __syncthreads();
}

constexpr int KI_OFF = 0, VI_OFF = 40960, KVP = 160;
template <bool MIDFULL>
__device__ __forceinline__ void attn_core(const LAS unsigned char* KI, const LAS unsigned char* VI, int kt0, const bf16x8 (&qf)[2], int jlo, int jhi, float sink, int fr, int fq, f32x4 (&o)[4]) {
    f32x4 s[9];
    const LAS unsigned char* kb = KI + (16 * kt0 + fr) * KVP + 16 * fq;
#pragma unroll
    for (int x = 0; x < 9; ++x) {
        s[x] = (f32x4){0.f, 0.f, 0.f, 0.f};
#pragma unroll
        for (int kk = 0; kk < 2; ++kk) { const bf16x8 a = *(const LAS bf16x8*)(kb + x * 16 * KVP + kk * 64); s[x] = MFMA16(a, qf[kk], s[x]); }
    }
    float mx = sink;
    const int j0 = 16 * kt0 + 4 * fq;
#pragma unroll
    for (int x = 0; x < 9; ++x)
#pragma unroll
        for (int r = 0; r < 4; ++r) {
            float sv = s[x][r];
            if (!MIDFULL || x == 0 || x == 8) { const int j = j0 + 16 * x + r; const bool valid = (j >= jlo) && (j <= jhi); sv = valid ? sv : -1e30f; s[x][r] = sv; }
            mx = fmaxf(mx, sv); }
    mx = fmaxf(mx, __shfl_xor(mx, 16)); mx = fmaxf(mx, __shfl_xor(mx, 32));
    float sum = 0.f;
#pragma unroll
    for (int x = 0; x < 9; ++x)
#pragma unroll
        for (int r = 0; r < 4; ++r) { const float p = __builtin_amdgcn_exp2f(s[x][r] - mx); s[x][r] = p; sum += p; }
    sum += __shfl_xor(sum, 16); sum += __shfl_xor(sum, 32);
    const float inv = fast_rcp(sum + __builtin_amdgcn_exp2f(sink - mx));
    bf16x8 pb[5];
#pragma unroll
    for (int y = 0; y < 5; ++y) {
        u32x4 w; w.x = pk2(s[2 * y][0] * inv, s[2 * y][1] * inv); w.y = pk2(s[2 * y][2] * inv, s[2 * y][3] * inv);
        if (y < 4) { w.z = pk2(s[2 * y + 1][0] * inv, s[2 * y + 1][1] * inv); w.w = pk2(s[2 * y + 1][2] * inv, s[2 * y + 1][3] * inv); } else { w.z = 0u; w.w = 0u; }
        pb[y] = __builtin_bit_cast(bf16x8, w);
    }
    const LAS unsigned char* vb = VI + (16 * kt0 + 4 * fq + (fr >> 2)) * KVP + 8 * (fr & 3);
#pragma unroll
    for (int dt = 0; dt < 4; ++dt) {
        f32x4 acc = {0.f, 0.f, 0.f, 0.f};
#pragma unroll
        for (int y = 0; y < 5; ++y) {
            const s16x4 lo = tr_read(vb + (32 * y) * KVP + 32 * dt);
            s16x4 hi = {0, 0, 0, 0};
            if (y < 4) hi = tr_read(vb + (32 * y + 16) * KVP + 32 * dt);
            const bf16x8 a = {lo[0], lo[1], lo[2], lo[3], hi[0], hi[1], hi[2], hi[3]};
            acc = MFMA16(a, pb[y], acc);
        }
        o[dt] = acc;
    }
}

__device__ __forceinline__ void swa_prompt_unit(LAS unsigned char* lds, int unit, const bf16_t* QA, bf16_t* QAo, const bf16_t* GA, const bf16_t* KA, const bf16_t* VA, const float* sinks, int wave, int lane, const int tid) {
    const int b = unit >> 5, blk = (unit >> 1) & 15, kvh = unit & 1;
    const int R0 = b * SEQ + blk * 128;
    const int fr = lane & 15, fq = lane >> 4;
    LAS unsigned char* KI = lds + KI_OFF; LAS unsigned char* VI = lds + VI_OFF;
    const int hq = kvh * 8 + wave;
    const size_t qbase = (size_t)(R0 + fr) * DM + hq * 64;
    bf16x8 qf[8][2];
#pragma unroll
    for (int qt = 0; qt < 8; ++qt)
#pragma unroll
        for (int kk = 0; kk < 2; ++kk) qf[qt][kk] = *(const bf16x8*)(QA + qbase + (size_t)qt * 16 * DM + 32 * kk + 8 * fq);
#pragma unroll
    for (int i = 0; i < 4; ++i) {
        const int idx = tid + 512 * i, key = idx >> 3, ch = idx & 7;
        u32x4 kk = {0u, 0u, 0u, 0u}, vv = {0u, 0u, 0u, 0u};
        if (blk > 0 || key >= 128) { const size_t g = (size_t)(R0 - 128 + key) * 128 + kvh * 64 + ch * 8; kk = *(const u32x4*)(KA + g); vv = *(const u32x4*)(VA + g); }
        *(LAS u32x4*)(KI + key * KVP + ch * 16) = kk; *(LAS u32x4*)(VI + key * KVP + ch * 16) = vv;
    }
    const float sink = sinks[hq] * 1.4426950408889634f;
    __syncthreads();
#pragma unroll
    for (int qt = 0; qt < 8; ++qt) {
        const size_t idx0 = qbase + (size_t)qt * 16 * DM + 4 * fq;
        u32x2 gw[4];
#pragma unroll
        for (int dt = 0; dt < 4; ++dt) gw[dt] = *(const u32x2*)(GA + idx0 + 16 * dt);
        const int tq = 16 * qt + fr;
        f32x4 o[4];
        if (blk > 0) attn_core<true>(KI, VI, qt, qf[qt], tq, tq + 128, sink, fr, fq, o);
        else attn_core<false>(KI, VI, qt, qf[qt], tq > 128 ? tq : 128, tq + 128, sink, fr, fq, o);
#pragma unroll
        for (int dt = 0; dt < 4; ++dt) {
            u32x2 w; w.x = pk2(o[dt][0] * bflo(gw[dt].x), o[dt][1] * bfhi(gw[dt].x)); w.y = pk2(o[dt][2] * bflo(gw[dt].y), o[dt][3] * bfhi(gw[dt].y));
            *(u32x2*)(QAo + idx0 + 16 * dt) = w;
        }
    }
    __syncthreads();
}

__device__ __forceinline__ void swa_sample_unit(LAS unsigned char* lds, int unit, const bf16_t* QA, bf16_t* QAo, const bf16_t* GA, const bf16_t* KA, const bf16_t* VA, const float* ck, const float* cv, const float* sinks, int wave, int lane, const int tid) {
    const int n = unit >> 1, kvh = unit & 1;
    const size_t row = (size_t)(TP + n);
    const int fr = lane & 15, fq = lane >> 4;
    LAS unsigned char* KI = lds + KI_OFF; LAS unsigned char* VI = lds + VI_OFF;
    const int hq = kvh * 8 + (fr & 7);
    bf16x8 qf[2];
#pragma unroll
    for (int kk = 0; kk < 2; ++kk) qf[kk] = *(const bf16x8*)(QA + row * DM + hq * 64 + 32 * kk + 8 * fq);
#pragma unroll
    for (int i = 0; i < 3; ++i) {
        const int idx = tid + 512 * i, key = idx >> 3, ch = idx & 7;
        if (key < 144) {
            u32x4 kk = {0u, 0u, 0u, 0u}, vv = {0u, 0u, 0u, 0u};
            if (key < 128) {
                const size_t g = ((size_t)(n * 128 + key) * 2 + kvh) * 64 + ch * 8;
                const f32x4 k0 = *(const f32x4*)(ck + g), k1 = *(const f32x4*)(ck + g + 4), v0 = *(const f32x4*)(cv + g), v1 = *(const f32x4*)(cv + g + 4);
                kk.x = pk2(k0.x, k0.y); kk.y = pk2(k0.z, k0.w); kk.z = pk2(k1.x, k1.y); kk.w = pk2(k1.z, k1.w);
                vv.x = pk2(v0.x, v0.y); vv.y = pk2(v0.z, v0.w); vv.z = pk2(v1.x, v1.y); vv.w = pk2(v1.z, v1.w);
            } else if (key == 128) { const size_t g = row * 128 + kvh * 64 + ch * 8; kk = *(const u32x4*)(KA + g); vv = *(const u32x4*)(VA + g); }
            *(LAS u32x4*)(KI + key * KVP + ch * 16) = kk; *(LAS u32x4*)(VI + key * KVP + ch * 16) = vv;
        }
    }
    const float sink = sinks[hq] * 1.4426950408889634f;
    __syncthreads();
    if (wave == 0) {
        const size_t idx0 = row * DM + hq * 64 + 4 * fq;
        u32x2 gw[4];
#pragma unroll
        for (int dt = 0; dt < 4; ++dt) gw[dt] = *(const u32x2*)(GA + idx0 + 16 * dt);
        f32x4 o[4];
        attn_core<false>(KI, VI, 0, qf, 0, 128, sink, fr, fq, o);
        if (fr < 8) {
#pragma unroll
            for (int dt = 0; dt < 4; ++dt) {
                u32x2 w; w.x = pk2(o[dt][0] * bflo(gw[dt].x), o[dt][1] * bfhi(gw[dt].x)); w.y = pk2(o[dt][2] * bflo(gw[dt].y), o[dt][3] * bfhi(gw[dt].y));
                *(u32x2*)(QAo + idx0 + 16 * dt) = w;
            }
        }
    }
    __syncthreads();
}

__global__ void __launch_bounds__(NWAVES * 64, 2) yoco_fwd(Args args) {
    extern __shared__ __attribute__((aligned(16))) unsigned char lds_raw[];
    LAS unsigned char* lds = (LAS unsigned char*)lds_raw;
    volatile LAS unsigned* MISC = (volatile LAS unsigned*)(lds + MISC_OFF);
    const int G = gridDim.x, bx = blockIdx.x;
    { const int tid = threadIdx.x;
      for (int u = tid; u < (LDS_BYTES - LDSCTL_OFF) / 4; u += NWAVES * 64) ((LAS unsigned*)(lds + LDSCTL_OFF))[u] = 0u; }
    __syncthreads();
    XcdBarrier bar = xcd_barrier_post((unsigned*)(args.ws + WS_CTL) + CW_BAR, MISC + 8);
    const int lo = args.ph_lo, hi = args.ph_hi;
#define IN(k) (lo <= (k) && (k) < hi)
#define SEAM(k) do { if (IN(k) && IN((k) + 1)) { for (int rep = 0; rep < NREP(9); ++rep) xcd_barrier(bar); } } while (0)
#define PHASE_LOCALS() KArgPtr ap = kargs(); unsigned char* ws = ap->ws; const int tid = fresh_tid(), lane = tid & 63, wave = __builtin_amdgcn_readfirstlane(tid >> 6); (void)lane; (void)wave; (void)ws

    if (IN(0)) { for (int rep = 0; rep < NREP(0); ++rep) { PHASE_LOCALS(); p0_prologue(ap, lds, wave, lane); } }
    SEAM(0);

#define S_IN_A(l_)  do { EpiHgrnIn Es{ws, (l_), (const LAS float*)(lds + RSTD_OFF)}; const bf16_t* Bs = (const bf16_t*)(ws + ((l_) == 0 ? WS_WIN0 : WS_WIN1)); \
        for (int u = bx; u < 256; u += G) sgemm_unit<64, 32>(lds, (const bf16_t*)(ws + WS_HB) + (size_t)TP * DM, Bs, u, Es, wave, lane, tid); } while (0)
#define S_OUT(WOFF, u0_, ustep_) do { EpiResid Es{ws}; const bf16_t* Bs = (const bf16_t*)(ws + (WOFF)); \
        for (int u = (u0_); u < 256; u += (ustep_)) sgemm_unit<32, 16>(lds, (const bf16_t*)(ws + WS_Q) + (size_t)TP * DM, Bs, u, Es, wave, lane, tid); } while (0)
#define S_STEP(l_)  sample_rec_units(lds, ws, ap->in[2] + (size_t)(l_) * 1024 * 16384, ap->out + O_STS + (size_t)(l_) * 1024 * 16384, bx, G, tid)
#define S_ATTN(j_)  do { const float* sk = ap->in[14] + (j_) * 16; \
        for (int u = bx; u < 256; u += G) swa_sample_unit(lds, u, (const bf16_t*)(ws + WS_Q), (bf16_t*)(ws + WS_Q), (const bf16_t*)(ws + WS_G), (const bf16_t*)(ws + WS_KA), (const bf16_t*)(ws + WS_VA), ap->in[3], ap->in[4], sk, wave, lane, tid); } while (0)

#pragma unroll 1
    for (int l = 0; l < 2; ++l) {
        const int pb = 1 + 5 * l;
        if (IN(pb)) {
            PHASE_LOCALS();
            const bf16_t* Bt = (const bf16_t*)(ws + (l == 0 ? WS_WIN0 : WS_WIN1));
            const int vcu = (bx & 7) * (G >> 3) + (bx >> 3);
            pg8::Gemm g{(const bf16_t*)(ws + WS_HB), Bt, TP, 4096, 1024}; pg8::HeadPairOrder S; S.pm = vcu >> 2; S.hp = vcu & 3; S.rot = (vcu >> 5) & 3; { int n4 = 4; asm volatile("" : "+s"(n4)); S.nu = n4; }
            EpiHgrnIn E{ws, l, (const LAS float*)(lds + RSTD_OFF)};
            stage_row_tables(ws, S.pm, lds, false, tid);
            S_IN_A(l);
            pg8::gemm_phase<EpiHgrnIn, pg8::HeadPairOrder, PG8_ALIGN, PG8_SP2>(lds + RING_OFF, g, S, E, tid);
        }
        if (IN(pb)) {
            PHASE_LOCALS();
            __syncthreads();
            const int vcu = (bx & 7) * (G >> 3) + (bx >> 3);
            const int pm_ = vcu >> 2, hp_ = vcu & 3, bq = pm_ >> 3, c0 = 4 * (pm_ & 7);
            const bf16_t* Qp = (const bf16_t*)(ws + WS_Q); const bf16_t* Kp = (const bf16_t*)(ws + WS_K); const bf16_t* Lp = (const bf16_t*)(ws + WS_LF); const bf16_t* Vp = (const bf16_t*)(ws + WS_V);
            {
                ChunkIn r; f32x4 ds0[8]; float lam0[4] = {0.f, 0.f, 0.f, 0.f};
#pragma unroll
                for (int i = 0; i < 8; ++i) ds0[i] = (f32x4){0.f, 0.f, 0.f, 0.f};
                bf16_t* Qo = (bf16_t*)(ws + WS_Q); bf16_t* LFo = (bf16_t*)(ws + WS_LF); bf16_t* DSp = (bf16_t*)(ws + WS_DS); float* LAMp = (float*)(ws + WS_LAM);
                const int ub = (bq * 8 + 2 * hp_) * 32 + c0;
                chunk_load(r, ub, Qp, Kp, Lp, Vp, tid);
                chunk_A1(lds, 0, r, tid);
                chunk_load(r, ub + 1, Qp, Kp, Lp, Vp, tid);
                LDS_BARRIER();
                chunk_A2(lds, 0, ub, 0, lam0, Qo, LAMp, wave, lane);
                LDS_BARRIER();
#pragma unroll 1
                for (int k = 0; k < 8; ++k) {
                    const int u = ub + (k >> 2) * 32 + (k & 3), s = k & 1;
                    const bool has_next = k < 7;
                    const int k1 = k < 7 ? k + 1 : 7, un = ub + (k1 >> 2) * 32 + (k1 & 3), k2 = k + 2 < 8 ? k + 2 : 7, u2 = ub + (k2 >> 2) * 32 + (k2 & 3);
                    if (has_next) { chunk_A1(lds, s ^ 1, r, tid); chunk_load(r, u2, Qp, Kp, Lp, Vp, tid); }
                    __builtin_amdgcn_sched_barrier(0);
                    chunk_B(lds, s, wave, lane);
                    LDS_BARRIER();
                    if (has_next) chunk_A2(lds, s ^ 1, un, k1 & 3, lam0, Qo, LAMp, wave, lane);
                    __builtin_amdgcn_sched_barrier(0);
                    chunk_C(lds, s, u, k & 3, ds0, LFo, DSp, wave, lane);
                    LDS_BARRIER();
                }
            }
        }
        SEAM(pb);
        if (IN(pb + 3)) {
            PHASE_LOCALS();
            for (int rep = 0; rep < NREP(10); ++rep) {
                bf16_t* qo = (bf16_t*)(ws + (DUMMY(10, rep) ? WS_DUM0 : WS_Q));
                const bf16_t* Qp = (const bf16_t*)(ws + WS_Q); const bf16_t* Op = (const bf16_t*)(ws + WS_LF); const bf16_t* Gp = (const bf16_t*)(ws + WS_G); const bf16_t* Sp = (const bf16_t*)(ws + WS_DS);
                const int vcu = (bx & 7) * (G >> 3) + (bx >> 3), qp = vcu & 7, bh0 = (vcu >> 5) * 8 + ((vcu >> 3) & 3), bh1 = bh0 + 4, qd0 = bh0 * 8 + qp, qd1 = bh1 * 8 + (7 - qp);
                InterIn cur; InterSc sc, sc1;
                quad_prefix(lds, sc, sc1, bh0, bh1, qp, Sp, (const float*)(ws + WS_LAM), ap->out + O_STP + (size_t)l * 64 * 16384, wave, lane, tid);
                inter_load(cur, 4 * qd0, Qp, Op, Gp, Sp, wave, lane, tid);
#pragma unroll 1
                for (int k = 0; k < 2; ++k) {
                    const int qd = k == 0 ? qd0 : qd1, qn = qd1;
#pragma unroll 1
                    for (int jj = 0; jj < 3; ++jj) {
                        InterIn nxt; SampleIn sin;
                        const int su = bx + G * (2 * k + (jj >> 1)), half = jj & 1;
                        inter_load(nxt, 4 * qd + jj + 1, Qp, Op, Gp, Sp, wave, lane, tid);
                        sample_load(sin, su, half, Qp, (const bf16_t*)(ws + WS_K), Op, (const bf16_t*)(ws + WS_V), Gp, ap->in[2] + ((size_t)l * 1024 + su) * 16384, tid);
                        inter_compute(lds, 4 * qd + jj, jj & 1, cur, sc, qo, wave, lane, tid);
                        sample_compute(lds + 112640, su, half, sin, (bf16_t*)(ws + WS_Q), ap->out + O_STS + ((size_t)l * 1024 + su) * 16384, tid);
                        cur = nxt;
                    }
                    InterIn nxt; SampleIn sin;
                    const int su = bx + G * (2 * k + 1);
                    inter_load(nxt, 4 * qn, Qp, Op, Gp, Sp, wave, lane, tid);
                    sample_load(sin, su, 1, Qp, (const bf16_t*)(ws + WS_K), Op, (const bf16_t*)(ws + WS_V), Gp, ap->in[2] + ((size_t)l * 1024 + su) * 16384, tid);
                    inter_compute(lds, 4 * qd + 3, 1, cur, sc, qo, wave, lane, tid);
                    sample_compute(lds + 112640, su, 1, sin, (bf16_t*)(ws + WS_Q), ap->out + O_STS + ((size_t)l * 1024 + su) * 16384, tid);
                    cur = nxt; sc = sc1;
                }
            }
        }
        SEAM(pb + 3);
        if (IN(pb + 4)) {
            PHASE_LOCALS();
            const bf16_t* Bt = (const bf16_t*)(ws + (l == 0 ? WS_WOUT0 : WS_WOUT1));
            pg8::Gemm g{(const bf16_t*)(ws + WS_Q), Bt, TP, 1024, 1024}; pg8::StaticOrder S; S.init(TP, 1024, G, bx);
            EpiResid E{ws};
            S_OUT((l == 0 ? WS_WOUT0 : WS_WOUT1), bx, G);
            pg8::gemm_phase<EpiResid, pg8::StaticOrder, PG8_ALIGN, PG8_SP2>(lds + RING_OFF, g, S, E, tid);
        }
        SEAM(pb + 4);
    }
#pragma unroll 1
    for (int j = 0; j < 2; ++j) {
        const int pb = 11 + 3 * j;
        if (IN(pb)) {
            PHASE_LOCALS();
            const int N = j == 0 ? 2304 : 2048;
            const bf16_t* Bt = (const bf16_t*)(ws + (j == 0 ? WS_WINB0 : WS_WINB1));
            const int vcu = (bx & 7) * (G >> 3) + (bx >> 3);
            pg8::Gemm g{(const bf16_t*)(ws + WS_HB), Bt, TP, N, 1024}; pg8::PmOrder S; S.pm = vcu >> 2; S.q = vcu & 3; S.nN = N >> 8;
            EpiSwaIn E{ws, ap->out, (const LAS float*)(lds + RSTD_OFF), (const LAS float*)(lds + ROPEL_OFF)};
            stage_row_tables(ws, S.pm, lds, true, tid);
            if (j == 0) {
                const int rank = S.q < 2 ? -1 : (S.pm * 2 + S.q - 2), nr = G >> 1;
                if (rank >= 0) for (int u = rank; u < N / 16; u += nr) sgemm_unit<64, 32>(lds, g.A + (size_t)TP * DM, Bt, u, E, wave, lane, tid);
                pg8::gemm_phase<EpiSwaIn, pg8::PmOrder, PG8_ALIGN, PG8_SP2, true>(lds + RING_OFF, g, S, E, tid);
            } else {
                for (int u = bx; u < N / 8; u += G) sgemm_unit<32, 32>(lds, g.A + (size_t)TP * DM, Bt, u, E, wave, lane, tid);
                pg8::gemm_phase<EpiSwaIn, pg8::PmOrder, PG8_ALIGN, PG8_SP2, false>(lds + RING_OFF, g, S, E, tid);
            }
        }
        SEAM(pb);
        if (IN(pb + 1)) {
            PHASE_LOCALS();
            const float* sinks = ap->in[14] + j * 16;
            for (int rep = 0; rep < NREP(6); ++rep) {
            bf16_t* qo = (bf16_t*)(ws + (DUMMY(6, rep) ? WS_DUM0 : WS_Q));
            for (int u = (bx & 7) * (G >> 3) + (bx >> 3); u < 256; u += G) swa_prompt_unit(lds, u, (const bf16_t*)(ws + WS_Q), qo,
            (const bf16_t*)(ws + WS_G), (const bf16_t*)(ws + WS_KA), (const bf16_t*)(ws + WS_VA), sinks, wave, lane, tid);
            }
            S_ATTN(j);
        }
        SEAM(pb + 1);
        if (IN(pb + 2)) {
            PHASE_LOCALS();
            const bf16_t* Bt = (const bf16_t*)(ws + (j == 0 ? WS_WOUTB0 : WS_WOUTB1));
            pg8::Gemm g{(const bf16_t*)(ws + WS_Q), Bt, TP, 1024, 1024}; pg8::StaticOrder S; S.init(TP, 1024, G, bx);
            EpiResid E{ws};
            S_OUT((j == 0 ? WS_WOUTB0 : WS_WOUTB1), bx, G);
            pg8::gemm_phase<EpiResid, pg8::StaticOrder, PG8_ALIGN, PG8_SP2>(lds + RING_OFF, g, S, E, tid);
        }
        SEAM(pb + 2);
    }
    if (IN(17)) {
        PHASE_LOCALS();
        const int gw = bx * NWAVES + wave, NGW = G * NWAVES;
        const f32x4* fn = (const f32x4*)ap->in[16] + lane;
        const float* SSQ = (const float*)(ws + WS_SSQ); const bf16_t* HBf = (const bf16_t*)(ws + WS_HB); float* outp = ap->out;
        f32x4 gn[4];
#pragma unroll
        for (int j = 0; j < 4; ++j) gn[j] = fn[64 * j];
        const int vcu = (bx & 7) * (G >> 3) + (bx >> 3), vw = vcu * NWAVES + wave;
        for (int rep = 0; rep < NREP(8); ++rep)
        for (int i = 0; i < 9; ++i) {
            const int m = i < 8 ? (vw >> 8) * SEQ + (vw & 255) + 256 * i : TP + vw;
            if (m >= TP + TS) break;
            const float rs = m < TP ? row_rstd(SSQ, m) : row_rstd_s((const float*)(ws + WS_SSQS), m - TP);
            const u32x2* hr = (const u32x2*)(HBf + (size_t)m * DM) + lane; f32x4* o = (f32x4*)(outp + (size_t)m * DM) + lane;
#pragma unroll
            for (int j = 0; j < 4; ++j) { const u32x2 hw = hr[64 * j]; __builtin_nontemporal_store((f32x4){bflo(hw.x), bfhi(hw.x), bflo(hw.y), bfhi(hw.y)} * rs * gn[j], &o[64 * j]); }
        }
    }
#undef S_IN_A
#undef S_OUT
#undef S_STEP
#undef S_ATTN
#undef IN
#undef SEAM
#undef PHASE_LOCALS
}

#ifndef MK_PER_PHASE
#define MK_PER_PHASE 0
#endif
extern "C" void kernel_launch(void* const* d_in, const int* in_sizes, int n_in, void* d_out, int out_size, void* d_ws, size_t ws_size, hipStream_t stream) {
    static int grid = 0;
    if (grid == 0) {
        if (n_in != 17 || ws_size < WS_END) { fprintf(stderr, "kernel_launch: unexpected inputs (n_in %d, ws %zu)\n", n_in, ws_size); grid = -1; return; }
        int dev = 0, cus = 0;
        if (hipGetDevice(&dev) != hipSuccess || hipDeviceGetAttribute(&cus, hipDeviceAttributeMultiprocessorCount, dev) != hipSuccess) { grid = -1; return; }
        if (hipFuncSetAttribute((const void*)yoco_fwd, hipFuncAttributeMaxDynamicSharedMemorySize, LDS_BYTES) != hipSuccess) { grid = -1; return; }
        (void)hipGetLastError();
        grid = cus;
    }
    if (grid < 0) return;
    (void)hipMemsetAsync((char*)d_ws + WS_CTL, 0, CTL_ZERO_BYTES, stream);
    Args a{};
    for (int i = 0; i < 17; ++i) a.in[i] = (const float*)d_in[i];
    a.out = (float*)d_out; a.ws = (unsigned char*)d_ws;
#if MK_PER_PHASE
    for (int p = 0; p < 18; ++p) { a.ph_lo = p; a.ph_hi = p + 1; hipLaunchKernelGGL(yoco_fwd, dim3(grid), dim3(NWAVES * 64), LDS_BYTES, stream, a); }
#else
    a.ph_lo = 0; a.ph_hi = 18;
    hipLaunchKernelGGL(yoco_fwd, dim3(grid), dim3(NWAVES * 64), LDS_BYTES, stream, a);
#endif
}
```

```cpp
#include <hip/hip_runtime.h>
#include <cstdio>
#include <cstdint>

#define LAS __attribute__((address_space(3)))
#define GAS __attribute__((address_space(1)))
typedef unsigned short bf16_t;
typedef short bf16x8 __attribute__((ext_vector_type(8)));
typedef short s16x4 __attribute__((ext_vector_type(4)));
typedef float f32x4 __attribute__((ext_vector_type(4)));
typedef float f32x2 __attribute__((ext_vector_type(2)));
typedef unsigned u32x4 __attribute__((ext_vector_type(4)));
typedef unsigned u32x2 __attribute__((ext_vector_type(2)));

constexpr int DM = 1024;
constexpr int TP = 16384;
constexpr int TS = 128;
constexpr int MT = 16640;
constexpr int SEQ = 2048;
constexpr float NORM_EPS = 1e-6f;
constexpr size_t O_YP = 0, O_YS = 16777216, O_STP = 16908288, O_STS = 19005440, O_KWP = 52559872, O_VWP = 52690944, O_KNS = 52822016, O_VNS = 52838400;
constexpr size_t MiB = 1u << 20;
constexpr size_t WS_CTL = 0, CTL_ZERO_BYTES = 65536;
constexpr size_t WS_LB1 = 1 * MiB, WS_ROPE = 1 * MiB + 8192, WS_SSQS = 1 * MiB + 262144;
constexpr size_t WS_WIN0 = 2 * MiB, WS_WIN1 = 10 * MiB, WS_WOUT0 = 18 * MiB, WS_WOUT1 = 20 * MiB, WS_WINB0 = 22 * MiB, WS_WINB1 = 27 * MiB, WS_WOUTB0 = 31 * MiB, WS_WOUTB1 = 33 * MiB;
constexpr size_t WS_SSQ = 35 * MiB, WS_HB = 37 * MiB, WS_H = 70 * MiB, WS_Q = 136 * MiB, WS_K = 169 * MiB, WS_V = 202 * MiB, WS_G = 235 * MiB, WS_LF = 268 * MiB;
constexpr size_t WS_DS = 334 * MiB, WS_LAM = 398 * MiB, WS_KA = 399 * MiB, WS_VA = 404 * MiB, WS_END = 409 * MiB;
constexpr int CW_BAR = 4096;
constexpr size_t WS_DUM0 = 409 * MiB, WS_DUM1 = 442 * MiB;
#ifndef DUP_MASK
#define DUP_MASK 0
#endif
#define NREP(id) (((DUP_MASK >> (id)) & 1) ? 2 : 1)
#define DUMMY(id, rep) (((DUP_MASK >> (id)) & 1) && (rep) == 0)

typedef float f32x2_t __attribute__((ext_vector_type(2))); typedef __bf16 bf16x2_t __attribute__((ext_vector_type(2)));
__device__ __forceinline__ unsigned pk2(float lo, float hi) { f32x2_t v = {lo, hi}; bf16x2_t b = __builtin_convertvector(v, bf16x2_t); return __builtin_bit_cast(unsigned, b); }
__device__ __forceinline__ unsigned f2bf(float f) { return pk2(f, f) & 0xffffu; }
__device__ __forceinline__ float bflo(unsigned w) { return __builtin_bit_cast(float, w << 16); }
__device__ __forceinline__ float bfhi(unsigned w) { return __builtin_bit_cast(float, w & 0xffff0000u); }
__device__ __forceinline__ float bf1(bf16_t b) { return __builtin_bit_cast(float, (unsigned)b << 16); }
__device__ __forceinline__ float fast_rcp(float x) { return __builtin_amdgcn_rcpf(x); }
__device__ __forceinline__ float silu_f(float u) { return u * fast_rcp(1.0f + __expf(-u)); }
__device__ __forceinline__ float wave_sum(float v) {
#pragma unroll
    for (int o = 1; o < 64; o <<= 1) v += __shfl_xor(v, o);
    return v;
}
__device__ __forceinline__ float wave_max(float v) {
#pragma unroll
    for (int o = 1; o < 64; o <<= 1) v = fmaxf(v, __shfl_xor(v, o));
    return v;
}
#define LDS_WAIT() asm volatile("s_waitcnt lgkmcnt(0)" ::: "memory")
#define VM_WAIT() asm volatile("s_waitcnt vmcnt(0)" ::: "memory")
#define MFMA16(a, b, c) __builtin_amdgcn_mfma_f32_16x16x32_bf16((a), (b), (c), 0, 0, 0)

namespace pg8 {
constexpr int BM = 256, BK = 64, HALF = 128, HTB = HALF * BK * 2, STAGE_BYTES = 8 * HTB, NXCD = 8, WGM = 8;
__host__ __device__ __forceinline__ int lds_byte(int r, int c) { const int st = (r >> 4) * 2 + (c >> 5), rr = r & 15, cc = c & 31, ob = rr * 64 + cc * 2; return st * 1024 + (ob ^ (((ob >> 9) & 1) << 5)); }
__host__ __device__ __forceinline__ void stage_rc(int b, int& R, int& C) { const int st = b / 1024, sb = b % 1024, swz = sb ^ (((sb >> 9) & 1) << 5); R = (st >> 1) * 16 + swz / 64; C = (st & 1) * 32 + (swz % 64) / 2; }
__host__ __device__ __forceinline__ int perm32(int rho) { const int n = rho >> 4, i = rho & 15; return 8 * (i >> 2) + 4 * n + (i & 3); }
struct Unit { int pm, pn, hs; };
struct Gemm { const bf16_t* A; const bf16_t* Bt; int M, N, K; };
struct StaticOrder {
    int nM, nN, nwg, G, c;
    __host__ __device__ void init(int M, int N, int G_, int c_) { nM = M / BM; nN = N / BM; nwg = nM * nN; G = G_; c = c_; }
    __host__ __device__ __forceinline__ bool next(int i, Unit& u) const {
        const long L = (long)i * G + c; if (L >= nwg) return false;
        int wgid = (int)L; { const int q = nwg / NXCD, r = nwg % NXCD, xcd = wgid % NXCD, off = wgid / NXCD; wgid = (xcd < r ? xcd * (q + 1) : r * (q + 1) + (xcd - r) * q) + off; }
        const int nig = WGM * nN, gid = wgid / nig, fm = gid * WGM, gsz = (nM - fm) < WGM ? (nM - fm) : WGM;
        u.pm = fm + ((wgid % nig) % gsz); u.pn = (wgid % nig) / gsz; u.hs = 0; return true;
    }
    __device__ __forceinline__ void a_ready(const Unit&) const {}
    __device__ __forceinline__ void done(const Unit&) const {}
};
struct HeadPairOrder {
    int pm, hp, nu, rot;
    __device__ __forceinline__ bool next(int i, Unit& u) const { if (i >= nu) return false; u.pm = pm; u.pn = hp + 4 * ((i + rot) & 3); u.hs = 0; return true; }
    __device__ __forceinline__ void a_ready(const Unit&) const {}
    __device__ __forceinline__ void done(const Unit&) const {}
};
struct PmOrder {
    int pm, q, nN;
    __device__ __forceinline__ bool next(int i, Unit& u) const {
        u.pm = pm; u.hs = 0;
        if (i < 2) { u.pn = q + 4 * i; return true; }
        if (i == 2 && nN == 9 && q < 2) { u.pn = 8; u.hs = q + 1; return true; }
        return false; }
    __device__ __forceinline__ void a_ready(const Unit&) const {}
    __device__ __forceinline__ void done(const Unit&) const {}
};
template <class Epi, class Sched, bool ALIGN_EPI = false, bool SP2 = false, bool HALFN = false>
__device__ __forceinline__ void gemm_phase(LAS unsigned char* lds, const Gemm g, const Sched& S, const Epi& E, const int tid) {
    const int wid = __builtin_amdgcn_readfirstlane(tid >> 6), lane = tid & 63, wr = wid >> 2, wc = wid & 3, fr = lane & 15, fq = lane >> 4;
    const int K = g.K, nt = K / BK;
    unsigned voffA[2], voffB[2];
#pragma unroll
    for (int i = 0; i < 2; ++i) { int R, C; stage_rc(tid * 16 + i * 8192, R, C); const int Rb = Epi::PERM ? ((R & ~31) + perm32(R & 31)) : R;
        voffA[i] = (unsigned)(R * K + C) * 2u; voffB[i] = (unsigned)(Rb * K + C) * 2u; }
    const size_t kstep = (size_t)(BK * 2);
    const size_t hstep = (size_t)HALF * K * 2;
    const size_t tstep = 2 * hstep;
    const unsigned ldsw = (unsigned)wid * 1024u;
    const int aoff = lds_byte(wr * 64 + fr, fq * 8), boff = lds_byte(wc * 32 + fr, fq * 8);
#define PG8_SA(b, h) (((b) * 2 + (h)) * HTB)
#define PG8_SB(b, h) ((4 + (b) * 2 + (h)) * HTB)
#define PG8_STAGE(bufoff, gbase, voff) do { _Pragma("unroll") for (int _i = 0; _i < 2; ++_i) \
        __builtin_amdgcn_global_load_lds((const unsigned*)((const char*)(gbase) + (voff)[_i]), (LAS unsigned*)(lds + (bufoff) + ldsw + _i * 8192), 16, 0, 0); } while (0)
#define PG8_LDA(dst, b, h) do { _Pragma("unroll") for (int m = 0; m < 4; ++m) _Pragma("unroll") for (int k = 0; k < 2; ++k) dst[m][k] = *(const LAS bf16x8*)(lds + PG8_SA(b, h) + aoff + m * 2048 + k * 1024); } while (0)
#define PG8_LDB(dst, b, h) do { _Pragma("unroll") for (int n = 0; n < 2; ++n) _Pragma("unroll") for (int k = 0; k < 2; ++k) dst[n][k] = *(const LAS bf16x8*)(lds + PG8_SB(b, h) + boff + n * 2048 + k * 1024); } while (0)
#define PG8_MMA(ai, bj, At, Bt) do { __builtin_amdgcn_s_setprio(1); _Pragma("unroll") for (int m = 0; m < 4; ++m) _Pragma("unroll") for (int n = 0; n < 2; ++n) _Pragma("unroll") for (int k = 0; k < 2; ++k) \
        acc[ai][bj][m][n] = __builtin_amdgcn_mfma_f32_16x16x32_bf16(Bt[n][k], At[m][k], acc[ai][bj][m][n], 0, 0, 0); __builtin_amdgcn_s_setprio(0); } while (0)
#define PG8_MMA2(ai) do { if constexpr (HALFN) { if (cur.hs != 2) PG8_MMA(ai, 0, At, B0); if (cur.hs != 1) PG8_MMA(ai, 1, At, B1); } else { PG8_MMA(ai, 0, At, B0); PG8_MMA(ai, 1, At, B1); } } while (0)
#define PG8_WAIT_V(n) asm volatile("s_waitcnt vmcnt(" #n ")" ::: "memory")
#define PG8_WAIT_L(n) asm volatile("s_waitcnt lgkmcnt(" #n ")" ::: "memory")
#define PG8_BAR __builtin_amdgcn_s_barrier()
#define PG8_SCHED __builtin_amdgcn_sched_barrier(0)
    Unit cur, nxt; int ui = 0;
    if (!S.next(0, cur)) return;
    f32x4 acc[2][2][4][2];
#pragma unroll
    for (int a = 0; a < 2; ++a)
#pragma unroll
        for (int b = 0; b < 2; ++b)
#pragma unroll
            for (int m = 0; m < 4; ++m)
#pragma unroll
                for (int n = 0; n < 2; ++n) acc[a][b][m][n] = (f32x4){0.f, 0.f, 0.f, 0.f};
    bf16x8 At[4][2], B0[2][2], B1[2][2];
    const char* cA = (const char*)g.A + (size_t)cur.pm * tstep; const char* cB = (const char*)g.Bt + (size_t)cur.pn * tstep;
    S.a_ready(cur);
    if constexpr (SP2) {
        PG8_STAGE(PG8_SB(0, 0), cB, voffB); PG8_STAGE(PG8_SB(0, 1), cB + hstep, voffB); PG8_STAGE(PG8_SA(0, 0), cA, voffA); PG8_STAGE(PG8_SA(0, 1), cA + hstep, voffA);
        if (wr == 1) PG8_BAR;
        PG8_WAIT_V(2); PG8_BAR;
        PG8_STAGE(PG8_SB(1, 0), cB + kstep, voffB); PG8_STAGE(PG8_SA(1, 0), cA + kstep, voffA); PG8_STAGE(PG8_SB(1, 1), cB + hstep + kstep, voffB);
        PG8_WAIT_V(6); PG8_BAR;
    } else {
        PG8_STAGE(PG8_SB(0, 0), cB, voffB); PG8_STAGE(PG8_SA(0, 0), cA, voffA); PG8_STAGE(PG8_SB(0, 1), cB + hstep, voffB); PG8_STAGE(PG8_SA(0, 1), cA + hstep, voffA);
        if (wr == 1) PG8_BAR;
        PG8_WAIT_V(4); PG8_BAR;
        PG8_STAGE(PG8_SB(1, 0), cB + kstep, voffB); PG8_STAGE(PG8_SA(1, 0), cA + kstep, voffA); PG8_STAGE(PG8_SB(1, 1), cB + hstep + kstep, voffB);
        PG8_WAIT_V(6); PG8_BAR;
    }
    for (;;) {
        const bool has_next = S.next(ui + 1, nxt);
        const char* nA = has_next ? (const char*)g.A + (size_t)nxt.pm * tstep : cA; const char* nB = has_next ? (const char*)g.Bt + (size_t)nxt.pn * tstep : cB;
        for (int t = 0; t < nt; t += 2) {
            const bool last = (t == nt - 2);
            const char* a1 = cA + (size_t)(t + 1) * kstep;
            const char* a2 = last ? nA : cA + (size_t)(t + 2) * kstep; const char* b2 = last ? nB : cB + (size_t)(t + 2) * kstep;
            const char* a3 = a2 + kstep; const char* b3 = b2 + kstep;
            if (last && has_next) S.a_ready(nxt);
            if constexpr (SP2) {
            PG8_LDB(B0, 0, 0); PG8_LDB(B1, 0, 1); PG8_SCHED; PG8_LDA(At, 0, 0); PG8_STAGE(PG8_SA(1, 1), a1 + hstep, voffA);
            PG8_WAIT_V(8); PG8_WAIT_L(0); PG8_BAR; PG8_MMA2(0); PG8_BAR; PG8_SCHED;
            PG8_LDA(At, 0, 1); PG8_STAGE(PG8_SB(0, 0), b2, voffB); PG8_STAGE(PG8_SB(0, 1), b2 + hstep, voffB); PG8_STAGE(PG8_SA(0, 0), a2, voffA);
            PG8_WAIT_V(8); PG8_WAIT_L(0); PG8_BAR; PG8_MMA2(1); PG8_BAR; PG8_SCHED;
            PG8_LDB(B0, 1, 0); PG8_LDB(B1, 1, 1); PG8_SCHED; PG8_LDA(At, 1, 0); PG8_STAGE(PG8_SA(0, 1), a2 + hstep, voffA);
            PG8_WAIT_V(8); PG8_WAIT_L(0); PG8_BAR; PG8_MMA2(0); PG8_BAR; PG8_SCHED;
            PG8_LDA(At, 1, 1); PG8_STAGE(PG8_SB(1, 0), b3, voffB); PG8_STAGE(PG8_SB(1, 1), b3 + hstep, voffB); PG8_STAGE(PG8_SA(1, 0), a3, voffA);
            PG8_WAIT_V(8); PG8_WAIT_L(0); PG8_BAR; PG8_MMA2(1); PG8_BAR; PG8_SCHED;
            } else {
            PG8_LDB(B0, 0, 0); PG8_SCHED; PG8_LDA(At, 0, 0); PG8_STAGE(PG8_SA(1, 1), a1 + hstep, voffA);
            PG8_WAIT_L(8); PG8_BAR; PG8_WAIT_L(0); PG8_MMA(0, 0, At, B0); PG8_BAR; PG8_SCHED;
            PG8_LDB(B1, 0, 1); PG8_STAGE(PG8_SB(0, 0), b2, voffB);
            PG8_BAR; PG8_WAIT_L(0); PG8_MMA(0, 1, At, B1); PG8_BAR;
            PG8_LDA(At, 0, 1); PG8_STAGE(PG8_SA(0, 0), a2, voffA);
            PG8_BAR; PG8_WAIT_L(0); PG8_MMA(1, 0, At, B0); PG8_BAR; PG8_SCHED;
            PG8_STAGE(PG8_SB(0, 1), b2 + hstep, voffB);
            PG8_WAIT_V(6); PG8_BAR; PG8_MMA(1, 1, At, B1); PG8_BAR;
            PG8_LDB(B0, 1, 0); PG8_SCHED; PG8_LDA(At, 1, 0); PG8_STAGE(PG8_SA(0, 1), a2 + hstep, voffA);
            PG8_WAIT_L(8); PG8_BAR; PG8_WAIT_L(0); PG8_MMA(0, 0, At, B0); PG8_BAR; PG8_SCHED;
            PG8_LDB(B1, 1, 1); PG8_STAGE(PG8_SB(1, 0), b3, voffB);
            PG8_BAR; PG8_WAIT_L(0); PG8_MMA(0, 1, At, B1); PG8_BAR;
            PG8_LDA(At, 1, 1); PG8_STAGE(PG8_SA(1, 0), a3, voffA);
            PG8_BAR; PG8_WAIT_L(0); PG8_MMA(1, 0, At, B0); PG8_BAR; PG8_SCHED;
            PG8_STAGE(PG8_SB(1, 1), b3 + hstep, voffB);
            PG8_WAIT_V(6); PG8_BAR; PG8_MMA(1, 1, At, B1); PG8_BAR;
            }
        }
        if constexpr (ALIGN_EPI) { if (wr == 0) PG8_BAR; }
        E(acc, cur, wr, wc, fr, fq);
        if (!has_next) break;
#pragma unroll
        for (int a = 0; a < 2; ++a)
#pragma unroll
            for (int b = 0; b < 2; ++b)
#pragma unroll
                for (int m = 0; m < 4; ++m)
#pragma unroll
                    for (int n = 0; n < 2; ++n) acc[a][b][m][n] = (f32x4){0.f, 0.f, 0.f, 0.f};
        cur = nxt; cA = nA; cB = nB; ++ui;
        if constexpr (ALIGN_EPI) { if (wr == 1) PG8_BAR; }
    }
    PG8_WAIT_V(0);
    if constexpr (!ALIGN_EPI) { if (wr == 0) PG8_BAR; }
    PG8_BAR;
#undef PG8_SA
#undef PG8_SB
#undef PG8_STAGE
#undef PG8_LDA
#undef PG8_LDB
#undef PG8_MMA
#undef PG8_MMA2
#undef PG8_WAIT_V
#undef PG8_WAIT_L
#undef PG8_BAR
#undef PG8_SCHED
}
}
#ifndef PG8_SP2
#define PG8_SP2 true
#endif
#ifndef PG8_ALIGN
#define PG8_ALIGN true
#endif

__device__ __forceinline__ float row_rstd(const float* ssq, int row) {
    const f32x4* p = (const f32x4*)(ssq + (size_t)row * 16);
    const f32x4 a = p[0], b = p[1], c = p[2], d = p[3];
    const float s = ((a.x + a.y) + (a.z + a.w)) + ((b.x + b.y) + (b.z + b.w)) + ((c.x + c.y) + (c.z + c.w)) + ((d.x + d.y) + (d.z + d.w));
    return rsqrtf(s * (1.0f / DM) + NORM_EPS);
}
__device__ __forceinline__ float row_rstd_s(const float* ssqs, int n) {
    const f32x4* p = (const f32x4*)(ssqs + (size_t)n * 64); float s = 0.f;
#pragma unroll
    for (int i = 0; i < 16; ++i) { const f32x4 a = p[i]; s += (a.x + a.y) + (a.z + a.w); }
    return rsqrtf(s * (1.0f / DM) + NORM_EPS);
}
struct SsqQ { f32x4 s[4]; };
__device__ __forceinline__ SsqQ ssqs_quarter(const float* ssqs, int n, int fq) { SsqQ r; const f32x4* p = (const f32x4*)(ssqs + (size_t)n * 64 + 16 * fq);
#pragma unroll
    for (int i = 0; i < 4; ++i) r.s[i] = p[i];
    return r; }
__device__ __forceinline__ float ssqs_rstd(const SsqQ& r) {
    float s = 0.f;
#pragma unroll
    for (int i = 0; i < 4; ++i) s += (r.s[i].x + r.s[i].y) + (r.s[i].z + r.s[i].w);
    s += __shfl_xor(s, 16); s += __shfl_xor(s, 32);
    return rsqrtf(s * (1.0f / DM) + NORM_EPS);
}
__device__ __forceinline__ u32x4 pack8(const float (&v)[8]) { u32x4 w; w.x = pk2(v[0], v[1]); w.y = pk2(v[2], v[3]); w.z = pk2(v[4], v[5]); w.w = pk2(v[6], v[7]); return w; }

struct EpiHgrnIn {
    static constexpr bool PERM = true;
    unsigned char* ws; int layer; const LAS float* rstd_lds;
#define EHI_PTRS const float* ssq = (const float*)(ws + WS_SSQ); bf16_t* Q = (bf16_t*)(ws + WS_Q); bf16_t* Kb = (bf16_t*)(ws + WS_K); bf16_t* LF = (bf16_t*)(ws + WS_LF); bf16_t* V = (bf16_t*)(ws + WS_V); bf16_t* G = (bf16_t*)(ws + WS_G); \
    const float* lb = layer == 0 ? (const float*)nullptr : (const float*)(ws + WS_LB1); const float* ssqs = (const float*)(ws + WS_SSQS); (void)ssq; (void)Q; (void)Kb; (void)LF; (void)V; (void)G; (void)lb; (void)ssqs
    struct Pre { SsqQ q; f32x4 l4; };
    __device__ __forceinline__ Pre sample_pre(int row, int col, int fq) const {
        EHI_PTRS; Pre p; p.q = ssqs_quarter(ssqs, row - TP, fq); p.l4 = (f32x4){0.f, 0.f, 0.f, 0.f};
        if ((col >> 10) == 1 && lb) p.l4 = *(const f32x4*)(lb + (col & 1023));
        return p; }
    __device__ __forceinline__ void sample(const f32x4 a, int row, int col, int u, int fq, const Pre& pre) const {
        EHI_PTRS;
        const float rs = ssqs_rstd(pre.q); const int sec = col >> 10, ch = col & 1023; const size_t idx = (size_t)row * DM + ch;
        float v[4] = {a[0] * rs, a[1] * rs, a[2] * rs, a[3] * rs};
        if (sec == 0) {
#pragma unroll
            for (int j = 0; j < 4; ++j) v[j] = silu_f(v[j]);
            u32x2 w; w.x = pk2(v[0], v[1]); w.y = pk2(v[2], v[3]); *(u32x2*)(Q + idx) = w;
        } else if (sec == 1) {
            const f32x4 l4 = pre.l4;
            float lf[4];
#pragma unroll
            for (int j = 0; j < 4; ++j) { const float e = __expf(-v[j]); const float s = fast_rcp(1.0f + e); lf[j] = __logf(l4[j] + (1.0f - l4[j]) * s); }
            { u32x2 wl; wl.x = pk2(lf[0], lf[1]); wl.y = pk2(lf[2], lf[3]); *(u32x2*)(LF + idx) = wl; }
        } else if (sec == 2) {
            u32x2 w; w.x = pk2(v[0], v[1]); w.y = pk2(v[2], v[3]); *(u32x2*)(V + idx) = w;
        } else {
#pragma unroll
            for (int j = 0; j < 4; ++j) v[j] = silu_f(v[j]);
            u32x2 w; w.x = pk2(v[0], v[1]); w.y = pk2(v[2], v[3]); *(u32x2*)(G + idx) = w;
        }
    }
    __device__ __forceinline__ void operator()(const f32x4 (&acc)[2][2][4][2], const pg8::Unit& u, int wr, int wc, int fr_, int fq_) const {
        int fr = fr_, fq = fq_; asm volatile("" : "+v"(fr), "+v"(fq));
        EHI_PTRS;
        const int sec = u.pn >> 2;
        const int colb = (u.pn & 3) * 256 + wc * 32 + 8 * fq;
        float lbu[2][8];
#pragma unroll
        for (int bj = 0; bj < 2; ++bj) {
            if (sec == 1 && lb) { const f32x4 l0 = *(const f32x4*)(lb + colb + bj * 128), l1 = *(const f32x4*)(lb + colb + bj * 128 + 4); lbu[bj][0] = l0.x; lbu[bj][1] = l0.y; lbu[bj][2] = l0.z; lbu[bj][3] = l0.w; lbu[bj][4] = l1.x; lbu[bj][5] = l1.y; lbu[bj][6] = l1.z; lbu[bj][7] = l1.w; }
            else {
#pragma unroll
                for (int j = 0; j < 8; ++j) lbu[bj][j] = 0.f; }
        }
#pragma unroll
        for (int ai = 0; ai < 2; ++ai)
#pragma unroll
            for (int m = 0; m < 4; ++m) {
                const int row = u.pm * 256 + ai * 128 + wr * 64 + m * 16 + fr;
                const float rs = rstd_lds[ai * 128 + wr * 64 + m * 16 + fr];
#pragma unroll
                for (int bj = 0; bj < 2; ++bj) {
                    const int col = colb + bj * 128; const size_t idx = (size_t)row * DM + col;
                    float v[8];
#pragma unroll
                    for (int j = 0; j < 4; ++j) { v[j] = acc[ai][bj][m][0][j] * rs; v[4 + j] = acc[ai][bj][m][1][j] * rs; }
                    if (sec == 0) {
#pragma unroll
                        for (int j = 0; j < 8; ++j) v[j] = silu_f(v[j]);
                        *(u32x4*)(Q + idx) = pack8(v);
                    } else if (sec == 1) {
                        float lbv[8];
#pragma unroll
                        for (int j = 0; j < 8; ++j) lbv[j] = lbu[bj][j];
                        float lf[8];
#pragma unroll
                        for (int j = 0; j < 8; ++j) { const float e = __expf(-v[j]); const float s = fast_rcp(1.0f + e); lf[j] = __logf(lbv[j] + (1.0f - lbv[j]) * s); }
                        *(u32x4*)(LF + idx) = pack8(lf);
                    } else if (sec == 2) {
                        *(u32x4*)(V + idx) = pack8(v);
                    } else {
#pragma unroll
                        for (int j = 0; j < 8; ++j) v[j] = silu_f(v[j]);
                        *(u32x4*)(G + idx) = pack8(v);
                    }
                }
            }
    }
};

struct EpiResid {
    static constexpr bool PERM = true;
    unsigned char* ws;
#define ERS_PTRS const bf16_t* Hold = (const bf16_t*)(ws + WS_HB); bf16_t* HB = (bf16_t*)(ws + WS_HB); float* ssq = (float*)(ws + WS_SSQ); float* ssqs = (float*)(ws + WS_SSQS); (void)ssq; (void)ssqs
    struct Pre { u32x2 hw; };
    __device__ __forceinline__ Pre sample_pre(int row, int col, int fq) const { ERS_PTRS; Pre p; p.hw = *(const u32x2*)(Hold + (size_t)row * DM + col); return p; }
    __device__ __forceinline__ void sample(const f32x4 a, int row, int col, int u, int fq, const Pre& pre) const {
        ERS_PTRS;
        const size_t idx = (size_t)row * DM + col;
        const u32x2 hw = pre.hw;
        f32x4 o = {bflo(hw.x), bfhi(hw.x), bflo(hw.y), bfhi(hw.y)}; o += a;
        u32x2 w; w.x = pk2(o.x, o.y); w.y = pk2(o.z, o.w); *(u32x2*)(HB + idx) = w;
        float part = (o.x * o.x + o.y * o.y) + (o.z * o.z + o.w * o.w);
        part += __shfl_xor(part, 16); part += __shfl_xor(part, 32);
        if (fq == 0) ssqs[(size_t)(row - TP) * 64 + u] = part;
    }
    __device__ __forceinline__ void operator()(const f32x4 (&acc)[2][2][4][2], const pg8::Unit& u, int wr, int wc, int fr_, int fq_) const {
        int fr = fr_, fq = fq_; asm volatile("" : "+v"(fr), "+v"(fq));
        ERS_PTRS;
        const int col0 = u.pn * 256 + wc * 32 + 8 * fq;
#pragma unroll
        for (int ai = 0; ai < 2; ++ai) {
        u32x4 hpre[4][2];
#pragma unroll
            for (int m = 0; m < 4; ++m)
#pragma unroll
                for (int bj = 0; bj < 2; ++bj) hpre[m][bj] = *(const u32x4*)(Hold + (size_t)(u.pm * 256 + ai * 128 + wr * 64 + m * 16 + fr) * DM + col0 + bj * 128);
        __builtin_amdgcn_sched_barrier(0);
#pragma unroll
            for (int m = 0; m < 4; ++m) {
                const int row = u.pm * 256 + ai * 128 + wr * 64 + m * 16 + fr;
                float part = 0.f;
#pragma unroll
                for (int bj = 0; bj < 2; ++bj) {
                    const int col = col0 + bj * 128; const size_t idx = (size_t)row * DM + col;
                    const u32x4 hw = hpre[m][bj];
                    f32x4 o0 = {bflo(hw.x), bfhi(hw.x), bflo(hw.y), bfhi(hw.y)}, o1 = {bflo(hw.z), bfhi(hw.z), bflo(hw.w), bfhi(hw.w)};
                    o0 += acc[ai][bj][m][0]; o1 += acc[ai][bj][m][1];
                    u32x4 w; w.x = pk2(o0.x, o0.y); w.y = pk2(o0.z, o0.w); w.z = pk2(o1.x, o1.y); w.w = pk2(o1.z, o1.w);
                    *(u32x4*)(HB + idx) = w;
                    part += (o0.x * o0.x + o0.y * o0.y) + (o0.z * o0.z + o0.w * o0.w) + (o1.x * o1.x + o1.y * o1.y) + (o1.z * o1.z + o1.w * o1.w);
                }
                part += __shfl_xor(part, 16); part += __shfl_xor(part, 32);
                if (fq == 0) ssq[(size_t)row * 16 + u.pn * 4 + wc] = part;
            }
        }
    }
};

struct EpiSwaIn {
    static constexpr bool PERM = true;
    unsigned char* ws; float* out; const LAS float* rstd_lds; const LAS float* rope_lds;
#define ESI_PTRS const float* ssq = (const float*)(ws + WS_SSQ); const float* rope = (const float*)(ws + WS_ROPE); bf16_t* QA = (bf16_t*)(ws + WS_Q); bf16_t* GA = (bf16_t*)(ws + WS_G); bf16_t* KA = (bf16_t*)(ws + WS_KA); bf16_t* VA = (bf16_t*)(ws + WS_VA); \
    const float* ssqs = (const float*)(ws + WS_SSQS); (void)ssq; (void)rope; (void)QA; (void)GA; (void)KA; (void)VA; (void)ssqs
    struct Pre { SsqQ q; f32x4 c4, s4; };
    __device__ __forceinline__ Pre sample_pre(int row, int col, int fq) const {
        ESI_PTRS; Pre p; p.q = ssqs_quarter(ssqs, row - TP, fq);
        const float* rp = rope + (size_t)SEQ * 16 + ((4 * fq) & 7); p.c4 = *(const f32x4*)rp; p.s4 = *(const f32x4*)(rp + 8);
        return p; }
    __device__ __forceinline__ void sample(const f32x4 a, int row, int col, int u, int fq, const Pre& pre) const {
        ESI_PTRS;
        const float rs = ssqs_rstd(pre.q);
        float v[4] = {a[0] * rs, a[1] * rs, a[2] * rs, a[3] * rs};
        const int sec = col < 1024 ? 0 : col < 2048 ? 1 : col < 2176 ? 2 : 3;
        if ((sec == 0 || sec == 2) && ((16 * u) & 63) == 0) {
#pragma unroll
            for (int r = 0; r < 4; ++r) { const float pr = __shfl_xor(v[r], 32); const float c = pre.c4[r], s = pre.s4[r];
                v[r] = fq < 2 ? v[r] * c - pr * s : v[r] * c + pr * s; }
        }
        if (sec == 0) {
#pragma unroll
            for (int j = 0; j < 4; ++j) v[j] *= 0.18033688011112042f;
            u32x2 w; w.x = pk2(v[0], v[1]); w.y = pk2(v[2], v[3]); *(u32x2*)(QA + (size_t)row * DM + col) = w;
        } else if (sec == 1) {
#pragma unroll
            for (int j = 0; j < 4; ++j) v[j] = silu_f(v[j]);
            u32x2 w; w.x = pk2(v[0], v[1]); w.y = pk2(v[2], v[3]); *(u32x2*)(GA + (size_t)row * DM + (col - 1024)) = w;
        } else {
            const int kc = sec == 2 ? col - 2048 : col - 2176;
            u32x2 w; w.x = pk2(v[0], v[1]); w.y = pk2(v[2], v[3]); *(u32x2*)((sec == 2 ? KA : VA) + (size_t)row * 128 + kc) = w;
            *(f32x4*)(out + (sec == 2 ? O_KNS : O_VNS) + (size_t)(row - TP) * 128 + kc) = (f32x4){v[0], v[1], v[2], v[3]};
        }
    }
    __device__ __forceinline__ void operator()(const f32x4 (&acc)[2][2][4][2], const pg8::Unit& u, int wr, int wc, int fr_, int fq_) const {
        int fr = fr_, fq = fq_; asm volatile("" : "+v"(fr), "+v"(fq));
        ESI_PTRS;
        const int sec = u.pn >> 2;
        const int colb = (u.pn & 3) * 256 + wc * 32 + 8 * fq;
        const bool rot_wave = (wc & 1) == 0;
#pragma unroll
        for (int ai = 0; ai < 2; ++ai)
#pragma unroll
            for (int m = 0; m < 4; ++m) {
                const int row = u.pm * 256 + ai * 128 + wr * 64 + m * 16 + fr;
                const int rl = ai * 128 + wr * 64 + m * 16 + fr;
                const float rs = rstd_lds[rl];
                float cs[8], sn[8];
                if (sec != 1 && rot_wave) {
                    const LAS f32x4* rp = (const LAS f32x4*)(rope_lds + rl * 16);
                    const f32x4 c0 = rp[0], c1 = rp[1], s0 = rp[2], s1 = rp[3];
                    cs[0] = c0.x; cs[1] = c0.y; cs[2] = c0.z; cs[3] = c0.w; cs[4] = c1.x; cs[5] = c1.y; cs[6] = c1.z; cs[7] = c1.w;
                    sn[0] = s0.x; sn[1] = s0.y; sn[2] = s0.z; sn[3] = s0.w; sn[4] = s1.x; sn[5] = s1.y; sn[6] = s1.z; sn[7] = s1.w;
                }
#pragma unroll
                for (int bj = 0; bj < 2; ++bj) {
                    if (u.hs != 0 && bj != u.hs - 1) continue;
                    float v[8];
#pragma unroll
                    for (int j = 0; j < 4; ++j) { v[j] = acc[ai][bj][m][0][j] * rs; v[4 + j] = acc[ai][bj][m][1][j] * rs; }
                    if (sec == 0) {
                        const int col = colb + bj * 128; const size_t idx = (size_t)row * DM + col;
                        if (rot_wave) {
                            float pr[8];
#pragma unroll
                            for (int j = 0; j < 8; ++j) pr[j] = __shfl_xor(v[j], 16);
                            if (fq < 2) { const float sg = fq == 0 ? -1.0f : 1.0f;
#pragma unroll
                                for (int j = 0; j < 8; ++j) v[j] = v[j] * cs[j] + sg * pr[j] * sn[j]; }
                        }
#pragma unroll
                        for (int j = 0; j < 8; ++j) v[j] *= 0.18033688011112042f;
                        *(u32x4*)(QA + idx) = pack8(v);
                    } else if (sec == 1) {
                        const int col = colb + bj * 128; const size_t idx = (size_t)row * DM + col;
#pragma unroll
                        for (int j = 0; j < 8; ++j) v[j] = silu_f(v[j]);
                        *(u32x4*)(GA + idx) = pack8(v);
                    } else {
                        const int kc = wc * 32 + 8 * fq;
                        const size_t idx = (size_t)row * 128 + kc;
                        if (bj == 0 && rot_wave) {
                            float pr[8];
#pragma unroll
                            for (int j = 0; j < 8; ++j) pr[j] = __shfl_xor(v[j], 16);
                            if (fq < 2) { const float sg = fq == 0 ? -1.0f : 1.0f;
#pragma unroll
                                for (int j = 0; j < 8; ++j) v[j] = v[j] * cs[j] + sg * pr[j] * sn[j]; }
                        }
                        *(u32x4*)((bj == 0 ? KA : VA) + idx) = pack8(v);
                        float* dst = nullptr;
                        if (row < TP) { const int t = row & (SEQ - 1); if (t >= SEQ - 128) dst = out + (bj == 0 ? O_KWP : O_VWP) + ((size_t)((row >> 11) * 128 + (t - (SEQ - 128))) * 128 + kc); }
                        else if (row < TP + TS) dst = out + (bj == 0 ? O_KNS : O_VNS) + ((size_t)(row - TP) * 128 + kc);
                        if (dst) { *(f32x4*)dst = (f32x4){v[0], v[1], v[2], v[3]}; *(f32x4*)(dst + 4) = (f32x4){v[4], v[5], v[6], v[7]}; }
                    }
                }
            }
    }
};

#define LDS_BARRIER() asm volatile("s_waitcnt lgkmcnt(0)\n\ts_barrier" ::: "memory")
template <int ROWS, int COLS, class Epi>
__device__ __forceinline__ void sgemm_unit(LAS unsigned char* lds, const bf16_t* HBs, const bf16_t* Bt, int u, const Epi& E, int wave, int lane, const int tid) {
    constexpr int KC = 256, NCH = 1024 / KC;
    constexpr int XP = KC * 2 + 16, XBUF = (ROWS + COLS) * XP;
    constexpr int NLX = ROWS / 16, NLW = (COLS * 32 + 511) / 512;
    constexpr int NRG = 128 / ROWS;
    const int cgu = u / NRG, row0 = ROWS * (u % NRG), col0 = COLS * cgu;
    const int fr = lane & 15, fq = lane >> 4;
    const int rt = COLS == 16 ? wave : (wave & 3), ct = COLS == 16 ? 0 : (wave >> 2);
    const int lr = tid >> 5, lc = tid & 31;
    const bool wl = COLS * 32 >= 512 || tid < COLS * 32;
    const bf16_t* xa = HBs + (size_t)(row0 + lr) * DM + lc * 8;
    const bf16_t* wa = Bt + (size_t)(col0 + (lr & (COLS - 1))) * DM + lc * 8;
    u32x4 xr[NCH][NLX], wv[NCH][NLW];
#pragma unroll
    for (int c = 0; c < NCH; ++c) {
#pragma unroll
        for (int i = 0; i < NLX; ++i) xr[c][i] = *(const u32x4*)(xa + (size_t)16 * i * DM + KC * c);
#pragma unroll
        for (int i = 0; i < NLW; ++i) { if (wl) wv[c][i] = *(const u32x4*)(wa + (size_t)16 * i * DM + KC * c); }
    }
    const int srow = TP + row0 + 16 * rt + fr, scol = col0 + 16 * ct + 4 * fq;
    typename Epi::Pre pre;
    if (16 * rt < ROWS) pre = E.sample_pre(srow, scol, fq);
    f32x4 acc = {0.f, 0.f, 0.f, 0.f};
#pragma unroll
    for (int c = 0; c < NCH; ++c) {
        LAS unsigned char* buf = lds + (c & 1) * XBUF;
#pragma unroll
        for (int i = 0; i < NLX; ++i) *(LAS u32x4*)(buf + (lr + 16 * i) * XP + lc * 16) = xr[c][i];
#pragma unroll
        for (int i = 0; i < NLW; ++i) { if (wl) *(LAS u32x4*)(buf + (ROWS + lr + 16 * i) * XP + lc * 16) = wv[c][i]; }
        LDS_BARRIER();
        if (16 * rt < ROWS) {
#pragma unroll
            for (int ks = 0; ks < KC / 32; ++ks) {
                const bf16x8 x = *(const LAS bf16x8*)(buf + (16 * rt + fr) * XP + (32 * ks + 8 * fq) * 2);
                const bf16x8 w = *(const LAS bf16x8*)(buf + (ROWS + 16 * ct + fr) * XP + (32 * ks + 8 * fq) * 2);
                acc = MFMA16(w, x, acc); }
        }
    }
    LDS_BARRIER();
    if (16 * rt < ROWS) E.sample(acc, srow, scol, (col0 >> 4) + ct, fq, pre);
}

#define XB_TMO      128
#define XB_XCNT(j)  (256  + 64 * (j))
#define XB_XSUB(j)  (1280 + 64 * (j))
#define XB_XGEN(j)  (2304 + 64 * (j))
#define XB_TOP      3328
#define XB_TOPGEN   3392
#define XCD_BAR_WORDS 3456
#define XB_SPIN_CAP (1u << 18)
__device__ __forceinline__ unsigned xb_ld(unsigned* p)              { return __hip_atomic_load(p, __ATOMIC_RELAXED, __HIP_MEMORY_SCOPE_AGENT); }
__device__ __forceinline__ unsigned xb_add(unsigned* p, unsigned v) { return __hip_atomic_fetch_add(p, v, __ATOMIC_RELAXED, __HIP_MEMORY_SCOPE_AGENT); }
__device__ __forceinline__ unsigned xb_xcc_id() { return (unsigned)__builtin_amdgcn_s_getreg((3 << 11) | 20) & 0xFu; }
#define XB_SPIN(cond, bar) do { unsigned _sp = 0; while (cond) { __builtin_amdgcn_s_sleep(1); \
    if ((++_sp & 255u) == 0u) { if (xb_ld(&(bar)[XB_TMO])) break; if (_sp > XB_SPIN_CAP) { atomicAdd(&(bar)[XB_TMO], 1u); break; } } } } while (0)
struct XcdBarrier { unsigned* bar; unsigned x; volatile LAS unsigned* st; };
__device__ __forceinline__ XcdBarrier xcd_barrier_post(unsigned* bar, volatile LAS unsigned* st) {
    XcdBarrier b; b.bar = bar; b.x = xb_xcc_id(); b.st = st;
    if (threadIdx.x == 0) (void)xb_add(&bar[XB_XCNT(b.x)], 1u);
    return b;
}
__device__ __forceinline__ void xcd_barrier_complete(unsigned* bar, unsigned x, unsigned& nloc, unsigned& nx) {
    const unsigned G = gridDim.x * gridDim.y * gridDim.z;
    unsigned sum, cnt, mine, sp = 0u;
    for (;;) {
        sum = 0u; cnt = 0u; mine = 0u;
#pragma unroll
        for (unsigned j = 0; j < 16; ++j) { const unsigned c = xb_ld(&bar[XB_XCNT(j)]); sum += c; cnt += (c > 0u) ? 1u : 0u; mine = (j == x) ? c : mine; }
        if (sum == G) break;
        __builtin_amdgcn_s_sleep(1);
        if ((++sp & 255u) == 0u) { if (xb_ld(&bar[XB_TMO])) break; if (sp > XB_SPIN_CAP) { atomicAdd(&bar[XB_TMO], 1u); break; } }
    }
    nloc = mine > 0u ? mine : 1u; nx = cnt > 0u ? cnt : 1u;
}
__device__ __forceinline__ void xcd_barrier(const XcdBarrier& b) {
    asm volatile("s_waitcnt vmcnt(0)" ::: "memory");
    __syncthreads();
    if (threadIdx.x == 0) {
        unsigned* bar = b.bar;
        __builtin_amdgcn_s_waitcnt(0);
        unsigned nloc = b.st[0], nx = b.st[1];
        if (nloc == 0u) { xcd_barrier_complete(bar, b.x, nloc, nx); b.st[0] = nloc; b.st[1] = nx; }
        const unsigned old = xb_add(&bar[XB_XSUB(b.x)], 1u);
        const unsigned gen = old / nloc;
        if (old + 1u == (gen + 1u) * nloc) {
            __builtin_amdgcn_fence(__ATOMIC_RELEASE, "agent");
            asm volatile("s_waitcnt vmcnt(0)" ::: "memory");
            const unsigned og = xb_add(&bar[XB_TOP], 1u);
            const unsigned tg = og / nx;
            if (og + 1u == (tg + 1u) * nx) xb_add(&bar[XB_TOPGEN], 1u);
            else XB_SPIN(xb_ld(&bar[XB_TOPGEN]) == tg, bar);
            __builtin_amdgcn_fence(__ATOMIC_ACQUIRE, "agent");
            xb_add(&bar[XB_XGEN(b.x)], 1u);
            asm volatile("s_waitcnt vmcnt(0)" ::: "memory");
        } else {
            XB_SPIN(xb_ld(&bar[XB_XGEN(b.x)]) == gen, bar);
            __builtin_amdgcn_fence(__ATOMIC_ACQUIRE, "agent");
            asm volatile("s_waitcnt vmcnt(0)" ::: "memory");
        }
    }
    __syncthreads();
}

constexpr int RING_OFF = 0, RING_BYTES = 131072;
constexpr int LDSCTL_OFF = RING_BYTES, MISC_OFF = LDSCTL_OFF + 320;
constexpr int RSTD_OFF = 131584, ROPEL_OFF = 132608;
constexpr int LDS_BYTES = 155648;
constexpr int NWAVES = 8;

struct Args {
    const float* in[17]; float* out; unsigned char* ws; int ph_lo, ph_hi;
};
typedef const Args __attribute__((address_space(4)))* KArgPtr;
__device__ __forceinline__ KArgPtr kargs() { KArgPtr p = (KArgPtr)__builtin_amdgcn_kernarg_segment_ptr(); asm volatile("" : "+s"(p)); return p; }
__device__ __forceinline__ int fresh_tid() { int t = threadIdx.x; asm volatile("" : "+v"(t)); return t; }

__device__ __forceinline__ void stage_row_tables(unsigned char* ws, int pm, LAS unsigned char* lds, bool with_rope, const int tid) {
    if (tid < 256) ((LAS float*)(lds + RSTD_OFF))[tid] = row_rstd((const float*)(ws + WS_SSQ), pm * 256 + tid);
    if (with_rope) {
        const f32x4* rope = (const f32x4*)(ws + WS_ROPE);
#pragma unroll
        for (int i = 0; i < 2; ++i) { const int v = tid + 512 * i, r = v >> 2, part = v & 3; ((LAS f32x4*)(lds + ROPEL_OFF))[v] = rope[(size_t)((pm * 256 + r) & (SEQ - 1)) * 4 + part]; }
    }
    __syncthreads();
}

__device__ __forceinline__ void p0_transpose_item(const float* W, const float* scale, int smask, int K, int N, bf16_t* WT, int row_off, LAS float* scr, int item, int lane) {
    const int nblk = N / 32, kb = item / nblk, nb = item % nblk, k0 = 64 * kb, n0 = 32 * nb;
#pragma unroll 8
    for (int i = 0; i < 32; ++i) { const int kk = 2 * i + (lane >> 5); const float sc = scale ? scale[(k0 + kk) & smask] : 1.0f;
        scr[kk * 33 + (lane & 31)] = __builtin_nontemporal_load(W + (size_t)(k0 + kk) * N + n0 + (lane & 31)) * sc; }
    LDS_WAIT(); asm volatile("" ::: "memory");
    const int c = lane & 7;
#pragma unroll
    for (int j = 0; j < 4; ++j) { const int n = (lane >> 3) + 8 * j; const LAS float* s = scr + (8 * c) * 33 + n;
        u32x4 o; o.x = pk2(s[0 * 33], s[1 * 33]); o.y = pk2(s[2 * 33], s[3 * 33]); o.z = pk2(s[4 * 33], s[5 * 33]); o.w = pk2(s[6 * 33], s[7 * 33]);
        *(u32x4*)(WT + (size_t)(row_off + n0 + n) * K + k0 + 8 * c) = o; }
    LDS_WAIT(); asm volatile("" ::: "memory");
}

__device__ __forceinline__ void p0_prologue(KArgPtr Ap, LAS unsigned char* lds, int wave, int lane) {
    unsigned char* ws = Ap->ws;
    LAS float* scr = (LAS float*)(lds + RING_OFF + wave * 16384);
    const int G = gridDim.x, gw = blockIdx.x * NWAVES + wave, NGW = G * NWAVES;
    constexpr int I_AIN = 16 * 128, I_SQ = 16 * 32, I_BIN = 16 * 64, I_KV = 16 * 8;
    constexpr int NITEMS = 2 * I_AIN + 2 * I_SQ + 2 * I_BIN + I_KV + 2 * I_SQ;
    for (int it = gw; it < NITEMS; it += NGW) {
        int r = it;
        if (r < I_AIN) { p0_transpose_item(Ap->in[6], Ap->in[5], 1023, 1024, 4096, (bf16_t*)(ws + WS_WIN0), 0, scr, r, lane); continue; } r -= I_AIN;
        if (r < I_AIN) { p0_transpose_item(Ap->in[6] + (size_t)1024 * 4096, Ap->in[5] + 1024, 1023, 1024, 4096, (bf16_t*)(ws + WS_WIN1), 0, scr, r, lane); continue; } r -= I_AIN;
        if (r < I_SQ) { p0_transpose_item(Ap->in[9], Ap->in[8], 127, 1024, 1024, (bf16_t*)(ws + WS_WOUT0), 0, scr, r, lane); continue; } r -= I_SQ;
        if (r < I_SQ) { p0_transpose_item(Ap->in[9] + (size_t)1024 * 1024, Ap->in[8] + 128, 127, 1024, 1024, (bf16_t*)(ws + WS_WOUT1), 0, scr, r, lane); continue; } r -= I_SQ;
        if (r < I_BIN) { p0_transpose_item(Ap->in[13], Ap->in[12], 1023, 1024, 2048, (bf16_t*)(ws + WS_WINB0), 0, scr, r, lane); continue; } r -= I_BIN;
        if (r < I_BIN) { p0_transpose_item(Ap->in[13] + (size_t)1024 * 2048, Ap->in[12] + 1024, 1023, 1024, 2048, (bf16_t*)(ws + WS_WINB1), 0, scr, r, lane); continue; } r -= I_BIN;
        if (r < I_KV) { p0_transpose_item(Ap->in[11], Ap->in[10], 1023, 1024, 256, (bf16_t*)(ws + WS_WINB0), 2048, scr, r, lane); continue; } r -= I_KV;
        if (r < I_SQ) { p0_transpose_item(Ap->in[15], nullptr, 0, 1024, 1024, (bf16_t*)(ws + WS_WOUTB0), 0, scr, r, lane); continue; } r -= I_SQ;
        p0_transpose_item(Ap->in[15] + (size_t)1024 * 1024, nullptr, 0, 1024, 1024, (bf16_t*)(ws + WS_WOUTB1), 0, scr, r, lane);
    }
    bf16_t* HB = (bf16_t*)(ws + WS_HB); float* SSQ = (float*)(ws + WS_SSQ);
    float* SSQS = (float*)(ws + WS_SSQS);
    for (int m = gw; m < TP + TS; m += NGW) {
        f32x4 v[4]; float s = 0.f;
        if (m < TP + TS) {
            const f32x4* xr = (const f32x4*)(m < TP ? Ap->in[0] + (size_t)m * DM : Ap->in[1] + (size_t)(m - TP) * DM) + lane;
#pragma unroll
            for (int j = 0; j < 4; ++j) { v[j] = __builtin_nontemporal_load(xr + 64 * j); s += (v[j].x * v[j].x + v[j].y * v[j].y) + (v[j].z * v[j].z + v[j].w * v[j].w); }
        } else {
#pragma unroll
            for (int j = 0; j < 4; ++j) v[j] = (f32x4){0.f, 0.f, 0.f, 0.f};
        }
        s = wave_sum(s);
        u32x2* o8 = (u32x2*)(HB + (size_t)m * DM) + lane;
#pragma unroll
        for (int j = 0; j < 4; ++j) { u32x2 w; w.x = pk2(v[j].x, v[j].y); w.y = pk2(v[j].z, v[j].w); o8[64 * j] = w; }
        if (m < TP) { if (lane < 16) SSQ[(size_t)m * 16 + lane] = lane == 0 ? s : 0.f; }
        else SSQS[(size_t)(m - TP) * 64 + lane] = lane == 0 ? s : 0.f;
    }
    const int gt = blockIdx.x * (NWAVES * 64) + threadIdx.x, NGT = G * NWAVES * 64;
    float* LB1 = (float*)(ws + WS_LB1); float* ROPE = (float*)(ws + WS_ROPE);
    for (int i = gt; i < 1024; i += NGT) { const float l0 = Ap->in[7][i], l1 = Ap->in[7][1024 + i]; LB1[i] = 1.0f / (1.0f + expf(l0 - l1)); }
    for (int i = gt; i < (SEQ + 1) * 8; i += NGT) {
        const int p = i >> 3, j = i & 7; const double pos = p < SEQ ? (double)p : 8192.0;
        const double invf[8] = {1.0, 0.19392274474868576, 0.03760603093086393, 0.007292664737217109, 0.001414213562373095, 0.0002742481756762073, 5.318295896944988e-05, 1.031338537721246e-05};
        double fr_ = invf[0];
#pragma unroll
        for (int q = 1; q < 8; ++q) fr_ = (j == q) ? invf[q] : fr_;
        const double x = pos * fr_;
        const double qd = __builtin_rint(x * 0.6366197723675814);
        const double r = (x - qd * 1.5707963267948966) - qd * 6.123233995736766e-17;
        const double r2 = r * r;
        const double sr = r * (1.0 + r2 * (-1.0 / 6 + r2 * (1.0 / 120 + r2 * (-1.0 / 5040 + r2 * (1.0 / 362880 + r2 * (-1.0 / 39916800 + r2 * (1.0 / 6227020800.0)))))));
        const double cr = 1.0 + r2 * (-0.5 + r2 * (1.0 / 24 + r2 * (-1.0 / 720 + r2 * (1.0 / 40320 + r2 * (-1.0 / 3628800 + r2 * (1.0 / 479001600.0 + r2 * (-1.0 / 87178291200.0)))))));
        const int qi = ((int)((long long)qd)) & 3;
        const double sv = (qi == 0) ? sr : (qi == 1) ? cr : (qi == 2) ? -sr : -cr;
        const double cv = (qi == 0) ? cr : (qi == 1) ? -sr : (qi == 2) ? -cr : sr;
        ROPE[(size_t)p * 16 + j] = (float)cv; ROPE[(size_t)p * 16 + 8 + j] = (float)sv;
    }
}

constexpr int CP = 288, LFI_OFF = 0, QI_OFF = 18432, KI2_OFF = 36864, VI2_OFF = 55296, AM_OFF = 73728, BETA_OFF = 82944, EM_OFF = 83456, LAM1_OFF = 83968;
__device__ __forceinline__ s16x4 tr_read(const LAS unsigned char* p) { return __builtin_bit_cast(s16x4, __builtin_amdgcn_ds_read_tr16_b64_v4i16((LAS s16x4*)p)); }
struct ChunkIn { u32x4 lw[2], qv[2], vv[2]; };
__device__ __forceinline__ void chunk_load(ChunkIn& r, int unit, const bf16_t* Q, const bf16_t* Kb, const bf16_t* LF, const bf16_t* V, const int tid) {
    const int c = unit & 31, bh = unit >> 5, h = bh & 7, b = bh >> 3;
    const size_t g = ((size_t)b * SEQ + (size_t)c * 64 + (tid >> 3)) * DM + h * 128 + (tid & 7) * 8;
#pragma unroll
    for (int i = 0; i < 2; ++i) { r.lw[i] = *(const u32x4*)(LF + g + 64 * i); r.qv[i] = *(const u32x4*)(Q + g + 64 * i); r.vv[i] = *(const u32x4*)(V + g + 64 * i); }
}
__device__ __forceinline__ bf16x8 tr_frag(const LAS unsigned char* img, int kk, int col0, int fr, int fq) {
    const LAS unsigned char* p = img + (32 * kk + 4 * fq + (fr >> 2)) * CP + (col0 + 4 * (fr & 3)) * 2;
    const s16x4 lo = tr_read(p), hi = tr_read(p + 16 * CP);
    return (bf16x8){lo[0], lo[1], lo[2], lo[3], hi[0], hi[1], hi[2], hi[3]};
}
__device__ __forceinline__ void chunk_stepA(LAS unsigned char* lds, int unit, const int pos, float (&lam0)[4], const ChunkIn& r, bf16_t* Qo, float* LAM, int wave, int lane, const int tid) {
    const int c = unit & 31, bh = unit >> 5, h = bh & 7, b = bh >> 3;
    const size_t row0 = (size_t)b * SEQ + (size_t)c * 64;
    const int fr = lane & 15, fq = lane >> 4;
    LAS unsigned char* LFI = lds + LFI_OFF; LAS unsigned char* QI = lds + QI_OFF; LAS unsigned char* KI = lds + KI2_OFF; LAS unsigned char* VI = lds + VI2_OFF;
    LAS float* BETA = (LAS float*)(lds + BETA_OFF); LAS float* EM = (LAS float*)(lds + EM_OFF); LAS float* LAM1 = (LAS float*)(lds + LAM1_OFF);
    { const int lo = (tid >> 3) * CP + (tid & 7) * 16;
#pragma unroll
      for (int i = 0; i < 2; ++i) { *(LAS u32x4*)(LFI + lo + 128 * i) = r.lw[i]; *(LAS u32x4*)(QI + lo + 128 * i) = r.qv[i]; *(LAS u32x4*)(VI + lo + 128 * i) = r.vv[i]; } }
    LDS_BARRIER();
    f32x4 bt[4];
#pragma unroll
    for (int tt = 0; tt < 4; ++tt) {
        f32x4 acc = {0.f, 0.f, 0.f, 0.f};
#pragma unroll
        for (int kk = 0; kk < 2; ++kk) if (32 * kk <= 16 * tt + 15) {
            const bf16x8 a = tr_frag(LFI, kk, 16 * wave, fr, fq);
            const int t = 16 * tt + fr, s0 = 32 * kk + 4 * fq;
            bf16x8 tri;
#pragma unroll
            for (int jj = 0; jj < 8; ++jj) tri[jj] = (s0 + (jj < 4 ? jj : 12 + jj)) <= t ? (short)0x3F80 : (short)0;
            acc = MFMA16(a, tri, acc);
        }
        bt[tt] = acc;
    }
    float bmid[4], em[4];
#pragma unroll
    for (int j = 0; j < 4; ++j) {
        bmid[j] = __shfl(bt[1][j], (lane & 48) | 15);
        const float bend = __shfl(bt[3][j], (lane & 48) | 15);
        em[j] = __expf(bmid[j]);
        const float lam = __expf(bend);
        const int d = 16 * wave + 4 * fq + j;
        if (fr == 0) { BETA[d] = __expf(bend - bmid[j]); if (pos > 0) { EM[d] = em[j]; LAM1[d] = lam; } if (pos == 3) LAM[(size_t)(((unit >> 5) << 3) + ((unit & 31) >> 2)) * 128 + d] = lam0[j] * lam; }
        if (pos > 0) { em[j] *= lam0[j]; lam0[j] *= lam; } else lam0[j] = lam;
    }
#pragma unroll
    for (int tt = 0; tt < 4; ++tt) {
        const int ao = (16 * tt + fr) * CP + (16 * wave + 4 * fq) * 2;
        const u32x2 qw = *(const LAS u32x2*)(QI + ao), lw = *(const LAS u32x2*)(LFI + ao);
        const float qf[4] = {bflo(qw.x), bfhi(qw.x), bflo(qw.y), bfhi(qw.y)};
        const float kf[4] = {1.0f - __expf(bflo(lw.x)), 1.0f - __expf(bfhi(lw.x)), 1.0f - __expf(bflo(lw.y)), 1.0f - __expf(bfhi(lw.y))};
        float qt[4], kt[4], qh[4];
#pragma unroll
        for (int j = 0; j < 4; ++j) { const float e1 = __expf(bt[tt][j] - bmid[j]), e2 = __expf(bmid[j] - bt[tt][j]); qt[j] = qf[j] * e1; kt[j] = kf[j] * e2; qh[j] = qt[j] * em[j]; }
        u32x2 w; w.x = pk2(qt[0], qt[1]); w.y = pk2(qt[2], qt[3]); *(LAS u32x2*)(QI + ao) = w;
        w.x = pk2(kt[0], kt[1]); w.y = pk2(kt[2], kt[3]); *(LAS u32x2*)(KI + ao) = w;
        w.x = pk2(qh[0], qh[1]); w.y = pk2(qh[2], qh[3]); *(u32x2*)(Qo + (row0 + 16 * tt + fr) * DM + h * 128 + 16 * wave + 4 * fq) = w;
    }
    LDS_BARRIER();
}
__device__ __forceinline__ void chunk_stepBC(LAS unsigned char* lds, int unit, const int pos, f32x4 (&ds0)[8], bf16_t* LFo, bf16_t* DS, int wave, int lane) {
    const int c = unit & 31, bh = unit >> 5, h = bh & 7, b = bh >> 3;
    const size_t row0 = (size_t)b * SEQ + (size_t)c * 64;
    const int fr = lane & 15, fq = lane >> 4;
    LAS unsigned char* QI = lds + QI_OFF; LAS unsigned char* KI = lds + KI2_OFF; LAS unsigned char* VI = lds + VI2_OFF;
    LAS bf16_t* AM = (LAS bf16_t*)(lds + AM_OFF); LAS float* BETA = (LAS float*)(lds + BETA_OFF); LAS float* EM = (LAS float*)(lds + EM_OFF); LAS float* LAM1 = (LAS float*)(lds + LAM1_OFF);
#pragma unroll
    for (int ii = 0; ii < 2; ++ii) {
        const int idx = 2 * wave + ii, st = idx >> 2, tt = idx & 3;
        f32x4 acc = {0.f, 0.f, 0.f, 0.f};
        if (st <= tt) {
#pragma unroll
            for (int kk = 0; kk < 4; ++kk) {
                const bf16x8 a = *(const LAS bf16x8*)(KI + (16 * st + fr) * CP + (32 * kk + 8 * fq) * 2);
                const bf16x8 bq = *(const LAS bf16x8*)(QI + (16 * tt + fr) * CP + (32 * kk + 8 * fq) * 2);
                acc = MFMA16(a, bq, acc);
            }
        }
        const int t = 16 * tt + fr, s0 = 16 * st + 4 * fq;
        float m0 = (s0 + 0 <= t) ? acc[0] : 0.f, m1 = (s0 + 1 <= t) ? acc[1] : 0.f, m2 = (s0 + 2 <= t) ? acc[2] : 0.f, m3 = (s0 + 3 <= t) ? acc[3] : 0.f;
        u32x2 w; w.x = pk2(m0, m1); w.y = pk2(m2, m3);
        *(LAS u32x2*)(AM + t * 72 + s0) = w;
    }
    LDS_BARRIER();
    bf16x8 va[2];
#pragma unroll
    for (int kk = 0; kk < 2; ++kk) va[kk] = tr_frag(VI, kk, 16 * wave, fr, fq);
    bf16x8 sf[4];
    if (pos > 0) {
#pragma unroll
        for (int kk = 0; kk < 4; ++kk) {
            const f32x4 e0 = *(const LAS f32x4*)(EM + 32 * kk + 4 * fq), e1 = *(const LAS f32x4*)(EM + 32 * kk + 16 + 4 * fq);
            const f32x4 x0 = ds0[2 * kk] * e0, x1 = ds0[2 * kk + 1] * e1;
            u32x4 w; w.x = pk2(x0[0], x0[1]); w.y = pk2(x0[2], x0[3]); w.z = pk2(x1[0], x1[1]); w.w = pk2(x1[2], x1[3]);
            sf[kk] = __builtin_bit_cast(bf16x8, w);
        }
    }
#pragma unroll
    for (int tt = 0; tt < 4; ++tt) {
        f32x4 acc = {0.f, 0.f, 0.f, 0.f};
        if (pos > 0) {
#pragma unroll
            for (int kk = 0; kk < 4; ++kk) {
                const LAS unsigned char* qp = QI + (16 * tt + fr) * CP + (32 * kk + 4 * fq) * 2;
                const u32x2 lo = *(const LAS u32x2*)qp, hi = *(const LAS u32x2*)(qp + 32);
                u32x4 w; w.x = lo.x; w.y = lo.y; w.z = hi.x; w.w = hi.y;
                acc = MFMA16(sf[kk], __builtin_bit_cast(bf16x8, w), acc);
            }
        }
#pragma unroll
        for (int kk = 0; kk < 2; ++kk) {
            const LAS bf16_t* ap = AM + (16 * tt + fr) * 72 + 32 * kk + 4 * fq;
            const u32x2 lo = *(const LAS u32x2*)ap, hi = *(const LAS u32x2*)(ap + 16);
            u32x4 w; w.x = lo.x; w.y = lo.y; w.z = hi.x; w.w = hi.y;
            acc = MFMA16(va[kk], __builtin_bit_cast(bf16x8, w), acc);
        }
        { u32x2 wo; wo.x = pk2(acc[0], acc[1]); wo.y = pk2(acc[2], acc[3]); *(u32x2*)(LFo + (row0 + 16 * tt + fr) * DM + h * 128 + 16 * wave + 4 * fq) = wo; }
    }
#pragma unroll
    for (int dt = 0; dt < 8; ++dt) {
        f32x4 acc = {0.f, 0.f, 0.f, 0.f};
#pragma unroll
        for (int kk = 0; kk < 2; ++kk) { const bf16x8 ak = tr_frag(KI, kk, 16 * dt, fr, fq); acc = MFMA16(ak, va[kk], acc); }
        const f32x4 be = *(const LAS f32x4*)(BETA + 16 * dt + 4 * fq);
        acc *= be;
        if (pos > 0) acc += ds0[dt] * *(const LAS f32x4*)(LAM1 + 16 * dt + 4 * fq);
        if (pos == 3) {
            u32x2 w; w.x = pk2(acc[0], acc[1]); w.y = pk2(acc[2], acc[3]);
            *(u32x2*)(DS + (((size_t)(((unit >> 5) << 3) + ((unit & 31) >> 2)) * 64 + dt * 8 + wave) * 64 + lane) * 4) = w;
        } else ds0[dt] = acc;
    }
    LDS_BARRIER();
}

constexpr int C2_SETB = 65536, C2_QI = 0, C2_KI = 18432, C2_VI = 36864, C2_AM = 55296, C2_AMP = 80, C2_SM0 = 150016, C2_SM1 = 151552, C2_LFI = 131584;
__device__ __forceinline__ LAS unsigned char* c2_set(LAS unsigned char* lds, int s) { return lds + s * C2_SETB; }
__device__ __forceinline__ LAS float* c2_small(LAS unsigned char* lds, int s) { return (LAS float*)(lds + (s ? C2_SM1 : C2_SM0)); }
__device__ __forceinline__ void chunk_A1(LAS unsigned char* lds, int s, const ChunkIn& r, const int tid) {
    LAS unsigned char* sb = c2_set(lds, s); LAS unsigned char* LFI = lds + C2_LFI;
    const int lo = (tid >> 3) * CP + (tid & 7) * 16;
#pragma unroll
    for (int i = 0; i < 2; ++i) { *(LAS u32x4*)(LFI + lo + 128 * i) = r.lw[i]; *(LAS u32x4*)(sb + C2_QI + lo + 128 * i) = r.qv[i]; *(LAS u32x4*)(sb + C2_VI + lo + 128 * i) = r.vv[i]; }
}
__device__ __forceinline__ void chunk_A2(LAS unsigned char* lds, int s, int unit, const int pos, float (&lam0)[4], bf16_t* Qo, float* LAM, int wave, int lane) {
    const int c = unit & 31, bh = unit >> 5, h = bh & 7, b = bh >> 3;
    const size_t row0 = (size_t)b * SEQ + (size_t)c * 64;
    const int fr = lane & 15, fq = lane >> 4;
    LAS unsigned char* sb = c2_set(lds, s); LAS unsigned char* LFI = lds + C2_LFI; LAS unsigned char* QI = sb + C2_QI; LAS unsigned char* KI = sb + C2_KI;
    LAS float* BETA = c2_small(lds, s); LAS float* EM = BETA + 128; LAS float* LAM1 = BETA + 256;
    f32x4 bt[4];
#pragma unroll
    for (int tt = 0; tt < 4; ++tt) {
        f32x4 acc = {0.f, 0.f, 0.f, 0.f};
#pragma unroll
        for (int kk = 0; kk < 2; ++kk) if (32 * kk <= 16 * tt + 15) {
            const bf16x8 a = tr_frag(LFI, kk, 16 * wave, fr, fq);
            const int t = 16 * tt + fr, s0 = 32 * kk + 4 * fq;
            bf16x8 tri;
#pragma unroll
            for (int jj = 0; jj < 8; ++jj) tri[jj] = (s0 + (jj < 4 ? jj : 12 + jj)) <= t ? (short)0x3F80 : (short)0;
            acc = MFMA16(a, tri, acc);
        }
        bt[tt] = acc;
    }
    float bmid[4], em[4];
#pragma unroll
    for (int j = 0; j < 4; ++j) {
        bmid[j] = __shfl(bt[1][j], (lane & 48) | 15);
        const float bend = __shfl(bt[3][j], (lane & 48) | 15);
        em[j] = __expf(bmid[j]);
        const float lam = __expf(bend);
        const int d = 16 * wave + 4 * fq + j;
        if (fr == 0) { BETA[d] = __expf(bend - bmid[j]); if (pos > 0) { EM[d] = em[j]; LAM1[d] = lam; } if (pos == 3) LAM[(size_t)(((unit >> 5) << 3) + ((unit & 31) >> 2)) * 128 + d] = lam0[j] * lam; }
        if (pos > 0) { em[j] *= lam0[j]; lam0[j] *= lam; } else lam0[j] = lam;
    }
#pragma unroll
    for (int tt = 0; tt < 4; ++tt) {
        const int ao = (16 * tt + fr) * CP + (16 * wave + 4 * fq) * 2;
        const u32x2 qw = *(const LAS u32x2*)(QI + ao), lw = *(const LAS u32x2*)(LFI + ao);
        const float qf[4] = {bflo(qw.x), bfhi(qw.x), bflo(qw.y), bfhi(qw.y)};
        const float kf[4] = {1.0f - __expf(bflo(lw.x)), 1.0f - __expf(bfhi(lw.x)), 1.0f - __expf(bflo(lw.y)), 1.0f - __expf(bfhi(lw.y))};
        float qt[4], kt[4], qh[4];
#pragma unroll
        for (int j = 0; j < 4; ++j) { const float e1 = __expf(bt[tt][j] - bmid[j]), e2 = __expf(bmid[j] - bt[tt][j]); qt[j] = qf[j] * e1; kt[j] = kf[j] * e2; qh[j] = qt[j] * em[j]; }
        u32x2 w; w.x = pk2(qt[0], qt[1]); w.y = pk2(qt[2], qt[3]); *(LAS u32x2*)(QI + ao) = w;
        w.x = pk2(kt[0], kt[1]); w.y = pk2(kt[2], kt[3]); *(LAS u32x2*)(KI + ao) = w;
        w.x = pk2(qh[0], qh[1]); w.y = pk2(qh[2], qh[3]); *(u32x2*)(Qo + (row0 + 16 * tt + fr) * DM + h * 128 + 16 * wave + 4 * fq) = w;
    }
}
__device__ __forceinline__ void chunk_B(LAS unsigned char* lds, int s, int wave, int lane) {
    const int fr = lane & 15, fq = lane >> 4;
    LAS unsigned char* sb = c2_set(lds, s); LAS unsigned char* QI = sb + C2_QI; LAS unsigned char* KI = sb + C2_KI; LAS bf16_t* AM = (LAS bf16_t*)(sb + C2_AM);
#pragma unroll
    for (int ii = 0; ii < 2; ++ii) {
        const int idx = 2 * wave + ii, st = idx >> 2, tt = idx & 3;
        f32x4 acc = {0.f, 0.f, 0.f, 0.f};
        if (st <= tt) {
#pragma unroll
            for (int kk = 0; kk < 4; ++kk) {
                const bf16x8 a = *(const LAS bf16x8*)(KI + (16 * st + fr) * CP + (32 * kk + 8 * fq) * 2);
                const bf16x8 bq = *(const LAS bf16x8*)(QI + (16 * tt + fr) * CP + (32 * kk + 8 * fq) * 2);
                acc = MFMA16(a, bq, acc);
            }
        }
        const int t = 16 * tt + fr, s0 = 16 * st + 4 * fq;
        float m0 = (s0 + 0 <= t) ? acc[0] : 0.f, m1 = (s0 + 1 <= t) ? acc[1] : 0.f, m2 = (s0 + 2 <= t) ? acc[2] : 0.f, m3 = (s0 + 3 <= t) ? acc[3] : 0.f;
        u32x2 w; w.x = pk2(m0, m1); w.y = pk2(m2, m3);
        *(LAS u32x2*)(AM + t * C2_AMP + 32 * (st >> 1) + 8 * fq + 4 * (st & 1)) = w;
    }
}
template <int POS>
__device__ __forceinline__ void chunk_C(LAS unsigned char* lds, int s, int unit, f32x4 (&ds0)[8], bf16_t* LFo, bf16_t* DS, int wave, int lane) {
    const int c = unit & 31, bh = unit >> 5, h = bh & 7, b = bh >> 3;
    const size_t row0 = (size_t)b * SEQ + (size_t)c * 64;
    const int fr = lane & 15, fq = lane >> 4;
    LAS unsigned char* sb = c2_set(lds, s); LAS unsigned char* QI = sb + C2_QI; LAS unsigned char* KI = sb + C2_KI; LAS unsigned char* VI = sb + C2_VI; LAS bf16_t* AM = (LAS bf16_t*)(sb + C2_AM);
    LAS float* BETA = c2_small(lds, s); LAS float* EM = BETA + 128; LAS float* LAM1 = BETA + 256;
    bf16x8 va[2];
#pragma unroll
    for (int kk = 0; kk < 2; ++kk) va[kk] = tr_frag(VI, kk, 16 * wave, fr, fq);
    bf16x8 sf[4];
    if constexpr (POS > 0) {
        f32x4 ev[8];
#pragma unroll
        for (int i = 0; i < 8; ++i) ev[i] = *(const LAS f32x4*)(EM + 16 * i + 4 * fq);
#pragma unroll
        for (int kk = 0; kk < 4; ++kk) {
            const f32x4 x0 = ds0[2 * kk] * ev[2 * kk], x1 = ds0[2 * kk + 1] * ev[2 * kk + 1];
            u32x4 w; w.x = pk2(x0[0], x0[1]); w.y = pk2(x0[2], x0[3]); w.z = pk2(x1[0], x1[1]); w.w = pk2(x1[2], x1[3]);
            sf[kk] = __builtin_bit_cast(bf16x8, w);
        }
    }
#pragma unroll
    for (int tp = 0; tp < 2; ++tp) {
        u32x4 qf[2][4], af[2][2];
#pragma unroll
        for (int t2 = 0; t2 < 2; ++t2) {
            const int tt = 2 * tp + t2;
            if constexpr (POS > 0) {
#pragma unroll
                for (int kk = 0; kk < 4; ++kk) {
                    const LAS unsigned char* qp = QI + (16 * tt + fr) * CP + (32 * kk + 4 * fq) * 2;
                    const u32x2 lo = *(const volatile LAS u32x2*)qp, hi = *(const volatile LAS u32x2*)(qp + 32);
                    qf[t2][kk] = (u32x4){lo.x, lo.y, hi.x, hi.y};
                }
            }
#pragma unroll
            for (int kk = 0; kk < 2; ++kk) {
                af[t2][kk] = *(const LAS u32x4*)(AM + (16 * tt + fr) * C2_AMP + 32 * kk + 8 * fq);
            }
        }
        __builtin_amdgcn_sched_barrier(0);
#pragma unroll
        for (int t2 = 0; t2 < 2; ++t2) {
            const int tt = 2 * tp + t2;
            f32x4 acc = {0.f, 0.f, 0.f, 0.f};
            if constexpr (POS > 0) {
#pragma unroll
                for (int kk = 0; kk < 4; ++kk) acc = MFMA16(sf[kk], __builtin_bit_cast(bf16x8, qf[t2][kk]), acc);
            }
#pragma unroll
            for (int kk = 0; kk < 2; ++kk) acc = MFMA16(va[kk], __builtin_bit_cast(bf16x8, af[t2][kk]), acc);
            u32x2 wo; wo.x = pk2(acc[0], acc[1]); wo.y = pk2(acc[2], acc[3]); *(u32x2*)(LFo + (row0 + 16 * tt + fr) * DM + h * 128 + 16 * wave + 4 * fq) = wo;
        }
    }
#pragma unroll
    for (int dq = 0; dq < 2; ++dq) {
        bf16x8 kfr[4][2]; f32x4 be[4], l1[4];
#pragma unroll
        for (int d4 = 0; d4 < 4; ++d4) {
            const int dt = 4 * dq + d4;
#pragma unroll
            for (int kk = 0; kk < 2; ++kk) kfr[d4][kk] = tr_frag(KI, kk, 16 * dt, fr, fq);
            be[d4] = *(const LAS f32x4*)(BETA + 16 * dt + 4 * fq);
            if constexpr (POS > 0) l1[d4] = *(const LAS f32x4*)(LAM1 + 16 * dt + 4 * fq);
        }
        __builtin_amdgcn_sched_barrier(0);
#pragma unroll
        for (int d4 = 0; d4 < 4; ++d4) {
            const int dt = 4 * dq + d4;
            f32x4 acc = {0.f, 0.f, 0.f, 0.f};
#pragma unroll
            for (int kk = 0; kk < 2; ++kk) acc = MFMA16(kfr[d4][kk], va[kk], acc);
            acc *= be[d4];
            if constexpr (POS > 0) acc += ds0[dt] * l1[d4];
            if constexpr (POS == 3) {
                u32x2 w; w.x = pk2(acc[0], acc[1]); w.y = pk2(acc[2], acc[3]);
                *(u32x2*)(DS + (((size_t)(((unit >> 5) << 3) + ((unit & 31) >> 2)) * 64 + dt * 8 + wave) * 64 + lane) * 4) = w;
            } else ds0[dt] = acc;
        }
    }
}

__device__ __forceinline__ void hgrn_scan_phase(const bf16_t* DS, bf16_t* SCo, const float* LAM, float* stp_layer, int gt, int ngt) {
    for (int item = gt; item < 64 * 4096; item += ngt) {
        const int bh = item >> 12, tl = item & 4095, tile = tl >> 6, ln = tl & 63, dt = tile >> 3, et = tile & 7, fq = ln >> 4, fr = ln & 15;
        float S0 = 0.f, S1 = 0.f, S2 = 0.f, S3 = 0.f;
        const size_t boff = ((size_t)bh * 32768 + tile * 64 + ln) * 4;
        const float* lbase = LAM + (size_t)bh * 8 * 128 + 16 * dt + 4 * fq;
#pragma unroll 1
        for (int c0 = 0; c0 < 8; c0 += 8) {
            u32x2 dw[8]; f32x4 lam[8];
#pragma unroll
            for (int j = 0; j < 8; ++j) { dw[j] = *(const u32x2*)(DS + boff + (size_t)(c0 + j) * 16384); lam[j] = *(const f32x4*)(lbase + (c0 + j) * 128); }
#pragma unroll
            for (int j = 0; j < 8; ++j) {
                u32x2 sc; sc.x = pk2(S0, S1); sc.y = pk2(S2, S3); *(u32x2*)(SCo + boff + (size_t)(c0 + j) * 16384) = sc;
                S0 = S0 * lam[j].x + bflo(dw[j].x); S1 = S1 * lam[j].y + bfhi(dw[j].x); S2 = S2 * lam[j].z + bflo(dw[j].y); S3 = S3 * lam[j].w + bfhi(dw[j].y);
            }
        }
        float* o = stp_layer + (size_t)bh * 16384 + (size_t)(16 * dt + 4 * fq) * 128 + 16 * et + fr;
        o[0] = S0; o[128] = S1; o[256] = S2; o[384] = S3;
    }
}

struct InterIn { u32x4 q[2], o[2], g[2]; };
struct InterSc { u32x2 sc[8]; };
__device__ __forceinline__ void inter_load(InterIn& r, int unit, const bf16_t* Q, const bf16_t* OI, const bf16_t* G, const bf16_t* SC, int wave, int lane, const int tid) {
    const int c = unit & 31, bh = unit >> 5, h = bh & 7, b = bh >> 3;
    const size_t g0 = ((size_t)b * SEQ + (size_t)c * 64 + (tid >> 3)) * DM + h * 128 + (tid & 7) * 8;
#pragma unroll
    for (int i = 0; i < 2; ++i) { r.q[i] = *(const u32x4*)(Q + g0 + 64 * i); r.o[i] = *(const u32x4*)(OI + g0 + 64 * i); r.g[i] = *(const u32x4*)(G + g0 + 64 * i); }
}
__device__ __forceinline__ void inter_load_sc(InterSc& s, int unit, const bf16_t* SC, int wave, int lane) {
    const size_t su = (size_t)(((unit >> 5) << 3) + ((unit & 31) >> 2));
#pragma unroll
    for (int dt = 0; dt < 8; ++dt) s.sc[dt] = *(const u32x2*)(SC + ((su * 64 + dt * 8 + wave) * 64 + lane) * 4);
}
__device__ __forceinline__ void quad_prefix(LAS unsigned char* lds, InterSc& sc0, InterSc& sc1, int bh0, int bh1, int qp, const bf16_t* DS, const float* LAM, float* stp_layer, int wave, int lane, const int tid) {
    LAS float* lam_l = (LAS float*)lds;
    const int last_bh = qp == 7 ? bh0 : (qp == 0 ? bh1 : -1);
#define QP_SU(i_) ((i_) < 7 ? ((i_) < qp ? bh0 * 8 + (i_) : bh1 * 8 + (i_) - qp) : (last_bh >= 0 ? last_bh * 8 + 7 : bh1 * 8 + 6 - qp + (qp == 7 ? 8 * (bh0 - bh1) + 7 : 0)))
#pragma unroll
    for (int r = 0; r < 2; ++r) { const int v = tid + 512 * r, i = v >> 7, d = v & 127; lam_l[v] = LAM[(size_t)QP_SU(i) * 128 + d]; }
#define QP_LOAD(dst, i_) do { const size_t su_ = (size_t)QP_SU(i_); _Pragma("unroll") for (int dt = 0; dt < 8; ++dt) dst.sc[dt] = *(const u32x2*)(DS + ((su_ * 64 + dt * 8 + wave) * 64 + lane) * 4); } while (0)
    InterSc dq[8];
#pragma unroll
    for (int i = 0; i < 8; ++i) QP_LOAD(dq[i], i);
    __syncthreads();
    const int fq = lane >> 4, fr = lane & 15;
    f32x4 S[8];
#pragma unroll
    for (int dt = 0; dt < 8; ++dt) { S[dt] = (f32x4){0.f, 0.f, 0.f, 0.f}; sc0.sc[dt].x = 0u; sc0.sc[dt].y = 0u; }
#pragma unroll
    for (int i = 0; i < 7; ++i) {
        if (i == qp) {
#pragma unroll
            for (int dt = 0; dt < 8; ++dt) { sc0.sc[dt].x = pk2(S[dt][0], S[dt][1]); sc0.sc[dt].y = pk2(S[dt][2], S[dt][3]); S[dt] = (f32x4){0.f, 0.f, 0.f, 0.f}; }
        }
#pragma unroll
        for (int dt = 0; dt < 8; ++dt) { const f32x4 lm = *(const LAS f32x4*)(lam_l + i * 128 + 16 * dt + 4 * fq);
            S[dt] = S[dt] * lm + (f32x4){bflo(dq[i].sc[dt].x), bfhi(dq[i].sc[dt].x), bflo(dq[i].sc[dt].y), bfhi(dq[i].sc[dt].y)}; }
    }
#pragma unroll
    for (int dt = 0; dt < 8; ++dt) {
        const unsigned wx = pk2(S[dt][0], S[dt][1]), wy = pk2(S[dt][2], S[dt][3]);
        if (qp == 7) { sc0.sc[dt].x = wx; sc0.sc[dt].y = wy; sc1.sc[dt].x = 0u; sc1.sc[dt].y = 0u; } else { sc1.sc[dt].x = wx; sc1.sc[dt].y = wy; }
    }
    if (last_bh >= 0) {
        float* o = stp_layer + (size_t)last_bh * 16384 + 16 * wave + fr;
#pragma unroll
        for (int dt = 0; dt < 8; ++dt) { const f32x4 lm = *(const LAS f32x4*)(lam_l + 7 * 128 + 16 * dt + 4 * fq);
            const f32x4 e = S[dt] * lm + (f32x4){bflo(dq[7].sc[dt].x), bfhi(dq[7].sc[dt].x), bflo(dq[7].sc[dt].y), bfhi(dq[7].sc[dt].y)};
#pragma unroll
            for (int r = 0; r < 4; ++r) o[(size_t)(16 * dt + 4 * fq + r) * 128] = e[r]; }
    }
#undef QP_SU
#undef QP_LOAD
    __syncthreads();
}
__device__ __forceinline__ void inter_compute(LAS unsigned char* lds, int unit, int par, const InterIn& r, const InterSc& s, bf16_t* Qo, int wave, int lane, const int tid) {
    const int c = unit & 31, bh = unit >> 5, h = bh & 7, b = bh >> 3, fr = lane & 15, fq = lane >> 4;
    LAS bf16_t* QH = (LAS bf16_t*)(lds + par * 52224); LAS bf16_t* OT = QH + 8704; LAS bf16_t* GT = OT + 8704;
    LAS float* red = (LAS float*)(lds + 104448 + par * 2048);
    const int so = (tid >> 3) * 136 + (tid & 7) * 8;
#pragma unroll
    for (int i = 0; i < 2; ++i) { *(LAS u32x4*)(QH + so + 64 * i) = r.q[i]; *(LAS u32x4*)(OT + so + 64 * i) = r.o[i]; *(LAS u32x4*)(GT + so + 64 * i) = r.g[i]; }
    LDS_BARRIER();
    f32x4 o[4];
#pragma unroll
    for (int tt = 0; tt < 4; ++tt) { const u32x2 ow = *(const LAS u32x2*)(OT + (16 * tt + fr) * 136 + 16 * wave + 4 * fq); o[tt] = (f32x4){bflo(ow.x), bfhi(ow.x), bflo(ow.y), bfhi(ow.y)}; }
#pragma unroll
    for (int kk = 0; kk < 4; ++kk) {
        u32x4 aw; aw.x = s.sc[2 * kk].x; aw.y = s.sc[2 * kk].y; aw.z = s.sc[2 * kk + 1].x; aw.w = s.sc[2 * kk + 1].y;
        const bf16x8 af = __builtin_bit_cast(bf16x8, aw);
#pragma unroll
        for (int tt = 0; tt < 4; ++tt) {
            const LAS bf16_t* qp = QH + (16 * tt + fr) * 136 + 32 * kk + 4 * fq;
            const u32x2 lo = *(const volatile LAS u32x2*)qp, hi = *(const volatile LAS u32x2*)(qp + 16);
            u32x4 w; w.x = lo.x; w.y = lo.y; w.z = hi.x; w.w = hi.y;
            o[tt] = MFMA16(af, __builtin_bit_cast(bf16x8, w), o[tt]);
        }
    }
#pragma unroll
    for (int tt = 0; tt < 4; ++tt) {
        float p = (o[tt][0] * o[tt][0] + o[tt][1] * o[tt][1]) + (o[tt][2] * o[tt][2] + o[tt][3] * o[tt][3]);
        p += __shfl_xor(p, 16); p += __shfl_xor(p, 32);
        if (fq == 0) red[wave * 64 + 16 * tt + fr] = p;
    }
    LDS_BARRIER();
#pragma unroll
    for (int tt = 0; tt < 4; ++tt) {
        float tot = 0.f;
#pragma unroll
        for (int w2 = 0; w2 < 8; ++w2) tot += red[w2 * 64 + 16 * tt + fr];
        const float rs = rsqrtf(tot * (1.0f / 128.0f) + NORM_EPS);
        const int po = (16 * tt + fr) * 136 + 16 * wave + 4 * fq;
        const u32x2 gw = *(const LAS u32x2*)(GT + po);
        u32x2 w; w.x = pk2(o[tt][0] * rs * bflo(gw.x), o[tt][1] * rs * bfhi(gw.x)); w.y = pk2(o[tt][2] * rs * bflo(gw.y), o[tt][3] * rs * bfhi(gw.y));
        *(LAS u32x2*)(OT + po) = w;
    }
    LDS_BARRIER();
    const size_t g0 = ((size_t)b * SEQ + (size_t)c * 64 + (tid >> 3)) * DM + h * 128 + (tid & 7) * 8;
#pragma unroll
    for (int i = 0; i < 2; ++i) *(u32x4*)(Qo + g0 + 64 * i) = *(const LAS u32x4*)(OT + so + 64 * i);
}

struct SampleIn { f32x4 sv[4]; u32x2 vw; bf16_t q, lf, g; };
__device__ __forceinline__ void sample_load(SampleIn& r, int unit, int half, const bf16_t* Q, const bf16_t* Kb, const bf16_t* LF, const bf16_t* V, const bf16_t* G, const float* s0, const int tid) {
    const int n = unit >> 3, h = unit & 7;
    const size_t rb = (size_t)(TP + n) * DM + h * 128;
    const int dg = tid >> 5, e4 = (tid & 31) * 4;
#pragma unroll
    for (int dd = 0; dd < 4; ++dd) r.sv[dd] = __builtin_nontemporal_load((const f32x4*)(s0 + (size_t)(dg * 8 + half * 4 + dd) * 128 + e4));
    r.vw = *(const u32x2*)(V + rb + e4);
    const int t7 = tid & 127;
    r.q = Q[rb + t7]; r.lf = LF[rb + t7]; r.g = G[rb + t7];
}
__device__ __forceinline__ void sample_compute(LAS unsigned char* lds, int unit, int half, const SampleIn& r, bf16_t* Qo, float* s1, const int tid) {
    const int n = unit >> 3, h = unit & 7;
    const size_t rb = (size_t)(TP + n) * DM + h * 128;
    LAS float* qs = (LAS float*)lds; LAS float* ks = qs + 128; LAS float* fs = qs + 256; LAS float* part = qs + 384;
    LAS float* redw = qs + 384 + 4096;
    if (half == 0) {
        if (tid < 128) { const float f = __expf(bf1(r.lf)); qs[tid] = bf1(r.q); ks[tid] = 1.0f - f; fs[tid] = f; }
        LDS_BARRIER();
    }
    const int dg = tid >> 5, e4 = (tid & 31) * 4;
    const f32x4 v4 = {bflo(r.vw.x), bfhi(r.vw.x), bflo(r.vw.y), bfhi(r.vw.y)};
    f32x4 o4 = {0.f, 0.f, 0.f, 0.f};
#pragma unroll
    for (int dd = 0; dd < 4; ++dd) {
        const int d = dg * 8 + half * 4 + dd;
        const f32x4 sn = r.sv[dd] * fs[d] + v4 * ks[d];
        __builtin_nontemporal_store(sn, (f32x4*)(s1 + (size_t)d * 128 + e4));
        o4 += sn * qs[d];
    }
    *(LAS f32x4*)(part + (dg * 2 + half) * 128 + e4) = o4;
    if (half == 1) {
        LDS_BARRIER();
        float o = 0.f;
        if (tid < 128) {
#pragma unroll
            for (int i = 0; i < 32; ++i) o += part[i * 128 + tid];
        }
        float sq = wave_sum(o * o);
        if ((tid & 63) == 0) redw[tid >> 6] = sq;
        LDS_BARRIER();
        if (tid < 128) {
            const float tot = redw[0] + redw[1];
            const float rs = rsqrtf(tot * (1.0f / 128.0f) + NORM_EPS);
            Qo[rb + tid] = (bf16_t)f2bf(o * rs * bf1(r.g));
        }
    }
}

__device__ __forceinline__ void sample_rec_units(LAS unsigned char* lds, unsigned char* ws, const float* st_in, float* st_out, int bx, int G, const int tid) {
    const bf16_t* Qp = (const bf16_t*)(ws + WS_Q); const bf16_t* Kp = (const bf16_t*)(ws + WS_K); const bf16_t* Lp = (const bf16_t*)(ws + WS_LF); const bf16_t* Vp = (const bf16_t*)(ws + WS_V); const bf16_t* Gp = (const bf16_t*)(ws + WS_G);
    bf16_t* Qo = (bf16_t*)(ws + WS_Q);
    SampleIn c0, c1, n0, n1;
    sample_load(c0, bx, 0, Qp, Kp, Lp, Vp, Gp, st_in + (size_t)bx * 16384, tid); sample_load(c1, bx, 1, Qp, Kp, Lp, Vp, Gp, st_in + (size_t)bx * 16384, tid);
#pragma unroll 1
    for (int k = 0; k < 4; ++k) {
        const int su = bx + G * k, sn = k < 3 ? su + G : su;
        sample_load(n0, sn, 0, Qp, Kp, Lp, Vp, Gp, st_in + (size_t)sn * 16384, tid); sample_load(n1, sn, 1, Qp, Kp, Lp, Vp, Gp, st_in + (size_t)sn * 16384, tid);
        sample_compute(lds + 112640, su, 0, c0, Qo, st_out + (size_t)su * 16384, tid);
        sample_compute(lds + 112640, su, 1, c1, Qo, st_out + (size_t)su * 16384, tid);
        c0 = n0; c1 = n1;
    }
    __syncthreads();
}

constexpr int KI_OFF = 0, VI_OFF = 40960, KVP = 160;
template <bool MIDFULL>
__device__ __forceinline__ void attn_core(const LAS unsigned char* KI, const LAS unsigned char* VI, int kt0, const bf16x8 (&qf)[2], int jlo, int jhi, float sink, int fr, int fq, f32x4 (&o)[4]) {
    f32x4 s[9];
    const LAS unsigned char* kb = KI + (16 * kt0 + fr) * KVP + 16 * fq;
#pragma unroll
    for (int x = 0; x < 9; ++x) {
        s[x] = (f32x4){0.f, 0.f, 0.f, 0.f};
#pragma unroll
        for (int kk = 0; kk < 2; ++kk) { const bf16x8 a = *(const LAS bf16x8*)(kb + x * 16 * KVP + kk * 64); s[x] = MFMA16(a, qf[kk], s[x]); }
    }
    float mx = sink;
    const int j0 = 16 * kt0 + 4 * fq;
#pragma unroll
    for (int x = 0; x < 9; ++x)
#pragma unroll
        for (int r = 0; r < 4; ++r) {
            float sv = s[x][r];
            if (!MIDFULL || x == 0 || x == 8) { const int j = j0 + 16 * x + r; const bool valid = (j >= jlo) && (j <= jhi); sv = valid ? sv : -1e30f; s[x][r] = sv; }
            mx = fmaxf(mx, sv); }
    mx = fmaxf(mx, __shfl_xor(mx, 16)); mx = fmaxf(mx, __shfl_xor(mx, 32));
    float sum = 0.f;
#pragma unroll
    for (int x = 0; x < 9; ++x)
#pragma unroll
        for (int r = 0; r < 4; ++r) { const float p = __builtin_amdgcn_exp2f(s[x][r] - mx); s[x][r] = p; sum += p; }
    sum += __shfl_xor(sum, 16); sum += __shfl_xor(sum, 32);
    const float inv = fast_rcp(sum + __builtin_amdgcn_exp2f(sink - mx));
    bf16x8 pb[5];
#pragma unroll
    for (int y = 0; y < 5; ++y) {
        u32x4 w; w.x = pk2(s[2 * y][0] * inv, s[2 * y][1] * inv); w.y = pk2(s[2 * y][2] * inv, s[2 * y][3] * inv);
        if (y < 4) { w.z = pk2(s[2 * y + 1][0] * inv, s[2 * y + 1][1] * inv); w.w = pk2(s[2 * y + 1][2] * inv, s[2 * y + 1][3] * inv); } else { w.z = 0u; w.w = 0u; }
        pb[y] = __builtin_bit_cast(bf16x8, w);
    }
    const LAS unsigned char* vb = VI + (16 * kt0 + 4 * fq + (fr >> 2)) * KVP + 8 * (fr & 3);
#pragma unroll
    for (int dt = 0; dt < 4; ++dt) {
        f32x4 acc = {0.f, 0.f, 0.f, 0.f};
#pragma unroll
        for (int y = 0; y < 5; ++y) {
            const s16x4 lo = tr_read(vb + (32 * y) * KVP + 32 * dt);
            s16x4 hi = {0, 0, 0, 0};
            if (y < 4) hi = tr_read(vb + (32 * y + 16) * KVP + 32 * dt);
            const bf16x8 a = {lo[0], lo[1], lo[2], lo[3], hi[0], hi[1], hi[2], hi[3]};
            acc = MFMA16(a, pb[y], acc);
        }
        o[dt] = acc;
    }
}

__device__ __forceinline__ void swa_prompt_unit(LAS unsigned char* lds, int unit, const bf16_t* QA, bf16_t* QAo, const bf16_t* GA, const bf16_t* KA, const bf16_t* VA, const float* sinks, int wave, int lane, const int tid) {
    const int b = unit >> 5, blk = (unit >> 1) & 15, kvh = unit & 1;
    const int R0 = b * SEQ + blk * 128;
    const int fr = lane & 15, fq = lane >> 4;
    LAS unsigned char* KI = lds + KI_OFF; LAS unsigned char* VI = lds + VI_OFF;
    const int hq = kvh * 8 + wave;
    const size_t qbase = (size_t)(R0 + fr) * DM + hq * 64;
    bf16x8 qf[8][2];
#pragma unroll
    for (int qt = 0; qt < 8; ++qt)
#pragma unroll
        for (int kk = 0; kk < 2; ++kk) qf[qt][kk] = *(const bf16x8*)(QA + qbase + (size_t)qt * 16 * DM + 32 * kk + 8 * fq);
#pragma unroll
    for (int i = 0; i < 4; ++i) {
        const int idx = tid + 512 * i, key = idx >> 3, ch = idx & 7;
        u32x4 kk = {0u, 0u, 0u, 0u}, vv = {0u, 0u, 0u, 0u};
        if (blk > 0 || key >= 128) { const size_t g = (size_t)(R0 - 128 + key) * 128 + kvh * 64 + ch * 8; kk = *(const u32x4*)(KA + g); vv = *(const u32x4*)(VA + g); }
        *(LAS u32x4*)(KI + key * KVP + ch * 16) = kk; *(LAS u32x4*)(VI + key * KVP + ch * 16) = vv;
    }
    const float sink = sinks[hq] * 1.4426950408889634f;
    __syncthreads();
#pragma unroll
    for (int qt = 0; qt < 8; ++qt) {
        const size_t idx0 = qbase + (size_t)qt * 16 * DM + 4 * fq;
        u32x2 gw[4];
#pragma unroll
        for (int dt = 0; dt < 4; ++dt) gw[dt] = *(const u32x2*)(GA + idx0 + 16 * dt);
        const int tq = 16 * qt + fr;
        f32x4 o[4];
        if (blk > 0) attn_core<true>(KI, VI, qt, qf[qt], tq, tq + 128, sink, fr, fq, o);
        else attn_core<false>(KI, VI, qt, qf[qt], tq > 128 ? tq : 128, tq + 128, sink, fr, fq, o);
#pragma unroll
        for (int dt = 0; dt < 4; ++dt) {
            u32x2 w; w.x = pk2(o[dt][0] * bflo(gw[dt].x), o[dt][1] * bfhi(gw[dt].x)); w.y = pk2(o[dt][2] * bflo(gw[dt].y), o[dt][3] * bfhi(gw[dt].y));
            *(u32x2*)(QAo + idx0 + 16 * dt) = w;
        }
    }
    __syncthreads();
}

__device__ __forceinline__ void swa_sample_unit(LAS unsigned char* lds, int unit, const bf16_t* QA, bf16_t* QAo, const bf16_t* GA, const bf16_t* KA, const bf16_t* VA, const float* ck, const float* cv, const float* sinks, int wave, int lane, const int tid) {
    const int n = unit >> 1, kvh = unit & 1;
    const size_t row = (size_t)(TP + n);
    const int fr = lane & 15, fq = lane >> 4;
    LAS unsigned char* KI = lds + KI_OFF; LAS unsigned char* VI = lds + VI_OFF;
    const int hq = kvh * 8 + (fr & 7);
    bf16x8 qf[2];
#pragma unroll
    for (int kk = 0; kk < 2; ++kk) qf[kk] = *(const bf16x8*)(QA + row * DM + hq * 64 + 32 * kk + 8 * fq);
#pragma unroll
    for (int i = 0; i < 3; ++i) {
        const int idx = tid + 512 * i, key = idx >> 3, ch = idx & 7;
        if (key < 144) {
            u32x4 kk = {0u, 0u, 0u, 0u}, vv = {0u, 0u, 0u, 0u};
            if (key < 128) {
                const size_t g = ((size_t)(n * 128 + key) * 2 + kvh) * 64 + ch * 8;
                const f32x4 k0 = *(const f32x4*)(ck + g), k1 = *(const f32x4*)(ck + g + 4), v0 = *(const f32x4*)(cv + g), v1 = *(const f32x4*)(cv + g + 4);
                kk.x = pk2(k0.x, k0.y); kk.y = pk2(k0.z, k0.w); kk.z = pk2(k1.x, k1.y); kk.w = pk2(k1.z, k1.w);
                vv.x = pk2(v0.x, v0.y); vv.y = pk2(v0.z, v0.w); vv.z = pk2(v1.x, v1.y); vv.w = pk2(v1.z, v1.w);
            } else if (key == 128) { const size_t g = row * 128 + kvh * 64 + ch * 8; kk = *(const u32x4*)(KA + g); vv = *(const u32x4*)(VA + g); }
            *(LAS u32x4*)(KI + key * KVP + ch * 16) = kk; *(LAS u32x4*)(VI + key * KVP + ch * 16) = vv;
        }
    }
    const float sink = sinks[hq] * 1.4426950408889634f;
    __syncthreads();
    if (wave == 0) {
        const size_t idx0 = row * DM + hq * 64 + 4 * fq;
        u32x2 gw[4];
#pragma unroll
        for (int dt = 0; dt < 4; ++dt) gw[dt] = *(const u32x2*)(GA + idx0 + 16 * dt);
        f32x4 o[4];
        attn_core<false>(KI, VI, 0, qf, 0, 128, sink, fr, fq, o);
        if (fr < 8) {
#pragma unroll
            for (int dt = 0; dt < 4; ++dt) {
                u32x2 w; w.x = pk2(o[dt][0] * bflo(gw[dt].x), o[dt][1] * bfhi(gw[dt].x)); w.y = pk2(o[dt][2] * bflo(gw[dt].y), o[dt][3] * bfhi(gw[dt].y));
                *(u32x2*)(QAo + idx0 + 16 * dt) = w;
            }
        }
    }
    __syncthreads();
}

__global__ void __launch_bounds__(NWAVES * 64, 2) yoco_fwd(Args args) {
    extern __shared__ __attribute__((aligned(16))) unsigned char lds_raw[];
    LAS unsigned char* lds = (LAS unsigned char*)lds_raw;
    volatile LAS unsigned* MISC = (volatile LAS unsigned*)(lds + MISC_OFF);
    const int G = gridDim.x, bx = blockIdx.x;
    { const int tid = threadIdx.x;
      for (int u = tid; u < (LDS_BYTES - LDSCTL_OFF) / 4; u += NWAVES * 64) ((LAS unsigned*)(lds + LDSCTL_OFF))[u] = 0u; }
    __syncthreads();
    XcdBarrier bar = xcd_barrier_post((unsigned*)(args.ws + WS_CTL) + CW_BAR, MISC + 8);
    const int lo = args.ph_lo, hi = args.ph_hi;
#define IN(k) (lo <= (k) && (k) < hi)
#define SEAM(k) do { if (IN(k) && IN((k) + 1)) { for (int rep = 0; rep < NREP(9); ++rep) xcd_barrier(bar); } } while (0)
#define PHASE_LOCALS() KArgPtr ap = kargs(); unsigned char* ws = ap->ws; const int tid = fresh_tid(), lane = tid & 63, wave = __builtin_amdgcn_readfirstlane(tid >> 6); (void)lane; (void)wave; (void)ws

    if (IN(0)) { for (int rep = 0; rep < NREP(0); ++rep) { PHASE_LOCALS(); p0_prologue(ap, lds, wave, lane); } }
    SEAM(0);

#define S_IN_A(l_)  do { EpiHgrnIn Es{ws, (l_), (const LAS float*)(lds + RSTD_OFF)}; const bf16_t* Bs = (const bf16_t*)(ws + ((l_) == 0 ? WS_WIN0 : WS_WIN1)); \
        for (int u = bx; u < 256; u += G) sgemm_unit<64, 32>(lds, (const bf16_t*)(ws + WS_HB) + (size_t)TP * DM, Bs, u, Es, wave, lane, tid); } while (0)
#define S_OUT(WOFF, u0_, ustep_) do { EpiResid Es{ws}; const bf16_t* Bs = (const bf16_t*)(ws + (WOFF)); \
        for (int u = (u0_); u < 256; u += (ustep_)) sgemm_unit<32, 16>(lds, (const bf16_t*)(ws + WS_Q) + (size_t)TP * DM, Bs, u, Es, wave, lane, tid); } while (0)
#define S_STEP(l_)  sample_rec_units(lds, ws, ap->in[2] + (size_t)(l_) * 1024 * 16384, ap->out + O_STS + (size_t)(l_) * 1024 * 16384, bx, G, tid)
#define S_ATTN(j_)  do { const float* sk = ap->in[14] + (j_) * 16; \
        for (int u = bx; u < 256; u += G) swa_sample_unit(lds, u, (const bf16_t*)(ws + WS_Q), (bf16_t*)(ws + WS_Q), (const bf16_t*)(ws + WS_G), (const bf16_t*)(ws + WS_KA), (const bf16_t*)(ws + WS_VA), ap->in[3], ap->in[4], sk, wave, lane, tid); } while (0)

#pragma unroll 1
    for (int l = 0; l < 2; ++l) {
        const int pb = 1 + 5 * l;
        if (IN(pb)) {
            PHASE_LOCALS();
            const bf16_t* Bt = (const bf16_t*)(ws + (l == 0 ? WS_WIN0 : WS_WIN1));
            const int vcu = (bx & 7) * (G >> 3) + (bx >> 3);
            pg8::Gemm g{(const bf16_t*)(ws + WS_HB), Bt, TP, 4096, 1024}; pg8::HeadPairOrder S; S.pm = vcu >> 2; S.hp = vcu & 3; S.rot = (vcu >> 5) & 3; { int n4 = 4; asm volatile("" : "+s"(n4)); S.nu = n4; }
            EpiHgrnIn E{ws, l, (const LAS float*)(lds + RSTD_OFF)};
            stage_row_tables(ws, S.pm, lds, false, tid);
            S_IN_A(l);
            pg8::gemm_phase<EpiHgrnIn, pg8::HeadPairOrder, PG8_ALIGN, PG8_SP2>(lds + RING_OFF, g, S, E, tid);
        }
        if (IN(pb)) {
            PHASE_LOCALS();
            __syncthreads();
            const int vcu = (bx & 7) * (G >> 3) + (bx >> 3);
            const int pm_ = vcu >> 2, hp_ = vcu & 3, bq = pm_ >> 3, c0 = 4 * (pm_ & 7);
            const bf16_t* Qp = (const bf16_t*)(ws + WS_Q); const bf16_t* Kp = (const bf16_t*)(ws + WS_K); const bf16_t* Lp = (const bf16_t*)(ws + WS_LF); const bf16_t* Vp = (const bf16_t*)(ws + WS_V);
            {
                ChunkIn r; f32x4 ds0[8]; float lam0[4] = {0.f, 0.f, 0.f, 0.f};
#pragma unroll
                for (int i = 0; i < 8; ++i) ds0[i] = (f32x4){0.f, 0.f, 0.f, 0.f};
                bf16_t* Qo = (bf16_t*)(ws + WS_Q); bf16_t* LFo = (bf16_t*)(ws + WS_LF); bf16_t* DSp = (bf16_t*)(ws + WS_DS); float* LAMp = (float*)(ws + WS_LAM);
                const int ub = (bq * 8 + 2 * hp_) * 32 + c0;
                chunk_load(r, ub, Qp, Kp, Lp, Vp, tid);
                chunk_A1(lds, 0, r, tid);
                chunk_load(r, ub + 1, Qp, Kp, Lp, Vp, tid);
                LDS_BARRIER();
                chunk_A2(lds, 0, ub, 0, lam0, Qo, LAMp, wave, lane);
                LDS_BARRIER();
#pragma unroll 1
                for (int k = 0; k < 8; ++k) {
                    const int u = ub + (k >> 2) * 32 + (k & 3), s = k & 1;
                    const bool has_next = k < 7;
                    const int k1 = k < 7 ? k + 1 : 7, un = ub + (k1 >> 2) * 32 + (k1 & 3), k2 = k + 2 < 8 ? k + 2 : 7, u2 = ub + (k2 >> 2) * 32 + (k2 & 3);
                    if (has_next) { chunk_A1(lds, s ^ 1, r, tid); chunk_load(r, u2, Qp, Kp, Lp, Vp, tid); }
                    __builtin_amdgcn_sched_barrier(0);
                    chunk_B(lds, s, wave, lane);
                    LDS_BARRIER();
                    if (has_next) chunk_A2(lds, s ^ 1, un, k1 & 3, lam0, Qo, LAMp, wave, lane);
                    __builtin_amdgcn_sched_barrier(0);
                    switch (k & 3) {
                        case 0: chunk_C<0>(lds, s, u, ds0, LFo, DSp, wave, lane); break;
                        case 1: chunk_C<1>(lds, s, u, ds0, LFo, DSp, wave, lane); break;
                        case 2: chunk_C<2>(lds, s, u, ds0, LFo, DSp, wave, lane); break;
                        default: chunk_C<3>(lds, s, u, ds0, LFo, DSp, wave, lane); break;
                    }
                    LDS_BARRIER();
                }
            }
        }
        SEAM(pb);
        if (IN(pb + 3)) {
            PHASE_LOCALS();
            for (int rep = 0; rep < NREP(10); ++rep) {
                bf16_t* qo = (bf16_t*)(ws + (DUMMY(10, rep) ? WS_DUM0 : WS_Q));
                const bf16_t* Qp = (const bf16_t*)(ws + WS_Q); const bf16_t* Op = (const bf16_t*)(ws + WS_LF); const bf16_t* Gp = (const bf16_t*)(ws + WS_G); const bf16_t* Sp = (const bf16_t*)(ws + WS_DS);
                const int vcu = (bx & 7) * (G >> 3) + (bx >> 3), qp = vcu & 7, bh0 = (vcu >> 5) * 8 + ((vcu >> 3) & 3), bh1 = bh0 + 4, qd0 = bh0 * 8 + qp, qd1 = bh1 * 8 + (7 - qp);
                InterIn cur; InterSc sc, sc1;
                quad_prefix(lds, sc, sc1, bh0, bh1, qp, Sp, (const float*)(ws + WS_LAM), ap->out + O_STP + (size_t)l * 64 * 16384, wave, lane, tid);
                inter_load(cur, 4 * qd0, Qp, Op, Gp, Sp, wave, lane, tid);
#pragma unroll 1
                for (int k = 0; k < 2; ++k) {
                    const int qd = k == 0 ? qd0 : qd1, qn = qd1;
#pragma unroll 1
                    for (int jj = 0; jj < 3; ++jj) {
                        InterIn nxt; SampleIn sin;
                        const int su = bx + G * (2 * k + (jj >> 1)), half = jj & 1;
                        inter_load(nxt, 4 * qd + jj + 1, Qp, Op, Gp, Sp, wave, lane, tid);
                        sample_load(sin, su, half, Qp, (const bf16_t*)(ws + WS_K), Op, (const bf16_t*)(ws + WS_V), Gp, ap->in[2] + ((size_t)l * 1024 + su) * 16384, tid);
                        inter_compute(lds, 4 * qd + jj, jj & 1, cur, sc, qo, wave, lane, tid);
                        sample_compute(lds + 112640, su, half, sin, (bf16_t*)(ws + WS_Q), ap->out + O_STS + ((size_t)l * 1024 + su) * 16384, tid);
                        cur = nxt;
                    }
                    InterIn nxt; SampleIn sin;
                    const int su = bx + G * (2 * k + 1);
                    inter_load(nxt, 4 * qn, Qp, Op, Gp, Sp, wave, lane, tid);
                    sample_load(sin, su, 1, Qp, (const bf16_t*)(ws + WS_K), Op, (const bf16_t*)(ws + WS_V), Gp, ap->in[2] + ((size_t)l * 1024 + su) * 16384, tid);
                    inter_compute(lds, 4 * qd + 3, 1, cur, sc, qo, wave, lane, tid);
                    sample_compute(lds + 112640, su, 1, sin, (bf16_t*)(ws + WS_Q), ap->out + O_STS + ((size_t)l * 1024 + su) * 16384, tid);
                    cur = nxt; sc = sc1;
                }
            }
        }
        SEAM(pb + 3);
        if (IN(pb + 4)) {
            PHASE_LOCALS();
            const bf16_t* Bt = (const bf16_t*)(ws + (l == 0 ? WS_WOUT0 : WS_WOUT1));
            pg8::Gemm g{(const bf16_t*)(ws + WS_Q), Bt, TP, 1024, 1024}; pg8::StaticOrder S; S.init(TP, 1024, G, bx);
            EpiResid E{ws};
            S_OUT((l == 0 ? WS_WOUT0 : WS_WOUT1), bx, G);
            pg8::gemm_phase<EpiResid, pg8::StaticOrder, PG8_ALIGN, PG8_SP2>(lds + RING_OFF, g, S, E, tid);
        }
        SEAM(pb + 4);
    }
#pragma unroll 1
    for (int j = 0; j < 2; ++j) {
        const int pb = 11 + 3 * j;
        if (IN(pb)) {
            PHASE_LOCALS();
            const int N = j == 0 ? 2304 : 2048;
            const bf16_t* Bt = (const bf16_t*)(ws + (j == 0 ? WS_WINB0 : WS_WINB1));
            const int vcu = (bx & 7) * (G >> 3) + (bx >> 3);
            pg8::Gemm g{(const bf16_t*)(ws + WS_HB), Bt, TP, N, 1024}; pg8::PmOrder S; S.pm = vcu >> 2; S.q = vcu & 3; S.nN = N >> 8;
            EpiSwaIn E{ws, ap->out, (const LAS float*)(lds + RSTD_OFF), (const LAS float*)(lds + ROPEL_OFF)};
            stage_row_tables(ws, S.pm, lds, true, tid);
            if (j == 0) {
                const int rank = S.q < 2 ? -1 : (S.pm * 2 + S.q - 2), nr = G >> 1;
                if (rank >= 0) for (int u = rank; u < N / 16; u += nr) sgemm_unit<64, 32>(lds, g.A + (size_t)TP * DM, Bt, u, E, wave, lane, tid);
                pg8::gemm_phase<EpiSwaIn, pg8::PmOrder, PG8_ALIGN, PG8_SP2, true>(lds + RING_OFF, g, S, E, tid);
            } else {
                for (int u = bx; u < N / 8; u += G) sgemm_unit<32, 32>(lds, g.A + (size_t)TP * DM, Bt, u, E, wave, lane, tid);
                pg8::gemm_phase<EpiSwaIn, pg8::PmOrder, PG8_ALIGN, PG8_SP2, false>(lds + RING_OFF, g, S, E, tid);
            }
        }
        SEAM(pb);
        if (IN(pb + 1)) {
            PHASE_LOCALS();
            const float* sinks = ap->in[14] + j * 16;
            for (int rep = 0; rep < NREP(6); ++rep) {
            bf16_t* qo = (bf16_t*)(ws + (DUMMY(6, rep) ? WS_DUM0 : WS_Q));
            for (int u = (bx & 7) * (G >> 3) + (bx >> 3); u < 256; u += G) swa_prompt_unit(lds, u, (const bf16_t*)(ws + WS_Q), qo,
            (const bf16_t*)(ws + WS_G), (const bf16_t*)(ws + WS_KA), (const bf16_t*)(ws + WS_VA), sinks, wave, lane, tid);
            }
            S_ATTN(j);
        }
        SEAM(pb + 1);
        if (IN(pb + 2)) {
            PHASE_LOCALS();
            const bf16_t* Bt = (const bf16_t*)(ws + (j == 0 ? WS_WOUTB0 : WS_WOUTB1));
            pg8::Gemm g{(const bf16_t*)(ws + WS_Q), Bt, TP, 1024, 1024}; pg8::StaticOrder S; S.init(TP, 1024, G, bx);
            EpiResid E{ws};
            S_OUT((j == 0 ? WS_WOUTB0 : WS_WOUTB1), bx, G);
            pg8::gemm_phase<EpiResid, pg8::StaticOrder, PG8_ALIGN, PG8_SP2>(lds + RING_OFF, g, S, E, tid);
        }
        SEAM(pb + 2);
    }
    if (IN(17)) {
        PHASE_LOCALS();
        const int gw = bx * NWAVES + wave, NGW = G * NWAVES;
        const f32x4* fn = (const f32x4*)ap->in[16] + lane;
        const float* SSQ = (const float*)(ws + WS_SSQ); const bf16_t* HBf = (const bf16_t*)(ws + WS_HB); float* outp = ap->out;
        f32x4 gn[4];
#pragma unroll
        for (int j = 0; j < 4; ++j) gn[j] = fn[64 * j];
        const int vcu = (bx & 7) * (G >> 3) + (bx >> 3), vw = vcu * NWAVES + wave;
        for (int rep = 0; rep < NREP(8); ++rep)
        for (int i = 0; i < 9; ++i) {
            const int m = i < 8 ? (vw >> 8) * SEQ + (vw & 255) + 256 * i : TP + vw;
            if (m >= TP + TS) break;
            const float rs = m < TP ? row_rstd(SSQ, m) : row_rstd_s((const float*)(ws + WS_SSQS), m - TP);
            const u32x2* hr = (const u32x2*)(HBf + (size_t)m * DM) + lane; f32x4* o = (f32x4*)(outp + (size_t)m * DM) + lane;
#pragma unroll
            for (int j = 0; j < 4; ++j) { const u32x2 hw = hr[64 * j]; __builtin_nontemporal_store((f32x4){bflo(hw.x), bfhi(hw.x), bflo(hw.y), bfhi(hw.y)} * rs * gn[j], &o[64 * j]); }
        }
    }
#undef S_IN_A
#undef S_OUT
#undef S_STEP
#undef S_ATTN
#undef IN
#undef SEAM
#undef PHASE_LOCALS
}

#ifndef MK_PER_PHASE
#define MK_PER_PHASE 0
#endif
extern "C" void kernel_launch(void* const* d_in, const int* in_sizes, int n_in, void* d_out, int out_size, void* d_ws, size_t ws_size, hipStream_t stream) {
    static int grid = 0;
    if (grid == 0) {
        if (n_in != 17 || ws_size < WS_END) { fprintf(stderr, "kernel_launch: unexpected inputs (n_in %d, ws %zu)\n", n_in, ws_size); grid = -1; return; }
        int dev = 0, cus = 0;
        if (hipGetDevice(&dev) != hipSuccess || hipDeviceGetAttribute(&cus, hipDeviceAttributeMultiprocessorCount, dev) != hipSuccess) { grid = -1; return; }
        if (hipFuncSetAttribute((const void*)yoco_fwd, hipFuncAttributeMaxDynamicSharedMemorySize, LDS_BYTES) != hipSuccess) { grid = -1; return; }
        (void)hipGetLastError();
        grid = cus;
    }
    if (grid < 0) return;
    (void)hipMemsetAsync((char*)d_ws + WS_CTL, 0, CTL_ZERO_BYTES, stream);
    Args a{};
    for (int i = 0; i < 17; ++i) a.in[i] = (const float*)d_in[i];
    a.out = (float*)d_out; a.ws = (unsigned char*)d_ws;
#if MK_PER_PHASE
    for (int p = 0; p < 18; ++p) { a.ph_lo = p; a.ph_hi = p + 1; hipLaunchKernelGGL(yoco_fwd, dim3(grid), dim3(NWAVES * 64), LDS_BYTES, stream, a); }
#else
    a.ph_lo = 0; a.ph_hi = 18;
    hipLaunchKernelGGL(yoco_fwd, dim3(grid), dim3(NWAVES * 64), LDS_BYTES, stream, a);
#endif
}
```

```cpp
#include <hip/hip_runtime.h>
#include <cstdio>
#include <cstdint>

#define LAS __attribute__((address_space(3)))
#define GAS __attribute__((address_space(1)))
typedef unsigned short bf16_t;
typedef short bf16x8 __attribute__((ext_vector_type(8)));
typedef short s16x4 __attribute__((ext_vector_type(4)));
typedef float f32x4 __attribute__((ext_vector_type(4)));
typedef float f32x2 __attribute__((ext_vector_type(2)));
typedef unsigned u32x4 __attribute__((ext_vector_type(4)));
typedef unsigned u32x2 __attribute__((ext_vector_type(2)));

constexpr int DM = 1024;
constexpr int TP = 16384;
constexpr int TS = 128;
constexpr int MT = 16640;
constexpr int SEQ = 2048;
constexpr float NORM_EPS = 1e-6f;
constexpr size_t O_YP = 0, O_YS = 16777216, O_STP = 16908288, O_STS = 19005440, O_KWP = 52559872, O_VWP = 52690944, O_KNS = 52822016, O_VNS = 52838400;
constexpr size_t MiB = 1u << 20;
constexpr size_t WS_CTL = 0, CTL_ZERO_BYTES = 65536;
constexpr size_t WS_LB1 = 1 * MiB, WS_ROPE = 1 * MiB + 8192, WS_SSQS = 1 * MiB + 262144;
constexpr size_t WS_WIN0 = 2 * MiB, WS_WIN1 = 10 * MiB, WS_WOUT0 = 18 * MiB, WS_WOUT1 = 20 * MiB, WS_WINB0 = 22 * MiB, WS_WINB1 = 27 * MiB, WS_WOUTB0 = 31 * MiB, WS_WOUTB1 = 33 * MiB;
constexpr size_t WS_SSQ = 35 * MiB, WS_HB = 37 * MiB, WS_H = 70 * MiB, WS_Q = 136 * MiB, WS_K = 169 * MiB, WS_V = 202 * MiB, WS_G = 235 * MiB, WS_LF = 268 * MiB;
constexpr size_t WS_DS = 334 * MiB, WS_LAM = 398 * MiB, WS_KA = 399 * MiB, WS_VA = 404 * MiB, WS_END = 409 * MiB;
constexpr int CW_BAR = 4096;
constexpr size_t WS_DUM0 = 409 * MiB, WS_DUM1 = 442 * MiB;
#ifndef DUP_MASK
#define DUP_MASK 0
#endif
#define NREP(id) (((DUP_MASK >> (id)) & 1) ? 2 : 1)
#define DUMMY(id, rep) (((DUP_MASK >> (id)) & 1) && (rep) == 0)

typedef float f32x2_t __attribute__((ext_vector_type(2))); typedef __bf16 bf16x2_t __attribute__((ext_vector_type(2)));
__device__ __forceinline__ unsigned pk2(float lo, float hi) { f32x2_t v = {lo, hi}; bf16x2_t b = __builtin_convertvector(v, bf16x2_t); return __builtin_bit_cast(unsigned, b); }
__device__ __forceinline__ unsigned f2bf(float f) { return pk2(f, f) & 0xffffu; }
__device__ __forceinline__ float bflo(unsigned w) { return __builtin_bit_cast(float, w << 16); }
__device__ __forceinline__ float bfhi(unsigned w) { return __builtin_bit_cast(float, w & 0xffff0000u); }
__device__ __forceinline__ float bf1(bf16_t b) { return __builtin_bit_cast(float, (unsigned)b << 16); }
__device__ __forceinline__ float fast_rcp(float x) { return __builtin_amdgcn_rcpf(x); }
__device__ __forceinline__ float silu_f(float u) { return u * fast_rcp(1.0f + __expf(-u)); }
__device__ __forceinline__ float wave_sum(float v) {
#pragma unroll
    for (int o = 1; o < 64; o <<= 1) v += __shfl_xor(v, o);
    return v;
}
__device__ __forceinline__ float wave_max(float v) {
#pragma unroll
    for (int o = 1; o < 64; o <<= 1) v = fmaxf(v, __shfl_xor(v, o));
    return v;
}
#define LDS_WAIT() asm volatile("s_waitcnt lgkmcnt(0)" ::: "memory")
#define VM_WAIT() asm volatile("s_waitcnt vmcnt(0)" ::: "memory")
#define MFMA16(a, b, c) __builtin_amdgcn_mfma_f32_16x16x32_bf16((a), (b), (c), 0, 0, 0)

namespace pg8 {
constexpr int BM = 256, BK = 64, HALF = 128, HTB = HALF * BK * 2, STAGE_BYTES = 8 * HTB, NXCD = 8, WGM = 8;
__host__ __device__ __forceinline__ int lds_byte(int r, int c) { const int st = (r >> 4) * 2 + (c >> 5), rr = r & 15, cc = c & 31, ob = rr * 64 + cc * 2; return st * 1024 + (ob ^ (((ob >> 9) & 1) << 5)); }
__host__ __device__ __forceinline__ void stage_rc(int b, int& R, int& C) { const int st = b / 1024, sb = b % 1024, swz = sb ^ (((sb >> 9) & 1) << 5); R = (st >> 1) * 16 + swz / 64; C = (st & 1) * 32 + (swz % 64) / 2; }
__host__ __device__ __forceinline__ int perm32(int rho) { const int n = rho >> 4, i = rho & 15; return 8 * (i >> 2) + 4 * n + (i & 3); }
struct Unit { int pm, pn, hs; };
struct Gemm { const bf16_t* A; const bf16_t* Bt; int M, N, K; };
struct StaticOrder {
    int nM, nN, nwg, G, c;
    __host__ __device__ void init(int M, int N, int G_, int c_) { nM = M / BM; nN = N / BM; nwg = nM * nN; G = G_; c = c_; }
    __host__ __device__ __forceinline__ bool next(int i, Unit& u) const {
        const long L = (long)i * G + c; if (L >= nwg) return false;
        int wgid = (int)L; { const int q = nwg / NXCD, r = nwg % NXCD, xcd = wgid % NXCD, off = wgid / NXCD; wgid = (xcd < r ? xcd * (q + 1) : r * (q + 1) + (xcd - r) * q) + off; }
        const int nig = WGM * nN, gid = wgid / nig, fm = gid * WGM, gsz = (nM - fm) < WGM ? (nM - fm) : WGM;
        u.pm = fm + ((wgid % nig) % gsz); u.pn = (wgid % nig) / gsz; u.hs = 0; return true;
    }
    __device__ __forceinline__ void a_ready(const Unit&) const {}
    __device__ __forceinline__ void done(const Unit&) const {}
};
struct HeadPairOrder {
    int pm, hp, nu, rot;
    __device__ __forceinline__ bool next(int i, Unit& u) const { if (i >= nu) return false; u.pm = pm; u.pn = hp + 4 * ((i + rot) & 3); u.hs = 0; return true; }
    __device__ __forceinline__ void a_ready(const Unit&) const {}
    __device__ __forceinline__ void done(const Unit&) const {}
};
struct PmOrder {
    int pm, q, nN;
    __device__ __forceinline__ bool next(int i, Unit& u) const {
        u.pm = pm; u.hs = 0;
        if (i < 2) { u.pn = q + 4 * i; return true; }
        if (i == 2 && nN == 9 && q < 2) { u.pn = 8; u.hs = q + 1; return true; }
        return false; }
    __device__ __forceinline__ void a_ready(const Unit&) const {}
    __device__ __forceinline__ void done(const Unit&) const {}
};
template <class Epi, class Sched, bool ALIGN_EPI = false, bool SP2 = false, bool HALFN = false>
__device__ __forceinline__ void gemm_phase(LAS unsigned char* lds, const Gemm g, const Sched& S, const Epi& E, const int tid) {
    const int wid = __builtin_amdgcn_readfirstlane(tid >> 6), lane = tid & 63, wr = wid >> 2, wc = wid & 3, fr = lane & 15, fq = lane >> 4;
    const int K = g.K, nt = K / BK;
    unsigned voffA[2], voffB[2];
#pragma unroll
    for (int i = 0; i < 2; ++i) { int R, C; stage_rc(tid * 16 + i * 8192, R, C); const int Rb = Epi::PERM ? ((R & ~31) + perm32(R & 31)) : R;
        voffA[i] = (unsigned)(R * K + C) * 2u; voffB[i] = (unsigned)(Rb * K + C) * 2u; }
    const size_t kstep = (size_t)(BK * 2);
    const size_t hstep = (size_t)HALF * K * 2;
    const size_t tstep = 2 * hstep;
    const unsigned ldsw = (unsigned)wid * 1024u;
    const int aoff = lds_byte(wr * 64 + fr, fq * 8), boff = lds_byte(wc * 32 + fr, fq * 8);
#define PG8_SA(b, h) (((b) * 2 + (h)) * HTB)
#define PG8_SB(b, h) ((4 + (b) * 2 + (h)) * HTB)
#define PG8_STAGE(bufoff, gbase, voff) do { _Pragma("unroll") for (int _i = 0; _i < 2; ++_i) \
        __builtin_amdgcn_global_load_lds((const unsigned*)((const char*)(gbase) + (voff)[_i]), (LAS unsigned*)(lds + (bufoff) + ldsw + _i * 8192), 16, 0, 0); } while (0)
#define PG8_LDA(dst, b, h) do { _Pragma("unroll") for (int m = 0; m < 4; ++m) _Pragma("unroll") for (int k = 0; k < 2; ++k) dst[m][k] = *(const LAS bf16x8*)(lds + PG8_SA(b, h) + aoff + m * 2048 + k * 1024); } while (0)
#define PG8_LDB(dst, b, h) do { _Pragma("unroll") for (int n = 0; n < 2; ++n) _Pragma("unroll") for (int k = 0; k < 2; ++k) dst[n][k] = *(const LAS bf16x8*)(lds + PG8_SB(b, h) + boff + n * 2048 + k * 1024); } while (0)
#define PG8_MMA(ai, bj, At, Bt) do { __builtin_amdgcn_s_setprio(1); _Pragma("unroll") for (int m = 0; m < 4; ++m) _Pragma("unroll") for (int n = 0; n < 2; ++n) _Pragma("unroll") for (int k = 0; k < 2; ++k) \
        acc[ai][bj][m][n] = __builtin_amdgcn_mfma_f32_16x16x32_bf16(Bt[n][k], At[m][k], acc[ai][bj][m][n], 0, 0, 0); __builtin_amdgcn_s_setprio(0); } while (0)
#define PG8_MMA2(ai) do { if constexpr (HALFN) { if (cur.hs != 2) PG8_MMA(ai, 0, At, B0); if (cur.hs != 1) PG8_MMA(ai, 1, At, B1); } else { PG8_MMA(ai, 0, At, B0); PG8_MMA(ai, 1, At, B1); } } while (0)
#define PG8_WAIT_V(n) asm volatile("s_waitcnt vmcnt(" #n ")" ::: "memory")
#define PG8_WAIT_L(n) asm volatile("s_waitcnt lgkmcnt(" #n ")" ::: "memory")
#define PG8_BAR __builtin_amdgcn_s_barrier()
#define PG8_SCHED __builtin_amdgcn_sched_barrier(0)
    Unit cur, nxt; int ui = 0;
    if (!S.next(0, cur)) return;
    f32x4 acc[2][2][4][2];
#pragma unroll
    for (int a = 0; a < 2; ++a)
#pragma unroll
        for (int b = 0; b < 2; ++b)
#pragma unroll
            for (int m = 0; m < 4; ++m)
#pragma unroll
                for (int n = 0; n < 2; ++n) acc[a][b][m][n] = (f32x4){0.f, 0.f, 0.f, 0.f};
    bf16x8 At[4][2], B0[2][2], B1[2][2];
    const char* cA = (const char*)g.A + (size_t)cur.pm * tstep; const char* cB = (const char*)g.Bt + (size_t)cur.pn * tstep;
    S.a_ready(cur);
    if constexpr (SP2) {
        PG8_STAGE(PG8_SB(0, 0), cB, voffB); PG8_STAGE(PG8_SB(0, 1), cB + hstep, voffB); PG8_STAGE(PG8_SA(0, 0), cA, voffA); PG8_STAGE(PG8_SA(0, 1), cA + hstep, voffA);
        if (wr == 1) PG8_BAR;
        PG8_WAIT_V(2); PG8_BAR;
        PG8_STAGE(PG8_SB(1, 0), cB + kstep, voffB); PG8_STAGE(PG8_SA(1, 0), cA + kstep, voffA); PG8_STAGE(PG8_SB(1, 1), cB + hstep + kstep, voffB);
        PG8_WAIT_V(6); PG8_BAR;
    } else {
        PG8_STAGE(PG8_SB(0, 0), cB, voffB); PG8_STAGE(PG8_SA(0, 0), cA, voffA); PG8_STAGE(PG8_SB(0, 1), cB + hstep, voffB); PG8_STAGE(PG8_SA(0, 1), cA + hstep, voffA);
        if (wr == 1) PG8_BAR;
        PG8_WAIT_V(4); PG8_BAR;
        PG8_STAGE(PG8_SB(1, 0), cB + kstep, voffB); PG8_STAGE(PG8_SA(1, 0), cA + kstep, voffA); PG8_STAGE(PG8_SB(1, 1), cB + hstep + kstep, voffB);
        PG8_WAIT_V(6); PG8_BAR;
    }
    for (;;) {
        const bool has_next = S.next(ui + 1, nxt);
        const char* nA = has_next ? (const char*)g.A + (size_t)nxt.pm * tstep : cA; const char* nB = has_next ? (const char*)g.Bt + (size_t)nxt.pn * tstep : cB;
        for (int t = 0; t < nt; t += 2) {
            const bool last = (t == nt - 2);
            const char* a1 = cA + (size_t)(t + 1) * kstep;
            const char* a2 = last ? nA : cA + (size_t)(t + 2) * kstep; const char* b2 = last ? nB : cB + (size_t)(t + 2) * kstep;
            const char* a3 = a2 + kstep; const char* b3 = b2 + kstep;
            if (last && has_next) S.a_ready(nxt);
            if constexpr (SP2) {
            PG8_LDB(B0, 0, 0); PG8_LDB(B1, 0, 1); PG8_SCHED; PG8_LDA(At, 0, 0); PG8_STAGE(PG8_SA(1, 1), a1 + hstep, voffA);
            PG8_WAIT_V(8); PG8_WAIT_L(0); PG8_BAR; PG8_MMA2(0); PG8_BAR; PG8_SCHED;
            PG8_LDA(At, 0, 1); PG8_STAGE(PG8_SB(0, 0), b2, voffB); PG8_STAGE(PG8_SB(0, 1), b2 + hstep, voffB); PG8_STAGE(PG8_SA(0, 0), a2, voffA);
            PG8_WAIT_V(8); PG8_WAIT_L(0); PG8_BAR; PG8_MMA2(1); PG8_BAR; PG8_SCHED;
            PG8_LDB(B0, 1, 0); PG8_LDB(B1, 1, 1); PG8_SCHED; PG8_LDA(At, 1, 0); PG8_STAGE(PG8_SA(0, 1), a2 + hstep, voffA);
            PG8_WAIT_V(8); PG8_WAIT_L(0); PG8_BAR; PG8_MMA2(0); PG8_BAR; PG8_SCHED;
            PG8_LDA(At, 1, 1); PG8_STAGE(PG8_SB(1, 0), b3, voffB); PG8_STAGE(PG8_SB(1, 1), b3 + hstep, voffB); PG8_STAGE(PG8_SA(1, 0), a3, voffA);
            PG8_WAIT_V(8); PG8_WAIT_L(0); PG8_BAR; PG8_MMA2(1); PG8_BAR; PG8_SCHED;
            } else {
            PG8_LDB(B0, 0, 0); PG8_SCHED; PG8_LDA(At, 0, 0); PG8_STAGE(PG8_SA(1, 1), a1 + hstep, voffA);
            PG8_WAIT_L(8); PG8_BAR; PG8_WAIT_L(0); PG8_MMA(0, 0, At, B0); PG8_BAR; PG8_SCHED;
            PG8_LDB(B1, 0, 1); PG8_STAGE(PG8_SB(0, 0), b2, voffB);
            PG8_BAR; PG8_WAIT_L(0); PG8_MMA(0, 1, At, B1); PG8_BAR;
            PG8_LDA(At, 0, 1); PG8_STAGE(PG8_SA(0, 0), a2, voffA);
            PG8_BAR; PG8_WAIT_L(0); PG8_MMA(1, 0, At, B0); PG8_BAR; PG8_SCHED;
            PG8_STAGE(PG8_SB(0, 1), b2 + hstep, voffB);
            PG8_WAIT_V(6); PG8_BAR; PG8_MMA(1, 1, At, B1); PG8_BAR;
            PG8_LDB(B0, 1, 0); PG8_SCHED; PG8_LDA(At, 1, 0); PG8_STAGE(PG8_SA(0, 1), a2 + hstep, voffA);
            PG8_WAIT_L(8); PG8_BAR; PG8_WAIT_L(0); PG8_MMA(0, 0, At, B0); PG8_BAR; PG8_SCHED;
            PG8_LDB(B1, 1, 1); PG8_STAGE(PG8_SB(1, 0), b3, voffB);
            PG8_BAR; PG8_WAIT_L(0); PG8_MMA(0, 1, At, B1); PG8_BAR;
            PG8_LDA(At, 1, 1); PG8_STAGE(PG8_SA(1, 0), a3, voffA);
            PG8_BAR; PG8_WAIT_L(0); PG8_MMA(1, 0, At, B0); PG8_BAR; PG8_SCHED;
            PG8_STAGE(PG8_SB(1, 1), b3 + hstep, voffB);
            PG8_WAIT_V(6); PG8_BAR; PG8_MMA(1, 1, At, B1); PG8_BAR;
            }
        }
        if constexpr (ALIGN_EPI) { if (wr == 0) PG8_BAR; }
        E(acc, cur, wr, wc, fr, fq);
        if (!has_next) break;
#pragma unroll
        for (int a = 0; a < 2; ++a)
#pragma unroll
            for (int b = 0; b < 2; ++b)
#pragma unroll
                for (int m = 0; m < 4; ++m)
#pragma unroll
                    for (int n = 0; n < 2; ++n) acc[a][b][m][n] = (f32x4){0.f, 0.f, 0.f, 0.f};
        cur = nxt; cA = nA; cB = nB; ++ui;
        if constexpr (ALIGN_EPI) { if (wr == 1) PG8_BAR; }
    }
    PG8_WAIT_V(0);
    if constexpr (!ALIGN_EPI) { if (wr == 0) PG8_BAR; }
    PG8_BAR;
#undef PG8_SA
#undef PG8_SB
#undef PG8_STAGE
#undef PG8_LDA
#undef PG8_LDB
#undef PG8_MMA
#undef PG8_MMA2
#undef PG8_WAIT_V
#undef PG8_WAIT_L
#undef PG8_BAR
#undef PG8_SCHED
}
}
#ifndef PG8_SP2
#define PG8_SP2 true
#endif
#ifndef PG8_ALIGN
#define PG8_ALIGN true
#endif

__device__ __forceinline__ float row_rstd(const float* ssq, int row) {
    const f32x4* p = (const f32x4*)(ssq + (size_t)row * 16);
    const f32x4 a = p[0], b = p[1], c = p[2], d = p[3];
    const float s = ((a.x + a.y) + (a.z + a.w)) + ((b.x + b.y) + (b.z + b.w)) + ((c.x + c.y) + (c.z + c.w)) + ((d.x + d.y) + (d.z + d.w));
    return rsqrtf(s * (1.0f / DM) + NORM_EPS);
}
__device__ __forceinline__ float row_rstd_s(const float* ssqs, int n) {
    const f32x4* p = (const f32x4*)(ssqs + (size_t)n * 64); float s = 0.f;
#pragma unroll
    for (int i = 0; i < 16; ++i) { const f32x4 a = p[i]; s += (a.x + a.y) + (a.z + a.w); }
    return rsqrtf(s * (1.0f / DM) + NORM_EPS);
}
struct SsqQ { f32x4 s[4]; };
__device__ __forceinline__ SsqQ ssqs_quarter(const float* ssqs, int n, int fq) { SsqQ r; const f32x4* p = (const f32x4*)(ssqs + (size_t)n * 64 + 16 * fq);
#pragma unroll
    for (int i = 0; i < 4; ++i) r.s[i] = p[i];
    return r; }
__device__ __forceinline__ float ssqs_rstd(const SsqQ& r) {
    float s = 0.f;
#pragma unroll
    for (int i = 0; i < 4; ++i) s += (r.s[i].x + r.s[i].y) + (r.s[i].z + r.s[i].w);
    s += __shfl_xor(s, 16); s += __shfl_xor(s, 32);
    return rsqrtf(s * (1.0f / DM) + NORM_EPS);
}
__device__ __forceinline__ u32x4 pack8(const float (&v)[8]) { u32x4 w; w.x = pk2(v[0], v[1]); w.y = pk2(v[2], v[3]); w.z = pk2(v[4], v[5]); w.w = pk2(v[6], v[7]); return w; }

struct EpiHgrnIn {
    static constexpr bool PERM = true;
    unsigned char* ws; int layer; const LAS float* rstd_lds;
#define EHI_PTRS const float* ssq = (const float*)(ws + WS_SSQ); bf16_t* Q = (bf16_t*)(ws + WS_Q); bf16_t* Kb = (bf16_t*)(ws + WS_K); bf16_t* LF = (bf16_t*)(ws + WS_LF); bf16_t* V = (bf16_t*)(ws + WS_V); bf16_t* G = (bf16_t*)(ws + WS_G); \
    const float* lb = layer == 0 ? (const float*)nullptr : (const float*)(ws + WS_LB1); const float* ssqs = (const float*)(ws + WS_SSQS); (void)ssq; (void)Q; (void)Kb; (void)LF; (void)V; (void)G; (void)lb; (void)ssqs
    struct Pre { SsqQ q; f32x4 l4; };
    __device__ __forceinline__ Pre sample_pre(int row, int col, int fq) const {
        EHI_PTRS; Pre p; p.q = ssqs_quarter(ssqs, row - TP, fq); p.l4 = (f32x4){0.f, 0.f, 0.f, 0.f};
        if ((col >> 10) == 1 && lb) p.l4 = *(const f32x4*)(lb + (col & 1023));
        return p; }
    __device__ __forceinline__ void sample(const f32x4 a, int row, int col, int u, int fq, const Pre& pre) const {
        EHI_PTRS;
        const float rs = ssqs_rstd(pre.q); const int sec = col >> 10, ch = col & 1023; const size_t idx = (size_t)row * DM + ch;
        float v[4] = {a[0] * rs, a[1] * rs, a[2] * rs, a[3] * rs};
        if (sec == 0) {
#pragma unroll
            for (int j = 0; j < 4; ++j) v[j] = silu_f(v[j]);
            u32x2 w; w.x = pk2(v[0], v[1]); w.y = pk2(v[2], v[3]); *(u32x2*)(Q + idx) = w;
        } else if (sec == 1) {
            const f32x4 l4 = pre.l4;
            float lf[4];
#pragma unroll
            for (int j = 0; j < 4; ++j) { const float e = __expf(-v[j]); const float s = fast_rcp(1.0f + e); lf[j] = __logf(l4[j] + (1.0f - l4[j]) * s); }
            { u32x2 wl; wl.x = pk2(lf[0], lf[1]); wl.y = pk2(lf[2], lf[3]); *(u32x2*)(LF + idx) = wl; }
        } else if (sec == 2) {
            u32x2 w; w.x = pk2(v[0], v[1]); w.y = pk2(v[2], v[3]); *(u32x2*)(V + idx) = w;
        } else {
#pragma unroll
            for (int j = 0; j < 4; ++j) v[j] = silu_f(v[j]);
            u32x2 w; w.x = pk2(v[0], v[1]); w.y = pk2(v[2], v[3]); *(u32x2*)(G + idx) = w;
        }
    }
    __device__ __forceinline__ void operator()(const f32x4 (&acc)[2][2][4][2], const pg8::Unit& u, int wr, int wc, int fr_, int fq_) const {
        int fr = fr_, fq = fq_; asm volatile("" : "+v"(fr), "+v"(fq));
        EHI_PTRS;
        const int sec = u.pn >> 2;
        const int colb = (u.pn & 3) * 256 + wc * 32 + 8 * fq;
        float lbu[2][8];
#pragma unroll
        for (int bj = 0; bj < 2; ++bj) {
            if (sec == 1 && lb) { const f32x4 l0 = *(const f32x4*)(lb + colb + bj * 128), l1 = *(const f32x4*)(lb + colb + bj * 128 + 4); lbu[bj][0] = l0.x; lbu[bj][1] = l0.y; lbu[bj][2] = l0.z; lbu[bj][3] = l0.w; lbu[bj][4] = l1.x; lbu[bj][5] = l1.y; lbu[bj][6] = l1.z; lbu[bj][7] = l1.w; }
            else {
#pragma unroll
                for (int j = 0; j < 8; ++j) lbu[bj][j] = 0.f; }
        }
#pragma unroll
        for (int ai = 0; ai < 2; ++ai)
#pragma unroll
            for (int m = 0; m < 4; ++m) {
                const int row = u.pm * 256 + ai * 128 + wr * 64 + m * 16 + fr;
                const float rs = rstd_lds[ai * 128 + wr * 64 + m * 16 + fr];
#pragma unroll
                for (int bj = 0; bj < 2; ++bj) {
                    const int col = colb + bj * 128; const size_t idx = (size_t)row * DM + col;
                    float v[8];
#pragma unroll
                    for (int j = 0; j < 4; ++j) { v[j] = acc[ai][bj][m][0][j] * rs; v[4 + j] = acc[ai][bj][m][1][j] * rs; }
                    if (sec == 0) {
#pragma unroll
                        for (int j = 0; j < 8; ++j) v[j] = silu_f(v[j]);
                        *(u32x4*)(Q + idx) = pack8(v);
                    } else if (sec == 1) {
                        float lbv[8];
#pragma unroll
                        for (int j = 0; j < 8; ++j) lbv[j] = lbu[bj][j];
                        float lf[8];
#pragma unroll
                        for (int j = 0; j < 8; ++j) { const float e = __expf(-v[j]); const float s = fast_rcp(1.0f + e); lf[j] = __logf(lbv[j] + (1.0f - lbv[j]) * s); }
                        *(u32x4*)(LF + idx) = pack8(lf);
                    } else if (sec == 2) {
                        *(u32x4*)(V + idx) = pack8(v);
                    } else {
#pragma unroll
                        for (int j = 0; j < 8; ++j) v[j] = silu_f(v[j]);
                        *(u32x4*)(G + idx) = pack8(v);
                    }
                }
            }
    }
};

struct EpiResid {
    static constexpr bool PERM = true;
    unsigned char* ws;
#define ERS_PTRS const bf16_t* Hold = (const bf16_t*)(ws + WS_HB); bf16_t* HB = (bf16_t*)(ws + WS_HB); float* ssq = (float*)(ws + WS_SSQ); float* ssqs = (float*)(ws + WS_SSQS); (void)ssq; (void)ssqs
    struct Pre { u32x2 hw; };
    __device__ __forceinline__ Pre sample_pre(int row, int col, int fq) const { ERS_PTRS; Pre p; p.hw = *(const u32x2*)(Hold + (size_t)row * DM + col); return p; }
    __device__ __forceinline__ void sample(const f32x4 a, int row, int col, int u, int fq, const Pre& pre) const {
        ERS_PTRS;
        const size_t idx = (size_t)row * DM + col;
        const u32x2 hw = pre.hw;
        f32x4 o = {bflo(hw.x), bfhi(hw.x), bflo(hw.y), bfhi(hw.y)}; o += a;
        u32x2 w; w.x = pk2(o.x, o.y); w.y = pk2(o.z, o.w); *(u32x2*)(HB + idx) = w;
        float part = (o.x * o.x + o.y * o.y) + (o.z * o.z + o.w * o.w);
        part += __shfl_xor(part, 16); part += __shfl_xor(part, 32);
        if (fq == 0) ssqs[(size_t)(row - TP) * 64 + u] = part;
    }
    __device__ __forceinline__ void operator()(const f32x4 (&acc)[2][2][4][2], const pg8::Unit& u, int wr, int wc, int fr_, int fq_) const {
        int fr = fr_, fq = fq_; asm volatile("" : "+v"(fr), "+v"(fq));
        ERS_PTRS;
        const int col0 = u.pn * 256 + wc * 32 + 8 * fq;
#pragma unroll
        for (int ai = 0; ai < 2; ++ai) {
        u32x4 hpre[4][2];
#pragma unroll
            for (int m = 0; m < 4; ++m)
#pragma unroll
                for (int bj = 0; bj < 2; ++bj) hpre[m][bj] = *(const u32x4*)(Hold + (size_t)(u.pm * 256 + ai * 128 + wr * 64 + m * 16 + fr) * DM + col0 + bj * 128);
        __builtin_amdgcn_sched_barrier(0);
#pragma unroll
            for (int m = 0; m < 4; ++m) {
                const int row = u.pm * 256 + ai * 128 + wr * 64 + m * 16 + fr;
                float part = 0.f;
#pragma unroll
                for (int bj = 0; bj < 2; ++bj) {
                    const int col = col0 + bj * 128; const size_t idx = (size_t)row * DM + col;
                    const u32x4 hw = hpre[m][bj];
                    f32x4 o0 = {bflo(hw.x), bfhi(hw.x), bflo(hw.y), bfhi(hw.y)}, o1 = {bflo(hw.z), bfhi(hw.z), bflo(hw.w), bfhi(hw.w)};
                    o0 += acc[ai][bj][m][0]; o1 += acc[ai][bj][m][1];
                    u32x4 w; w.x = pk2(o0.x, o0.y); w.y = pk2(o0.z, o0.w); w.z = pk2(o1.x, o1.y); w.w = pk2(o1.z, o1.w);
                    *(u32x4*)(HB + idx) = w;
                    part += (o0.x * o0.x + o0.y * o0.y) + (o0.z * o0.z + o0.w * o0.w) + (o1.x * o1.x + o1.y * o1.y) + (o1.z * o1.z + o1.w * o1.w);
                }
                part += __shfl_xor(part, 16); part += __shfl_xor(part, 32);
                if (fq == 0) ssq[(size_t)row * 16 + u.pn * 4 + wc] = part;
            }
        }
    }
};

struct EpiSwaIn {
    static constexpr bool PERM = true;
    unsigned char* ws; float* out; const LAS float* rstd_lds; const LAS float* rope_lds;
#define ESI_PTRS const float* ssq = (const float*)(ws + WS_SSQ); const float* rope = (const float*)(ws + WS_ROPE); bf16_t* QA = (bf16_t*)(ws + WS_Q); bf16_t* GA = (bf16_t*)(ws + WS_G); bf16_t* KA = (bf16_t*)(ws + WS_KA); bf16_t* VA = (bf16_t*)(ws + WS_VA); \
    const float* ssqs = (const float*)(ws + WS_SSQS); (void)ssq; (void)rope; (void)QA; (void)GA; (void)KA; (void)VA; (void)ssqs
    struct Pre { SsqQ q; f32x4 c4, s4; };
    __device__ __forceinline__ Pre sample_pre(int row, int col, int fq) const {
        ESI_PTRS; Pre p; p.q = ssqs_quarter(ssqs, row - TP, fq);
        const float* rp = rope + (size_t)SEQ * 16 + ((4 * fq) & 7); p.c4 = *(const f32x4*)rp; p.s4 = *(const f32x4*)(rp + 8);
        return p; }
    __device__ __forceinline__ void sample(const f32x4 a, int row, int col, int u, int fq, const Pre& pre) const {
        ESI_PTRS;
        const float rs = ssqs_rstd(pre.q);
        float v[4] = {a[0] * rs, a[1] * rs, a[2] * rs, a[3] * rs};
        const int sec = col < 1024 ? 0 : col < 2048 ? 1 : col < 2176 ? 2 : 3;
        if ((sec == 0 || sec == 2) && ((16 * u) & 63) == 0) {
#pragma unroll
            for (int r = 0; r < 4; ++r) { const float pr = __shfl_xor(v[r], 32); const float c = pre.c4[r], s = pre.s4[r];
                v[r] = fq < 2 ? v[r] * c - pr * s : v[r] * c + pr * s; }
        }
        if (sec == 0) {
#pragma unroll
            for (int j = 0; j < 4; ++j) v[j] *= 0.18033688011112042f;
            u32x2 w; w.x = pk2(v[0], v[1]); w.y = pk2(v[2], v[3]); *(u32x2*)(QA + (size_t)row * DM + col) = w;
        } else if (sec == 1) {
#pragma unroll
            for (int j = 0; j < 4; ++j) v[j] = silu_f(v[j]);
            u32x2 w; w.x = pk2(v[0], v[1]); w.y = pk2(v[2], v[3]); *(u32x2*)(GA + (size_t)row * DM + (col - 1024)) = w;
        } else {
            const int kc = sec == 2 ? col - 2048 : col - 2176;
            u32x2 w; w.x = pk2(v[0], v[1]); w.y = pk2(v[2], v[3]); *(u32x2*)((sec == 2 ? KA : VA) + (size_t)row * 128 + kc) = w;
            *(f32x4*)(out + (sec == 2 ? O_KNS : O_VNS) + (size_t)(row - TP) * 128 + kc) = (f32x4){v[0], v[1], v[2], v[3]};
        }
    }
    __device__ __forceinline__ void operator()(const f32x4 (&acc)[2][2][4][2], const pg8::Unit& u, int wr, int wc, int fr_, int fq_) const {
        int fr = fr_, fq = fq_; asm volatile("" : "+v"(fr), "+v"(fq));
        ESI_PTRS;
        const int sec = u.pn >> 2;
        const int colb = (u.pn & 3) * 256 + wc * 32 + 8 * fq;
        const bool rot_wave = (wc & 1) == 0;
#pragma unroll
        for (int ai = 0; ai < 2; ++ai)
#pragma unroll
            for (int m = 0; m < 4; ++m) {
                const int row = u.pm * 256 + ai * 128 + wr * 64 + m * 16 + fr;
                const int rl = ai * 128 + wr * 64 + m * 16 + fr;
                const float rs = rstd_lds[rl];
                float cs[8], sn[8];
                if (sec != 1 && rot_wave) {
                    const LAS f32x4* rp = (const LAS f32x4*)(rope_lds + rl * 16);
                    const f32x4 c0 = rp[0], c1 = rp[1], s0 = rp[2], s1 = rp[3];
                    cs[0] = c0.x; cs[1] = c0.y; cs[2] = c0.z; cs[3] = c0.w; cs[4] = c1.x; cs[5] = c1.y; cs[6] = c1.z; cs[7] = c1.w;
                    sn[0] = s0.x; sn[1] = s0.y; sn[2] = s0.z; sn[3] = s0.w; sn[4] = s1.x; sn[5] = s1.y; sn[6] = s1.z; sn[7] = s1.w;
                }
#pragma unroll
                for (int bj = 0; bj < 2; ++bj) {
                    if (u.hs != 0 && bj != u.hs - 1) continue;
                    float v[8];
#pragma unroll
                    for (int j = 0; j < 4; ++j) { v[j] = acc[ai][bj][m][0][j] * rs; v[4 + j] = acc[ai][bj][m][1][j] * rs; }
                    if (sec == 0) {
                        const int col = colb + bj * 128; const size_t idx = (size_t)row * DM + col;
                        if (rot_wave) {
                            float pr[8];
#pragma unroll
                            for (int j = 0; j < 8; ++j) pr[j] = __shfl_xor(v[j], 16);
                            if (fq < 2) { const float sg = fq == 0 ? -1.0f : 1.0f;
#pragma unroll
                                for (int j = 0; j < 8; ++j) v[j] = v[j] * cs[j] + sg * pr[j] * sn[j]; }
                        }
#pragma unroll
                        for (int j = 0; j < 8; ++j) v[j] *= 0.18033688011112042f;
                        *(u32x4*)(QA + idx) = pack8(v);
                    } else if (sec == 1) {
                        const int col = colb + bj * 128; const size_t idx = (size_t)row * DM + col;
#pragma unroll
                        for (int j = 0; j < 8; ++j) v[j] = silu_f(v[j]);
                        *(u32x4*)(GA + idx) = pack8(v);
                    } else {
                        const int kc = wc * 32 + 8 * fq;
                        const size_t idx = (size_t)row * 128 + kc;
                        if (bj == 0 && rot_wave) {
                            float pr[8];
#pragma unroll
                            for (int j = 0; j < 8; ++j) pr[j] = __shfl_xor(v[j], 16);
                            if (fq < 2) { const float sg = fq == 0 ? -1.0f : 1.0f;
#pragma unroll
                                for (int j = 0; j < 8; ++j) v[j] = v[j] * cs[j] + sg * pr[j] * sn[j]; }
                        }
                        *(u32x4*)((bj == 0 ? KA : VA) + idx) = pack8(v);
                        float* dst = nullptr;
                        if (row < TP) { const int t = row & (SEQ - 1); if (t >= SEQ - 128) dst = out + (bj == 0 ? O_KWP : O_VWP) + ((size_t)((row >> 11) * 128 + (t - (SEQ - 128))) * 128 + kc); }
                        else if (row < TP + TS) dst = out + (bj == 0 ? O_KNS : O_VNS) + ((size_t)(row - TP) * 128 + kc);
                        if (dst) { *(f32x4*)dst = (f32x4){v[0], v[1], v[2], v[3]}; *(f32x4*)(dst + 4) = (f32x4){v[4], v[5], v[6], v[7]}; }
                    }
                }
            }
    }
};

#define LDS_BARRIER() asm volatile("s_waitcnt lgkmcnt(0)\n\ts_barrier" ::: "memory")
template <int ROWS, int COLS, class Epi>
__device__ __forceinline__ void sgemm_unit(LAS unsigned char* lds, const bf16_t* HBs, const bf16_t* Bt, int u, const Epi& E, int wave, int lane, const int tid) {
    constexpr int KC = 256, NCH = 1024 / KC;
    constexpr int XP = KC * 2 + 16, XBUF = (ROWS + COLS) * XP;
    constexpr int NLX = ROWS / 16, NLW = (COLS * 32 + 511) / 512;
    constexpr int NRG = 128 / ROWS;
    const int cgu = u / NRG, row0 = ROWS * (u % NRG), col0 = COLS * cgu;
    const int fr = lane & 15, fq = lane >> 4;
    const int rt = COLS == 16 ? wave : (wave & 3), ct = COLS == 16 ? 0 : (wave >> 2);
    const int lr = tid >> 5, lc = tid & 31;
    const bool wl = COLS * 32 >= 512 || tid < COLS * 32;
    const bf16_t* xa = HBs + (size_t)(row0 + lr) * DM + lc * 8;
    const bf16_t* wa = Bt + (size_t)(col0 + (lr & (COLS - 1))) * DM + lc * 8;
    u32x4 xr[NCH][NLX], wv[NCH][NLW];
#pragma unroll
    for (int c = 0; c < NCH; ++c) {
#pragma unroll
        for (int i = 0; i < NLX; ++i) xr[c][i] = *(const u32x4*)(xa + (size_t)16 * i * DM + KC * c);
#pragma unroll
        for (int i = 0; i < NLW; ++i) { if (wl) wv[c][i] = *(const u32x4*)(wa + (size_t)16 * i * DM + KC * c); }
    }
    const int srow = TP + row0 + 16 * rt + fr, scol = col0 + 16 * ct + 4 * fq;
    typename Epi::Pre pre;
    if (16 * rt < ROWS) pre = E.sample_pre(srow, scol, fq);
    f32x4 acc = {0.f, 0.f, 0.f, 0.f};
#pragma unroll
    for (int c = 0; c < NCH; ++c) {
        LAS unsigned char* buf = lds + (c & 1) * XBUF;
#pragma unroll
        for (int i = 0; i < NLX; ++i) *(LAS u32x4*)(buf + (lr + 16 * i) * XP + lc * 16) = xr[c][i];
#pragma unroll
        for (int i = 0; i < NLW; ++i) { if (wl) *(LAS u32x4*)(buf + (ROWS + lr + 16 * i) * XP + lc * 16) = wv[c][i]; }
        LDS_BARRIER();
        if (16 * rt < ROWS) {
#pragma unroll
            for (int k4 = 0; k4 < KC / 32; k4 += 4) {
                bf16x8 xf[4], wf[4];
#pragma unroll
                for (int i = 0; i < 4; ++i) {
                    xf[i] = *(const LAS bf16x8*)(buf + (16 * rt + fr) * XP + (32 * (k4 + i) + 8 * fq) * 2);
                    wf[i] = *(const LAS bf16x8*)(buf + (ROWS + 16 * ct + fr) * XP + (32 * (k4 + i) + 8 * fq) * 2); }
                __builtin_amdgcn_sched_barrier(0);
#pragma unroll
                for (int i = 0; i < 4; ++i) acc = MFMA16(wf[i], xf[i], acc);
                __builtin_amdgcn_sched_barrier(0);
            }
        }
    }
    LDS_BARRIER();
    if (16 * rt < ROWS) E.sample(acc, srow, scol, (col0 >> 4) + ct, fq, pre);
}

#define XB_TMO      128
#define XB_XCNT(j)  (256  + 64 * (j))
#define XB_XSUB(j)  (1280 + 64 * (j))
#define XB_XGEN(j)  (2304 + 64 * (j))
#define XB_TOP      3328
#define XB_TOPGEN   3392
#define XCD_BAR_WORDS 3456
#define XB_SPIN_CAP (1u << 18)
__device__ __forceinline__ unsigned xb_ld(unsigned* p)              { return __hip_atomic_load(p, __ATOMIC_RELAXED, __HIP_MEMORY_SCOPE_AGENT); }
__device__ __forceinline__ unsigned xb_add(unsigned* p, unsigned v) { return __hip_atomic_fetch_add(p, v, __ATOMIC_RELAXED, __HIP_MEMORY_SCOPE_AGENT); }
__device__ __forceinline__ unsigned xb_xcc_id() { return (unsigned)__builtin_amdgcn_s_getreg((3 << 11) | 20) & 0xFu; }
#define XB_SPIN(cond, bar) do { unsigned _sp = 0; while (cond) { __builtin_amdgcn_s_sleep(1); \
    if ((++_sp & 255u) == 0u) { if (xb_ld(&(bar)[XB_TMO])) break; if (_sp > XB_SPIN_CAP) { atomicAdd(&(bar)[XB_TMO], 1u); break; } } } } while (0)
struct XcdBarrier { unsigned* bar; unsigned x; volatile LAS unsigned* st; };
__device__ __forceinline__ XcdBarrier xcd_barrier_post(unsigned* bar, volatile LAS unsigned* st) {
    XcdBarrier b; b.bar = bar; b.x = xb_xcc_id(); b.st = st;
    if (threadIdx.x == 0) (void)xb_add(&bar[XB_XCNT(b.x)], 1u);
    return b;
}
__device__ __forceinline__ void xcd_barrier_complete(unsigned* bar, unsigned x, unsigned& nloc, unsigned& nx) {
    const unsigned G = gridDim.x * gridDim.y * gridDim.z;
    unsigned sum, cnt, mine, sp = 0u;
    for (;;) {
        sum = 0u; cnt = 0u; mine = 0u;
#pragma unroll
        for (unsigned j = 0; j < 16; ++j) { const unsigned c = xb_ld(&bar[XB_XCNT(j)]); sum += c; cnt += (c > 0u) ? 1u : 0u; mine = (j == x) ? c : mine; }
        if (sum == G) break;
        __builtin_amdgcn_s_sleep(1);
        if ((++sp & 255u) == 0u) { if (xb_ld(&bar[XB_TMO])) break; if (sp > XB_SPIN_CAP) { atomicAdd(&bar[XB_TMO], 1u); break; } }
    }
    nloc = mine > 0u ? mine : 1u; nx = cnt > 0u ? cnt : 1u;
}
__device__ __forceinline__ void xcd_barrier(const XcdBarrier& b) {
    asm volatile("s_waitcnt vmcnt(0)" ::: "memory");
    __syncthreads();
    if (threadIdx.x == 0) {
        unsigned* bar = b.bar;
        __builtin_amdgcn_s_waitcnt(0);
        unsigned nloc = b.st[0], nx = b.st[1];
        if (nloc == 0u) { xcd_barrier_complete(bar, b.x, nloc, nx); b.st[0] = nloc; b.st[1] = nx; }
        const unsigned old = xb_add(&bar[XB_XSUB(b.x)], 1u);
        const unsigned gen = old / nloc;
        if (old + 1u == (gen + 1u) * nloc) {
            __builtin_amdgcn_fence(__ATOMIC_RELEASE, "agent");
            asm volatile("s_waitcnt vmcnt(0)" ::: "memory");
            const unsigned og = xb_add(&bar[XB_TOP], 1u);
            const unsigned tg = og / nx;
            if (og + 1u == (tg + 1u) * nx) xb_add(&bar[XB_TOPGEN], 1u);
            else XB_SPIN(xb_ld(&bar[XB_TOPGEN]) == tg, bar);
            __builtin_amdgcn_fence(__ATOMIC_ACQUIRE, "agent");
            xb_add(&bar[XB_XGEN(b.x)], 1u);
            asm volatile("s_waitcnt vmcnt(0)" ::: "memory");
        } else {
            XB_SPIN(xb_ld(&bar[XB_XGEN(b.x)]) == gen, bar);
            __builtin_amdgcn_fence(__ATOMIC_ACQUIRE, "agent");
            asm volatile("s_waitcnt vmcnt(0)" ::: "memory");
        }
    }
    __syncthreads();
}

constexpr int RING_OFF = 0, RING_BYTES = 131072;
constexpr int LDSCTL_OFF = RING_BYTES, MISC_OFF = LDSCTL_OFF + 320;
constexpr int RSTD_OFF = 131584, ROPEL_OFF = 132608;
constexpr int LDS_BYTES = 155648;
constexpr int NWAVES = 8;

struct Args {
    const float* in[17]; float* out; unsigned char* ws; int ph_lo, ph_hi;
};
typedef const Args __attribute__((address_space(4)))* KArgPtr;
__device__ __forceinline__ KArgPtr kargs() { KArgPtr p = (KArgPtr)__builtin_amdgcn_kernarg_segment_ptr(); asm volatile("" : "+s"(p)); return p; }
__device__ __forceinline__ int fresh_tid() { int t = threadIdx.x; asm volatile("" : "+v"(t)); return t; }

__device__ __forceinline__ void stage_row_tables(unsigned char* ws, int pm, LAS unsigned char* lds, bool with_rope, const int tid) {
    if (tid < 256) ((LAS float*)(lds + RSTD_OFF))[tid] = row_rstd((const float*)(ws + WS_SSQ), pm * 256 + tid);
    if (with_rope) {
        const f32x4* rope = (const f32x4*)(ws + WS_ROPE);
#pragma unroll
        for (int i = 0; i < 2; ++i) { const int v = tid + 512 * i, r = v >> 2, part = v & 3; ((LAS f32x4*)(lds + ROPEL_OFF))[v] = rope[(size_t)((pm * 256 + r) & (SEQ - 1)) * 4 + part]; }
    }
    __syncthreads();
}

__device__ __forceinline__ void p0_transpose_item(const float* W, const float* scale, int smask, int K, int N, bf16_t* WT, int row_off, LAS float* scr, int item, int lane) {
    const int nblk = N / 32, kb = item / nblk, nb = item % nblk, k0 = 64 * kb, n0 = 32 * nb;
#pragma unroll 8
    for (int i = 0; i < 32; ++i) { const int kk = 2 * i + (lane >> 5); const float sc = scale ? scale[(k0 + kk) & smask] : 1.0f;
        scr[kk * 33 + (lane & 31)] = __builtin_nontemporal_load(W + (size_t)(k0 + kk) * N + n0 + (lane & 31)) * sc; }
    LDS_WAIT(); asm volatile("" ::: "memory");
    const int c = lane & 7;
#pragma unroll
    for (int j = 0; j < 4; ++j) { const int n = (lane >> 3) + 8 * j; const LAS float* s = scr + (8 * c) * 33 + n;
        u32x4 o; o.x = pk2(s[0 * 33], s[1 * 33]); o.y = pk2(s[2 * 33], s[3 * 33]); o.z = pk2(s[4 * 33], s[5 * 33]); o.w = pk2(s[6 * 33], s[7 * 33]);
        *(u32x4*)(WT + (size_t)(row_off + n0 + n) * K + k0 + 8 * c) = o; }
    LDS_WAIT(); asm volatile("" ::: "memory");
}

__device__ __forceinline__ void p0_prologue(KArgPtr Ap, LAS unsigned char* lds, int wave, int lane) {
    unsigned char* ws = Ap->ws;
    LAS float* scr = (LAS float*)(lds + RING_OFF + wave * 16384);
    const int G = gridDim.x, gw = blockIdx.x * NWAVES + wave, NGW = G * NWAVES;
    constexpr int I_AIN = 16 * 128, I_SQ = 16 * 32, I_BIN = 16 * 64, I_KV = 16 * 8;
    constexpr int NITEMS = 2 * I_AIN + 2 * I_SQ + 2 * I_BIN + I_KV + 2 * I_SQ;
    for (int it = gw; it < NITEMS; it += NGW) {
        int r = it;
        if (r < I_AIN) { p0_transpose_item(Ap->in[6], Ap->in[5], 1023, 1024, 4096, (bf16_t*)(ws + WS_WIN0), 0, scr, r, lane); continue; } r -= I_AIN;
        if (r < I_AIN) { p0_transpose_item(Ap->in[6] + (size_t)1024 * 4096, Ap->in[5] + 1024, 1023, 1024, 4096, (bf16_t*)(ws + WS_WIN1), 0, scr, r, lane); continue; } r -= I_AIN;
        if (r < I_SQ) { p0_transpose_item(Ap->in[9], Ap->in[8], 127, 1024, 1024, (bf16_t*)(ws + WS_WOUT0), 0, scr, r, lane); continue; } r -= I_SQ;
        if (r < I_SQ) { p0_transpose_item(Ap->in[9] + (size_t)1024 * 1024, Ap->in[8] + 128, 127, 1024, 1024, (bf16_t*)(ws + WS_WOUT1), 0, scr, r, lane); continue; } r -= I_SQ;
        if (r < I_BIN) { p0_transpose_item(Ap->in[13], Ap->in[12], 1023, 1024, 2048, (bf16_t*)(ws + WS_WINB0), 0, scr, r, lane); continue; } r -= I_BIN;
        if (r < I_BIN) { p0_transpose_item(Ap->in[13] + (size_t)1024 * 2048, Ap->in[12] + 1024, 1023, 1024, 2048, (bf16_t*)(ws + WS_WINB1), 0, scr, r, lane); continue; } r -= I_BIN;
        if (r < I_KV) { p0_transpose_item(Ap->in[11], Ap->in[10], 1023, 1024, 256, (bf16_t*)(ws + WS_WINB0), 2048, scr, r, lane); continue; } r -= I_KV;
        if (r < I_SQ) { p0_transpose_item(Ap->in[15], nullptr, 0, 1024, 1024, (bf16_t*)(ws + WS_WOUTB0), 0, scr, r, lane); continue; } r -= I_SQ;
        p0_transpose_item(Ap->in[15] + (size_t)1024 * 1024, nullptr, 0, 1024, 1024, (bf16_t*)(ws + WS_WOUTB1), 0, scr, r, lane);
    }
    bf16_t* HB = (bf16_t*)(ws + WS_HB); float* SSQ = (float*)(ws + WS_SSQ);
    float* SSQS = (float*)(ws + WS_SSQS);
    for (int m = gw; m < TP + TS; m += NGW) {
        f32x4 v[4]; float s = 0.f;
        if (m < TP + TS) {
            const f32x4* xr = (const f32x4*)(m < TP ? Ap->in[0] + (size_t)m * DM : Ap->in[1] + (size_t)(m - TP) * DM) + lane;
#pragma unroll
            for (int j = 0; j < 4; ++j) { v[j] = __builtin_nontemporal_load(xr + 64 * j); s += (v[j].x * v[j].x + v[j].y * v[j].y) + (v[j].z * v[j].z + v[j].w * v[j].w); }
        } else {
#pragma unroll
            for (int j = 0; j < 4; ++j) v[j] = (f32x4){0.f, 0.f, 0.f, 0.f};
        }
        s = wave_sum(s);
        u32x2* o8 = (u32x2*)(HB + (size_t)m * DM) + lane;
#pragma unroll
        for (int j = 0; j < 4; ++j) { u32x2 w; w.x = pk2(v[j].x, v[j].y); w.y = pk2(v[j].z, v[j].w); o8[64 * j] = w; }
        if (m < TP) { if (lane < 16) SSQ[(size_t)m * 16 + lane] = lane == 0 ? s : 0.f; }
        else SSQS[(size_t)(m - TP) * 64 + lane] = lane == 0 ? s : 0.f;
    }
    const int gt = blockIdx.x * (NWAVES * 64) + threadIdx.x, NGT = G * NWAVES * 64;
    float* LB1 = (float*)(ws + WS_LB1); float* ROPE = (float*)(ws + WS_ROPE);
    for (int i = gt; i < 1024; i += NGT) { const float l0 = Ap->in[7][i], l1 = Ap->in[7][1024 + i]; LB1[i] = 1.0f / (1.0f + expf(l0 - l1)); }
    for (int i = gt; i < (SEQ + 1) * 8; i += NGT) {
        const int p = i >> 3, j = i & 7; const double pos = p < SEQ ? (double)p : 8192.0;
        const double invf[8] = {1.0, 0.19392274474868576, 0.03760603093086393, 0.007292664737217109, 0.001414213562373095, 0.0002742481756762073, 5.318295896944988e-05, 1.031338537721246e-05};
        double fr_ = invf[0];
#pragma unroll
        for (int q = 1; q < 8; ++q) fr_ = (j == q) ? invf[q] : fr_;
        const double x = pos * fr_;
        const double qd = __builtin_rint(x * 0.6366197723675814);
        const double r = (x - qd * 1.5707963267948966) - qd * 6.123233995736766e-17;
        const double r2 = r * r;
        const double sr = r * (1.0 + r2 * (-1.0 / 6 + r2 * (1.0 / 120 + r2 * (-1.0 / 5040 + r2 * (1.0 / 362880 + r2 * (-1.0 / 39916800 + r2 * (1.0 / 6227020800.0)))))));
        const double cr = 1.0 + r2 * (-0.5 + r2 * (1.0 / 24 + r2 * (-1.0 / 720 + r2 * (1.0 / 40320 + r2 * (-1.0 / 3628800 + r2 * (1.0 / 479001600.0 + r2 * (-1.0 / 87178291200.0)))))));
        const int qi = ((int)((long long)qd)) & 3;
        const double sv = (qi == 0) ? sr : (qi == 1) ? cr : (qi == 2) ? -sr : -cr;
        const double cv = (qi == 0) ? cr : (qi == 1) ? -sr : (qi == 2) ? -cr : sr;
        ROPE[(size_t)p * 16 + j] = (float)cv; ROPE[(size_t)p * 16 + 8 + j] = (float)sv;
    }
}

constexpr int CP = 288, LFI_OFF = 0, QI_OFF = 18432, KI2_OFF = 36864, VI2_OFF = 55296, AM_OFF = 73728, BETA_OFF = 82944, EM_OFF = 83456, LAM1_OFF = 83968;
__device__ __forceinline__ s16x4 tr_read(const LAS unsigned char* p) { return __builtin_bit_cast(s16x4, __builtin_amdgcn_ds_read_tr16_b64_v4i16((LAS s16x4*)p)); }
struct ChunkIn { u32x4 lw[2], qv[2], vv[2]; };
__device__ __forceinline__ void chunk_load(ChunkIn& r, int unit, const bf16_t* Q, const bf16_t* Kb, const bf16_t* LF, const bf16_t* V, const int tid) {
    const int c = unit & 31, bh = unit >> 5, h = bh & 7, b = bh >> 3;
    const size_t g = ((size_t)b * SEQ + (size_t)c * 64 + (tid >> 3)) * DM + h * 128 + (tid & 7) * 8;
#pragma unroll
    for (int i = 0; i < 2; ++i) { r.lw[i] = *(const u32x4*)(LF + g + 64 * i); r.qv[i] = *(const u32x4*)(Q + g + 64 * i); r.vv[i] = *(const u32x4*)(V + g + 64 * i); }
}
__device__ __forceinline__ bf16x8 tr_frag(const LAS unsigned char* img, int kk, int col0, int fr, int fq) {
    const LAS unsigned char* p = img + (32 * kk + 4 * fq + (fr >> 2)) * CP + (col0 + 4 * (fr & 3)) * 2;
    const s16x4 lo = tr_read(p), hi = tr_read(p + 16 * CP);
    return (bf16x8){lo[0], lo[1], lo[2], lo[3], hi[0], hi[1], hi[2], hi[3]};
}
__device__ __forceinline__ void chunk_stepA(LAS unsigned char* lds, int unit, const int pos, float (&lam0)[4], const ChunkIn& r, bf16_t* Qo, float* LAM, int wave, int lane, const int tid) {
    const int c = unit & 31, bh = unit >> 5, h = bh & 7, b = bh >> 3;
    const size_t row0 = (size_t)b * SEQ + (size_t)c * 64;
    const int fr = lane & 15, fq = lane >> 4;
    LAS unsigned char* LFI = lds + LFI_OFF; LAS unsigned char* QI = lds + QI_OFF; LAS unsigned char* KI = lds + KI2_OFF; LAS unsigned char* VI = lds + VI2_OFF;
    LAS float* BETA = (LAS float*)(lds + BETA_OFF); LAS float* EM = (LAS float*)(lds + EM_OFF); LAS float* LAM1 = (LAS float*)(lds + LAM1_OFF);
    { const int lo = (tid >> 3) * CP + (tid & 7) * 16;
#pragma unroll
      for (int i = 0; i < 2; ++i) { *(LAS u32x4*)(LFI + lo + 128 * i) = r.lw[i]; *(LAS u32x4*)(QI + lo + 128 * i) = r.qv[i]; *(LAS u32x4*)(VI + lo + 128 * i) = r.vv[i]; } }
    LDS_BARRIER();
    f32x4 bt[4];
#pragma unroll
    for (int tt = 0; tt < 4; ++tt) {
        f32x4 acc = {0.f, 0.f, 0.f, 0.f};
#pragma unroll
        for (int kk = 0; kk < 2; ++kk) if (32 * kk <= 16 * tt + 15) {
            const bf16x8 a = tr_frag(LFI, kk, 16 * wave, fr, fq);
            const int t = 16 * tt + fr, s0 = 32 * kk + 4 * fq;
            bf16x8 tri;
#pragma unroll
            for (int jj = 0; jj < 8; ++jj) tri[jj] = (s0 + (jj < 4 ? jj : 12 + jj)) <= t ? (short)0x3F80 : (short)0;
            acc = MFMA16(a, tri, acc);
        }
        bt[tt] = acc;
    }
    float bmid[4], em[4];
#pragma unroll
    for (int j = 0; j < 4; ++j) {
        bmid[j] = __shfl(bt[1][j], (lane & 48) | 15);
        const float bend = __shfl(bt[3][j], (lane & 48) | 15);
        em[j] = __expf(bmid[j]);
        const float lam = __expf(bend);
        const int d = 16 * wave + 4 * fq + j;
        if (fr == 0) { BETA[d] = __expf(bend - bmid[j]); if (pos > 0) { EM[d] = em[j]; LAM1[d] = lam; } if (pos == 3) LAM[(size_t)(((unit >> 5) << 3) + ((unit & 31) >> 2)) * 128 + d] = lam0[j] * lam; }
        if (pos > 0) { em[j] *= lam0[j]; lam0[j] *= lam; } else lam0[j] = lam;
    }
#pragma unroll
    for (int tt = 0; tt < 4; ++tt) {
        const int ao = (16 * tt + fr) * CP + (16 * wave + 4 * fq) * 2;
        const u32x2 qw = *(const LAS u32x2*)(QI + ao), lw = *(const LAS u32x2*)(LFI + ao);
        const float qf[4] = {bflo(qw.x), bfhi(qw.x), bflo(qw.y), bfhi(qw.y)};
        const float kf[4] = {1.0f - __expf(bflo(lw.x)), 1.0f - __expf(bfhi(lw.x)), 1.0f - __expf(bflo(lw.y)), 1.0f - __expf(bfhi(lw.y))};
        float qt[4], kt[4], qh[4];
#pragma unroll
        for (int j = 0; j < 4; ++j) { const float e1 = __expf(bt[tt][j] - bmid[j]), e2 = __expf(bmid[j] - bt[tt][j]); qt[j] = qf[j] * e1; kt[j] = kf[j] * e2; qh[j] = qt[j] * em[j]; }
        u32x2 w; w.x = pk2(qt[0], qt[1]); w.y = pk2(qt[2], qt[3]); *(LAS u32x2*)(QI + ao) = w;
        w.x = pk2(kt[0], kt[1]); w.y = pk2(kt[2], kt[3]); *(LAS u32x2*)(KI + ao) = w;
        w.x = pk2(qh[0], qh[1]); w.y = pk2(qh[2], qh[3]); *(u32x2*)(Qo + (row0 + 16 * tt + fr) * DM + h * 128 + 16 * wave + 4 * fq) = w;
    }
    LDS_BARRIER();
}
__device__ __forceinline__ void chunk_stepBC(LAS unsigned char* lds, int unit, const int pos, f32x4 (&ds0)[8], bf16_t* LFo, bf16_t* DS, int wave, int lane) {
    const int c = unit & 31, bh = unit >> 5, h = bh & 7, b = bh >> 3;
    const size_t row0 = (size_t)b * SEQ + (size_t)c * 64;
    const int fr = lane & 15, fq = lane >> 4;
    LAS unsigned char* QI = lds + QI_OFF; LAS unsigned char* KI = lds + KI2_OFF; LAS unsigned char* VI = lds + VI2_OFF;
    LAS bf16_t* AM = (LAS bf16_t*)(lds + AM_OFF); LAS float* BETA = (LAS float*)(lds + BETA_OFF); LAS float* EM = (LAS float*)(lds + EM_OFF); LAS float* LAM1 = (LAS float*)(lds + LAM1_OFF);
#pragma unroll
    for (int ii = 0; ii < 2; ++ii) {
        const int idx = 2 * wave + ii, st = idx >> 2, tt = idx & 3;
        f32x4 acc = {0.f, 0.f, 0.f, 0.f};
        if (st <= tt) {
#pragma unroll
            for (int kk = 0; kk < 4; ++kk) {
                const bf16x8 a = *(const LAS bf16x8*)(KI + (16 * st + fr) * CP + (32 * kk + 8 * fq) * 2);
                const bf16x8 bq = *(const LAS bf16x8*)(QI + (16 * tt + fr) * CP + (32 * kk + 8 * fq) * 2);
                acc = MFMA16(a, bq, acc);
            }
        }
        const int t = 16 * tt + fr, s0 = 16 * st + 4 * fq;
        float m0 = (s0 + 0 <= t) ? acc[0] : 0.f, m1 = (s0 + 1 <= t) ? acc[1] : 0.f, m2 = (s0 + 2 <= t) ? acc[2] : 0.f, m3 = (s0 + 3 <= t) ? acc[3] : 0.f;
        u32x2 w; w.x = pk2(m0, m1); w.y = pk2(m2, m3);
        *(LAS u32x2*)(AM + t * 72 + s0) = w;
    }
    LDS_BARRIER();
    bf16x8 va[2];
#pragma unroll
    for (int kk = 0; kk < 2; ++kk) va[kk] = tr_frag(VI, kk, 16 * wave, fr, fq);
    bf16x8 sf[4];
    if (pos > 0) {
#pragma unroll
        for (int kk = 0; kk < 4; ++kk) {
            const f32x4 e0 = *(const LAS f32x4*)(EM + 32 * kk + 4 * fq), e1 = *(const LAS f32x4*)(EM + 32 * kk + 16 + 4 * fq);
            const f32x4 x0 = ds0[2 * kk] * e0, x1 = ds0[2 * kk + 1] * e1;
            u32x4 w; w.x = pk2(x0[0], x0[1]); w.y = pk2(x0[2], x0[3]); w.z = pk2(x1[0], x1[1]); w.w = pk2(x1[2], x1[3]);
            sf[kk] = __builtin_bit_cast(bf16x8, w);
        }
    }
#pragma unroll
    for (int tt = 0; tt < 4; ++tt) {
        f32x4 acc = {0.f, 0.f, 0.f, 0.f};
        if (pos > 0) {
#pragma unroll
            for (int kk = 0; kk < 4; ++kk) {
                const LAS unsigned char* qp = QI + (16 * tt + fr) * CP + (32 * kk + 4 * fq) * 2;
                const u32x2 lo = *(const LAS u32x2*)qp, hi = *(const LAS u32x2*)(qp + 32);
                u32x4 w; w.x = lo.x; w.y = lo.y; w.z = hi.x; w.w = hi.y;
                acc = MFMA16(sf[kk], __builtin_bit_cast(bf16x8, w), acc);
            }
        }
#pragma unroll
        for (int kk = 0; kk < 2; ++kk) {
            const LAS bf16_t* ap = AM + (16 * tt + fr) * 72 + 32 * kk + 4 * fq;
            const u32x2 lo = *(const LAS u32x2*)ap, hi = *(const LAS u32x2*)(ap + 16);
            u32x4 w; w.x = lo.x; w.y = lo.y; w.z = hi.x; w.w = hi.y;
            acc = MFMA16(va[kk], __builtin_bit_cast(bf16x8, w), acc);
        }
        { u32x2 wo; wo.x = pk2(acc[0], acc[1]); wo.y = pk2(acc[2], acc[3]); *(u32x2*)(LFo + (row0 + 16 * tt + fr) * DM + h * 128 + 16 * wave + 4 * fq) = wo; }
    }
#pragma unroll
    for (int dt = 0; dt < 8; ++dt) {
        f32x4 acc = {0.f, 0.f, 0.f, 0.f};
#pragma unroll
        for (int kk = 0; kk < 2; ++kk) { const bf16x8 ak = tr_frag(KI, kk, 16 * dt, fr, fq); acc = MFMA16(ak, va[kk], acc); }
        const f32x4 be = *(const LAS f32x4*)(BETA + 16 * dt + 4 * fq);
        acc *= be;
        if (pos > 0) acc += ds0[dt] * *(const LAS f32x4*)(LAM1 + 16 * dt + 4 * fq);
        if (pos == 3) {
            u32x2 w; w.x = pk2(acc[0], acc[1]); w.y = pk2(acc[2], acc[3]);
            *(u32x2*)(DS + (((size_t)(((unit >> 5) << 3) + ((unit & 31) >> 2)) * 64 + dt * 8 + wave) * 64 + lane) * 4) = w;
        } else ds0[dt] = acc;
    }
    LDS_BARRIER();
}

constexpr int C2_SETB = 65536, C2_QI = 0, C2_KI = 18432, C2_VI = 36864, C2_AM = 55296, C2_AMP = 80, C2_SM0 = 150016, C2_SM1 = 151552, C2_LFI = 131584;
__device__ __forceinline__ LAS unsigned char* c2_set(LAS unsigned char* lds, int s) { return lds + s * C2_SETB; }
__device__ __forceinline__ LAS float* c2_small(LAS unsigned char* lds, int s) { return (LAS float*)(lds + (s ? C2_SM1 : C2_SM0)); }
__device__ __forceinline__ void chunk_A1(LAS unsigned char* lds, int s, const ChunkIn& r, const int tid) {
    LAS unsigned char* sb = c2_set(lds, s); LAS unsigned char* LFI = lds + C2_LFI;
    const int lo = (tid >> 3) * CP + (tid & 7) * 16;
#pragma unroll
    for (int i = 0; i < 2; ++i) { *(LAS u32x4*)(LFI + lo + 128 * i) = r.lw[i]; *(LAS u32x4*)(sb + C2_QI + lo + 128 * i) = r.qv[i]; *(LAS u32x4*)(sb + C2_VI + lo + 128 * i) = r.vv[i]; }
}
__device__ __forceinline__ void chunk_A2(LAS unsigned char* lds, int s, int unit, const int pos, float (&lam0)[4], bf16_t* Qo, float* LAM, int wave, int lane) {
    const int c = unit & 31, bh = unit >> 5, h = bh & 7, b = bh >> 3;
    const size_t row0 = (size_t)b * SEQ + (size_t)c * 64;
    const int fr = lane & 15, fq = lane >> 4;
    LAS unsigned char* sb = c2_set(lds, s); LAS unsigned char* LFI = lds + C2_LFI; LAS unsigned char* QI = sb + C2_QI; LAS unsigned char* KI = sb + C2_KI;
    LAS float* BETA = c2_small(lds, s); LAS float* EM = BETA + 128; LAS float* LAM1 = BETA + 256;
    f32x4 bt[4];
#pragma unroll
    for (int tt = 0; tt < 4; ++tt) {
        f32x4 acc = {0.f, 0.f, 0.f, 0.f};
#pragma unroll
        for (int kk = 0; kk < 2; ++kk) if (32 * kk <= 16 * tt + 15) {
            const bf16x8 a = tr_frag(LFI, kk, 16 * wave, fr, fq);
            const int t = 16 * tt + fr, s0 = 32 * kk + 4 * fq;
            bf16x8 tri;
#pragma unroll
            for (int jj = 0; jj < 8; ++jj) tri[jj] = (s0 + (jj < 4 ? jj : 12 + jj)) <= t ? (short)0x3F80 : (short)0;
            acc = MFMA16(a, tri, acc);
        }
        bt[tt] = acc;
    }
    float bmid[4], em[4];
#pragma unroll
    for (int j = 0; j < 4; ++j) {
        bmid[j] = __shfl(bt[1][j], (lane & 48) | 15);
        const float bend = __shfl(bt[3][j], (lane & 48) | 15);
        em[j] = __expf(bmid[j]);
        const float lam = __expf(bend);
        const int d = 16 * wave + 4 * fq + j;
        if (fr == 0) { BETA[d] = __expf(bend - bmid[j]); if (pos > 0) { EM[d] = em[j]; LAM1[d] = lam; } if (pos == 3) LAM[(size_t)(((unit >> 5) << 3) + ((unit & 31) >> 2)) * 128 + d] = lam0[j] * lam; }
        if (pos > 0) { em[j] *= lam0[j]; lam0[j] *= lam; } else lam0[j] = lam;
    }
#pragma unroll
    for (int tt = 0; tt < 4; ++tt) {
        const int ao = (16 * tt + fr) * CP + (16 * wave + 4 * fq) * 2;
        const u32x2 qw = *(const LAS u32x2*)(QI + ao), lw = *(const LAS u32x2*)(LFI + ao);
        const float qf[4] = {bflo(qw.x), bfhi(qw.x), bflo(qw.y), bfhi(qw.y)};
        const float kf[4] = {1.0f - __expf(bflo(lw.x)), 1.0f - __expf(bfhi(lw.x)), 1.0f - __expf(bflo(lw.y)), 1.0f - __expf(bfhi(lw.y))};
        float qt[4], kt[4], qh[4];
#pragma unroll
        for (int j = 0; j < 4; ++j) { const float e1 = __expf(bt[tt][j] - bmid[j]), e2 = __expf(bmid[j] - bt[tt][j]); qt[j] = qf[j] * e1; kt[j] = kf[j] * e2; qh[j] = qt[j] * em[j]; }
        u32x2 w; w.x = pk2(qt[0], qt[1]); w.y = pk2(qt[2], qt[3]); *(LAS u32x2*)(QI + ao) = w;
        w.x = pk2(kt[0], kt[1]); w.y = pk2(kt[2], kt[3]); *(LAS u32x2*)(KI + ao) = w;
        w.x = pk2(qh[0], qh[1]); w.y = pk2(qh[2], qh[3]); *(u32x2*)(Qo + (row0 + 16 * tt + fr) * DM + h * 128 + 16 * wave + 4 * fq) = w;
    }
}
__device__ __forceinline__ void chunk_B(LAS unsigned char* lds, int s, int wave, int lane) {
    const int fr = lane & 15, fq = lane >> 4;
    LAS unsigned char* sb = c2_set(lds, s); LAS unsigned char* QI = sb + C2_QI; LAS unsigned char* KI = sb + C2_KI; LAS bf16_t* AM = (LAS bf16_t*)(sb + C2_AM);
    bf16x8 ka[2][4], qa[2][4];
#pragma unroll
    for (int ii = 0; ii < 2; ++ii) {
        const int idx = 2 * wave + ii, st = idx >> 2, tt = idx & 3;
#pragma unroll
        for (int kk = 0; kk < 4; ++kk) {
            ka[ii][kk] = *(const LAS bf16x8*)(KI + (16 * st + fr) * CP + (32 * kk + 8 * fq) * 2);
            qa[ii][kk] = *(const LAS bf16x8*)(QI + (16 * tt + fr) * CP + (32 * kk + 8 * fq) * 2);
        }
    }
    __builtin_amdgcn_sched_barrier(0);
    f32x4 acc[2] = {{0.f, 0.f, 0.f, 0.f}, {0.f, 0.f, 0.f, 0.f}};
#pragma unroll
    for (int kk = 0; kk < 4; ++kk)
#pragma unroll
        for (int ii = 0; ii < 2; ++ii) acc[ii] = MFMA16(ka[ii][kk], qa[ii][kk], acc[ii]);
#pragma unroll
    for (int ii = 0; ii < 2; ++ii) {
        const int idx = 2 * wave + ii, st = idx >> 2, tt = idx & 3;
        const int t = 16 * tt + fr, s0 = 16 * st + 4 * fq;
        float m0 = (s0 + 0 <= t) ? acc[ii][0] : 0.f, m1 = (s0 + 1 <= t) ? acc[ii][1] : 0.f, m2 = (s0 + 2 <= t) ? acc[ii][2] : 0.f, m3 = (s0 + 3 <= t) ? acc[ii][3] : 0.f;
        u32x2 w; w.x = pk2(m0, m1); w.y = pk2(m2, m3);
        *(LAS u32x2*)(AM + t * C2_AMP + 32 * (st >> 1) + 8 * fq + 4 * (st & 1)) = w;
    }
}
template <int POS>
__device__ __forceinline__ void chunk_C(LAS unsigned char* lds, int s, int unit, f32x4 (&ds0)[8], bf16_t* LFo, bf16_t* DS, int wave, int lane) {
    const int c = unit & 31, bh = unit >> 5, h = bh & 7, b = bh >> 3;
    const size_t row0 = (size_t)b * SEQ + (size_t)c * 64;
    const int fr = lane & 15, fq = lane >> 4;
    LAS unsigned char* sb = c2_set(lds, s); LAS unsigned char* QI = sb + C2_QI; LAS unsigned char* KI = sb + C2_KI; LAS unsigned char* VI = sb + C2_VI; LAS bf16_t* AM = (LAS bf16_t*)(sb + C2_AM);
    LAS float* BETA = c2_small(lds, s); LAS float* EM = BETA + 128; LAS float* LAM1 = BETA + 256;
    bf16x8 va[2];
#pragma unroll
    for (int kk = 0; kk < 2; ++kk) va[kk] = tr_frag(VI, kk, 16 * wave, fr, fq);
    bf16x8 sf[4];
    if constexpr (POS > 0) {
        f32x4 ev[8];
#pragma unroll
        for (int i = 0; i < 8; ++i) ev[i] = *(const LAS f32x4*)(EM + 16 * i + 4 * fq);
#pragma unroll
        for (int kk = 0; kk < 4; ++kk) {
            const f32x4 x0 = ds0[2 * kk] * ev[2 * kk], x1 = ds0[2 * kk + 1] * ev[2 * kk + 1];
            u32x4 w; w.x = pk2(x0[0], x0[1]); w.y = pk2(x0[2], x0[3]); w.z = pk2(x1[0], x1[1]); w.w = pk2(x1[2], x1[3]);
            sf[kk] = __builtin_bit_cast(bf16x8, w);
        }
    }
#pragma unroll
    for (int tp = 0; tp < 2; ++tp) {
        u32x4 qf[2][4], af[2][2];
#pragma unroll
        for (int t2 = 0; t2 < 2; ++t2) {
            const int tt = 2 * tp + t2;
            if constexpr (POS > 0) {
#pragma unroll
                for (int kk = 0; kk < 4; ++kk) {
                    const LAS unsigned char* qp = QI + (16 * tt + fr) * CP + (32 * kk + 4 * fq) * 2;
                    const u32x2 lo = *(const volatile LAS u32x2*)qp, hi = *(const volatile LAS u32x2*)(qp + 32);
                    qf[t2][kk] = (u32x4){lo.x, lo.y, hi.x, hi.y};
                }
            }
#pragma unroll
            for (int kk = 0; kk < 2; ++kk) {
                af[t2][kk] = *(const LAS u32x4*)(AM + (16 * tt + fr) * C2_AMP + 32 * kk + 8 * fq);
            }
        }
        __builtin_amdgcn_sched_barrier(0);
#pragma unroll
        for (int t2 = 0; t2 < 2; ++t2) {
            const int tt = 2 * tp + t2;
            f32x4 acc = {0.f, 0.f, 0.f, 0.f};
            if constexpr (POS > 0) {
#pragma unroll
                for (int kk = 0; kk < 4; ++kk) acc = MFMA16(sf[kk], __builtin_bit_cast(bf16x8, qf[t2][kk]), acc);
            }
#pragma unroll
            for (int kk = 0; kk < 2; ++kk) acc = MFMA16(va[kk], __builtin_bit_cast(bf16x8, af[t2][kk]), acc);
            u32x2 wo; wo.x = pk2(acc[0], acc[1]); wo.y = pk2(acc[2], acc[3]); *(u32x2*)(LFo + (row0 + 16 * tt + fr) * DM + h * 128 + 16 * wave + 4 * fq) = wo;
        }
    }
#pragma unroll
    for (int dq = 0; dq < 2; ++dq) {
        bf16x8 kfr[4][2]; f32x4 be[4], l1[4];
#pragma unroll
        for (int d4 = 0; d4 < 4; ++d4) {
            const int dt = 4 * dq + d4;
#pragma unroll
            for (int kk = 0; kk < 2; ++kk) kfr[d4][kk] = tr_frag(KI, kk, 16 * dt, fr, fq);
            be[d4] = *(const LAS f32x4*)(BETA + 16 * dt + 4 * fq);
            if constexpr (POS > 0) l1[d4] = *(const LAS f32x4*)(LAM1 + 16 * dt + 4 * fq);
        }
        __builtin_amdgcn_sched_barrier(0);
#pragma unroll
        for (int d4 = 0; d4 < 4; ++d4) {
            const int dt = 4 * dq + d4;
            f32x4 acc = {0.f, 0.f, 0.f, 0.f};
#pragma unroll
            for (int kk = 0; kk < 2; ++kk) acc = MFMA16(kfr[d4][kk], va[kk], acc);
            acc *= be[d4];
            if constexpr (POS > 0) acc += ds0[dt] * l1[d4];
            if constexpr (POS == 3) {
                u32x2 w; w.x = pk2(acc[0], acc[1]); w.y = pk2(acc[2], acc[3]);
                *(u32x2*)(DS + (((size_t)(((unit >> 5) << 3) + ((unit & 31) >> 2)) * 64 + dt * 8 + wave) * 64 + lane) * 4) = w;
            } else ds0[dt] = acc;
        }
    }
}

__device__ __forceinline__ void hgrn_scan_phase(const bf16_t* DS, bf16_t* SCo, const float* LAM, float* stp_layer, int gt, int ngt) {
    for (int item = gt; item < 64 * 4096; item += ngt) {
        const int bh = item >> 12, tl = item & 4095, tile = tl >> 6, ln = tl & 63, dt = tile >> 3, et = tile & 7, fq = ln >> 4, fr = ln & 15;
        float S0 = 0.f, S1 = 0.f, S2 = 0.f, S3 = 0.f;
        const size_t boff = ((size_t)bh * 32768 + tile * 64 + ln) * 4;
        const float* lbase = LAM + (size_t)bh * 8 * 128 + 16 * dt + 4 * fq;
#pragma unroll 1
        for (int c0 = 0; c0 < 8; c0 += 8) {
            u32x2 dw[8]; f32x4 lam[8];
#pragma unroll
            for (int j = 0; j < 8; ++j) { dw[j] = *(const u32x2*)(DS + boff + (size_t)(c0 + j) * 16384); lam[j] = *(const f32x4*)(lbase + (c0 + j) * 128); }
#pragma unroll
            for (int j = 0; j < 8; ++j) {
                u32x2 sc; sc.x = pk2(S0, S1); sc.y = pk2(S2, S3); *(u32x2*)(SCo + boff + (size_t)(c0 + j) * 16384) = sc;
                S0 = S0 * lam[j].x + bflo(dw[j].x); S1 = S1 * lam[j].y + bfhi(dw[j].x); S2 = S2 * lam[j].z + bflo(dw[j].y); S3 = S3 * lam[j].w + bfhi(dw[j].y);
            }
        }
        float* o = stp_layer + (size_t)bh * 16384 + (size_t)(16 * dt + 4 * fq) * 128 + 16 * et + fr;
        o[0] = S0; o[128] = S1; o[256] = S2; o[384] = S3;
    }
}

struct InterIn { u32x4 q[2], o[2], g[2]; };
struct InterSc { u32x2 sc[8]; };
__device__ __forceinline__ void inter_load(InterIn& r, int unit, const bf16_t* Q, const bf16_t* OI, const bf16_t* G, const bf16_t* SC, int wave, int lane, const int tid) {
    const int c = unit & 31, bh = unit >> 5, h = bh & 7, b = bh >> 3;
    const size_t g0 = ((size_t)b * SEQ + (size_t)c * 64 + (tid >> 3)) * DM + h * 128 + (tid & 7) * 8;
#pragma unroll
    for (int i = 0; i < 2; ++i) { r.q[i] = *(const u32x4*)(Q + g0 + 64 * i); r.o[i] = *(const u32x4*)(OI + g0 + 64 * i); r.g[i] = *(const u32x4*)(G + g0 + 64 * i); }
}
__device__ __forceinline__ void inter_load_sc(InterSc& s, int unit, const bf16_t* SC, int wave, int lane) {
    const size_t su = (size_t)(((unit >> 5) << 3) + ((unit & 31) >> 2));
#pragma unroll
    for (int dt = 0; dt < 8; ++dt) s.sc[dt] = *(const u32x2*)(SC + ((su * 64 + dt * 8 + wave) * 64 + lane) * 4);
}
__device__ __forceinline__ void quad_prefix(LAS unsigned char* lds, InterSc& sc0, InterSc& sc1, int bh0, int bh1, int qp, const bf16_t* DS, const float* LAM, float* stp_layer, int wave, int lane, const int tid) {
    LAS float* lam_l = (LAS float*)lds;
    const int last_bh = qp == 7 ? bh0 : (qp == 0 ? bh1 : -1);
#define QP_SU(i_) ((i_) < 7 ? ((i_) < qp ? bh0 * 8 + (i_) : bh1 * 8 + (i_) - qp) : (last_bh >= 0 ? last_bh * 8 + 7 : bh1 * 8 + 6 - qp + (qp == 7 ? 8 * (bh0 - bh1) + 7 : 0)))
#pragma unroll
    for (int r = 0; r < 2; ++r) { const int v = tid + 512 * r, i = v >> 7, d = v & 127; lam_l[v] = LAM[(size_t)QP_SU(i) * 128 + d]; }
#define QP_LOAD(dst, i_) do { const size_t su_ = (size_t)QP_SU(i_); _Pragma("unroll") for (int dt = 0; dt < 8; ++dt) dst.sc[dt] = *(const u32x2*)(DS + ((su_ * 64 + dt * 8 + wave) * 64 + lane) * 4); } while (0)
    InterSc dq[8];
#pragma unroll
    for (int i = 0; i < 8; ++i) QP_LOAD(dq[i], i);
    __syncthreads();
    const int fq = lane >> 4, fr = lane & 15;
    f32x4 S[8];
#pragma unroll
    for (int dt = 0; dt < 8; ++dt) { S[dt] = (f32x4){0.f, 0.f, 0.f, 0.f}; sc0.sc[dt].x = 0u; sc0.sc[dt].y = 0u; }
#pragma unroll
    for (int i = 0; i < 7; ++i) {
        if (i == qp) {
#pragma unroll
            for (int dt = 0; dt < 8; ++dt) { sc0.sc[dt].x = pk2(S[dt][0], S[dt][1]); sc0.sc[dt].y = pk2(S[dt][2], S[dt][3]); S[dt] = (f32x4){0.f, 0.f, 0.f, 0.f}; }
        }
#pragma unroll
        for (int dt = 0; dt < 8; ++dt) { const f32x4 lm = *(const LAS f32x4*)(lam_l + i * 128 + 16 * dt + 4 * fq);
            S[dt] = S[dt] * lm + (f32x4){bflo(dq[i].sc[dt].x), bfhi(dq[i].sc[dt].x), bflo(dq[i].sc[dt].y), bfhi(dq[i].sc[dt].y)}; }
    }
#pragma unroll
    for (int dt = 0; dt < 8; ++dt) {
        const unsigned wx = pk2(S[dt][0], S[dt][1]), wy = pk2(S[dt][2], S[dt][3]);
        if (qp == 7) { sc0.sc[dt].x = wx; sc0.sc[dt].y = wy; sc1.sc[dt].x = 0u; sc1.sc[dt].y = 0u; } else { sc1.sc[dt].x = wx; sc1.sc[dt].y = wy; }
    }
    if (last_bh >= 0) {
        float* o = stp_layer + (size_t)last_bh * 16384 + 16 * wave + fr;
#pragma unroll
        for (int dt = 0; dt < 8; ++dt) { const f32x4 lm = *(const LAS f32x4*)(lam_l + 7 * 128 + 16 * dt + 4 * fq);
            const f32x4 e = S[dt] * lm + (f32x4){bflo(dq[7].sc[dt].x), bfhi(dq[7].sc[dt].x), bflo(dq[7].sc[dt].y), bfhi(dq[7].sc[dt].y)};
#pragma unroll
            for (int r = 0; r < 4; ++r) o[(size_t)(16 * dt + 4 * fq + r) * 128] = e[r]; }
    }
#undef QP_SU
#undef QP_LOAD
    __syncthreads();
}
__device__ __forceinline__ void inter_compute(LAS unsigned char* lds, int unit, int par, const InterIn& r, const InterSc& s, bf16_t* Qo, int wave, int lane, const int tid) {
    const int c = unit & 31, bh = unit >> 5, h = bh & 7, b = bh >> 3, fr = lane & 15, fq = lane >> 4;
    LAS bf16_t* QH = (LAS bf16_t*)(lds + par * 52224); LAS bf16_t* OT = QH + 8704; LAS bf16_t* GT = OT + 8704;
    LAS float* red = (LAS float*)(lds + 104448 + par * 2048);
    const int so = (tid >> 3) * 136 + (tid & 7) * 8;
#pragma unroll
    for (int i = 0; i < 2; ++i) { *(LAS u32x4*)(QH + so + 64 * i) = r.q[i]; *(LAS u32x4*)(OT + so + 64 * i) = r.o[i]; *(LAS u32x4*)(GT + so + 64 * i) = r.g[i]; }
    LDS_BARRIER();
    f32x4 o[4];
#pragma unroll
    for (int tt = 0; tt < 4; ++tt) { const u32x2 ow = *(const LAS u32x2*)(OT + (16 * tt + fr) * 136 + 16 * wave + 4 * fq); o[tt] = (f32x4){bflo(ow.x), bfhi(ow.x), bflo(ow.y), bfhi(ow.y)}; }
#pragma unroll
    for (int k2 = 0; k2 < 4; k2 += 2) {
        u32x4 qfr[2][4];
#pragma unroll
        for (int i = 0; i < 2; ++i)
#pragma unroll
            for (int tt = 0; tt < 4; ++tt) {
                const LAS bf16_t* qp = QH + (16 * tt + fr) * 136 + 32 * (k2 + i) + 4 * fq;
                const u32x2 lo = *(const volatile LAS u32x2*)qp, hi = *(const volatile LAS u32x2*)(qp + 16);
                qfr[i][tt] = (u32x4){lo.x, lo.y, hi.x, hi.y};
            }
        __builtin_amdgcn_sched_barrier(0);
#pragma unroll
        for (int i = 0; i < 2; ++i) {
            const int kk = k2 + i;
            u32x4 aw; aw.x = s.sc[2 * kk].x; aw.y = s.sc[2 * kk].y; aw.z = s.sc[2 * kk + 1].x; aw.w = s.sc[2 * kk + 1].y;
            const bf16x8 af = __builtin_bit_cast(bf16x8, aw);
#pragma unroll
            for (int tt = 0; tt < 4; ++tt) o[tt] = MFMA16(af, __builtin_bit_cast(bf16x8, qfr[i][tt]), o[tt]);
        }
        __builtin_amdgcn_sched_barrier(0);
    }
#pragma unroll
    for (int tt = 0; tt < 4; ++tt) {
        float p = (o[tt][0] * o[tt][0] + o[tt][1] * o[tt][1]) + (o[tt][2] * o[tt][2] + o[tt][3] * o[tt][3]);
        p += __shfl_xor(p, 16); p += __shfl_xor(p, 32);
        if (fq == 0) red[wave * 64 + 16 * tt + fr] = p;
    }
    LDS_BARRIER();
#pragma unroll
    for (int tt = 0; tt < 4; ++tt) {
        float tot = 0.f;
#pragma unroll
        for (int w2 = 0; w2 < 8; ++w2) tot += red[w2 * 64 + 16 * tt + fr];
        const float rs = rsqrtf(tot * (1.0f / 128.0f) + NORM_EPS);
        const int po = (16 * tt + fr) * 136 + 16 * wave + 4 * fq;
        const u32x2 gw = *(const LAS u32x2*)(GT + po);
        u32x2 w; w.x = pk2(o[tt][0] * rs * bflo(gw.x), o[tt][1] * rs * bfhi(gw.x)); w.y = pk2(o[tt][2] * rs * bflo(gw.y), o[tt][3] * rs * bfhi(gw.y));
        *(LAS u32x2*)(OT + po) = w;
    }
    LDS_BARRIER();
    const size_t g0 = ((size_t)b * SEQ + (size_t)c * 64 + (tid >> 3)) * DM + h * 128 + (tid & 7) * 8;
#pragma unroll
    for (int i = 0; i < 2; ++i) *(u32x4*)(Qo + g0 + 64 * i) = *(const LAS u32x4*)(OT + so + 64 * i);
}

struct SampleIn { f32x4 sv[4]; u32x2 vw; bf16_t q, lf, g; };
__device__ __forceinline__ void sample_load(SampleIn& r, int unit, int half, const bf16_t* Q, const bf16_t* Kb, const bf16_t* LF, const bf16_t* V, const bf16_t* G, const float* s0, const int tid) {
    const int n = unit >> 3, h = unit & 7;
    const size_t rb = (size_t)(TP + n) * DM + h * 128;
    const int dg = tid >> 5, e4 = (tid & 31) * 4;
#pragma unroll
    for (int dd = 0; dd < 4; ++dd) r.sv[dd] = __builtin_nontemporal_load((const f32x4*)(s0 + (size_t)(dg * 8 + half * 4 + dd) * 128 + e4));
    r.vw = *(const u32x2*)(V + rb + e4);
    const int t7 = tid & 127;
    r.q = Q[rb + t7]; r.lf = LF[rb + t7]; r.g = G[rb + t7];
}
__device__ __forceinline__ void sample_compute(LAS unsigned char* lds, int unit, int half, const SampleIn& r, bf16_t* Qo, float* s1, const int tid) {
    const int n = unit >> 3, h = unit & 7;
    const size_t rb = (size_t)(TP + n) * DM + h * 128;
    LAS float* qs = (LAS float*)lds; LAS float* ks = qs + 128; LAS float* fs = qs + 256; LAS float* part = qs + 384;
    LAS float* redw = qs + 384 + 4096;
    if (half == 0) {
        if (tid < 128) { const float f = __expf(bf1(r.lf)); qs[tid] = bf1(r.q); ks[tid] = 1.0f - f; fs[tid] = f; }
        LDS_BARRIER();
    }
    const int dg = tid >> 5, e4 = (tid & 31) * 4;
    const f32x4 v4 = {bflo(r.vw.x), bfhi(r.vw.x), bflo(r.vw.y), bfhi(r.vw.y)};
    f32x4 o4 = {0.f, 0.f, 0.f, 0.f};
#pragma unroll
    for (int dd = 0; dd < 4; ++dd) {
        const int d = dg * 8 + half * 4 + dd;
        const f32x4 sn = r.sv[dd] * fs[d] + v4 * ks[d];
        __builtin_nontemporal_store(sn, (f32x4*)(s1 + (size_t)d * 128 + e4));
        o4 += sn * qs[d];
    }
    *(LAS f32x4*)(part + (dg * 2 + half) * 128 + e4) = o4;
    if (half == 1) {
        LDS_BARRIER();
        float o = 0.f;
        if (tid < 128) {
#pragma unroll
            for (int i = 0; i < 32; ++i) o += part[i * 128 + tid];
        }
        float sq = wave_sum(o * o);
        if ((tid & 63) == 0) redw[tid >> 6] = sq;
        LDS_BARRIER();
        if (tid < 128) {
            const float tot = redw[0] + redw[1];
            const float rs = rsqrtf(tot * (1.0f / 128.0f) + NORM_EPS);
            Qo[rb + tid] = (bf16_t)f2bf(o * rs * bf1(r.g));
        }
    }
}

__device__ __forceinline__ void sample_rec_units(LAS unsigned char* lds, unsigned char* ws, const float* st_in, float* st_out, int bx, int G, const int tid) {
    const bf16_t* Qp = (const bf16_t*)(ws + WS_Q); const bf16_t* Kp = (const bf16_t*)(ws + WS_K); const bf16_t* Lp = (const bf16_t*)(ws + WS_LF); const bf16_t* Vp = (const bf16_t*)(ws + WS_V); const bf16_t* Gp = (const bf16_t*)(ws + WS_G);
    bf16_t* Qo = (bf16_t*)(ws + WS_Q);
    SampleIn c0, c1, n0, n1;
    sample_load(c0, bx, 0, Qp, Kp, Lp, Vp, Gp, st_in + (size_t)bx * 16384, tid); sample_load(c1, bx, 1, Qp, Kp, Lp, Vp, Gp, st_in + (size_t)bx * 16384, tid);
#pragma unroll 1
    for (int k = 0; k < 4; ++k) {
        const int su = bx + G * k, sn = k < 3 ? su + G : su;
        sample_load(n0, sn, 0, Qp, Kp, Lp, Vp, Gp, st_in + (size_t)sn * 16384, tid); sample_load(n1, sn, 1, Qp, Kp, Lp, Vp, Gp, st_in + (size_t)sn * 16384, tid);
        sample_compute(lds + 112640, su, 0, c0, Qo, st_out + (size_t)su * 16384, tid);
        sample_compute(lds + 112640, su, 1, c1, Qo, st_out + (size_t)su * 16384, tid);
        c0 = n0; c1 = n1;
    }
    __syncthreads();
}

constexpr int KI_OFF = 0, VI_OFF = 40960, KVP = 160;
template <bool MIDFULL>
__device__ __forceinline__ void attn_core(const LAS unsigned char* KI, const LAS unsigned char* VI, int kt0, const bf16x8 (&qf)[2], int jlo, int jhi, float sink, int fr, int fq, f32x4 (&o)[4]) {
    f32x4 s[9];
    const LAS unsigned char* kb = KI + (16 * kt0 + fr) * KVP + 16 * fq;
#pragma unroll
    for (int x3 = 0; x3 < 9; x3 += 3) {
        bf16x8 ka[3][2];
#pragma unroll
        for (int i = 0; i < 3; ++i)
#pragma unroll
            for (int kk = 0; kk < 2; ++kk) ka[i][kk] = *(const LAS bf16x8*)(kb + (x3 + i) * 16 * KVP + kk * 64);
        __builtin_amdgcn_sched_barrier(0);
#pragma unroll
        for (int i = 0; i < 3; ++i) s[x3 + i] = (f32x4){0.f, 0.f, 0.f, 0.f};
#pragma unroll
        for (int kk = 0; kk < 2; ++kk)
#pragma unroll
            for (int i = 0; i < 3; ++i) s[x3 + i] = MFMA16(ka[i][kk], qf[kk], s[x3 + i]);
        __builtin_amdgcn_sched_barrier(0);
    }
    float mx = sink;
    const int j0 = 16 * kt0 + 4 * fq;
#pragma unroll
    for (int x = 0; x < 9; ++x)
#pragma unroll
        for (int r = 0; r < 4; ++r) {
            float sv = s[x][r];
            if (!MIDFULL || x == 0 || x == 8) { const int j = j0 + 16 * x + r; const bool valid = (j >= jlo) && (j <= jhi); sv = valid ? sv : -1e30f; s[x][r] = sv; }
            mx = fmaxf(mx, sv); }
    mx = fmaxf(mx, __shfl_xor(mx, 16)); mx = fmaxf(mx, __shfl_xor(mx, 32));
    float sum = 0.f;
#pragma unroll
    for (int x = 0; x < 9; ++x)
#pragma unroll
        for (int r = 0; r < 4; ++r) { const float p = __builtin_amdgcn_exp2f(s[x][r] - mx); s[x][r] = p; sum += p; }
    sum += __shfl_xor(sum, 16); sum += __shfl_xor(sum, 32);
    const float inv = fast_rcp(sum + __builtin_amdgcn_exp2f(sink - mx));
    bf16x8 pb[5];
#pragma unroll
    for (int y = 0; y < 5; ++y) {
        u32x4 w; w.x = pk2(s[2 * y][0] * inv, s[2 * y][1] * inv); w.y = pk2(s[2 * y][2] * inv, s[2 * y][3] * inv);
        if (y < 4) { w.z = pk2(s[2 * y + 1][0] * inv, s[2 * y + 1][1] * inv); w.w = pk2(s[2 * y + 1][2] * inv, s[2 * y + 1][3] * inv); } else { w.z = 0u; w.w = 0u; }
        pb[y] = __builtin_bit_cast(bf16x8, w);
    }
    const LAS unsigned char* vb = VI + (16 * kt0 + 4 * fq + (fr >> 2)) * KVP + 8 * (fr & 3);
#pragma unroll
    for (int d2 = 0; d2 < 4; d2 += 2) {
        s16x4 lo[2][5], hi[2][4];
#pragma unroll
        for (int i = 0; i < 2; ++i)
#pragma unroll
            for (int y = 0; y < 5; ++y) { lo[i][y] = tr_read(vb + (32 * y) * KVP + 32 * (d2 + i)); if (y < 4) hi[i][y] = tr_read(vb + (32 * y + 16) * KVP + 32 * (d2 + i)); }
        __builtin_amdgcn_sched_barrier(0);
        f32x4 acc[2] = {{0.f, 0.f, 0.f, 0.f}, {0.f, 0.f, 0.f, 0.f}};
#pragma unroll
        for (int y = 0; y < 5; ++y)
#pragma unroll
            for (int i = 0; i < 2; ++i) {
                const s16x4 l = lo[i][y]; s16x4 h = {0, 0, 0, 0}; if (y < 4) h = hi[i][y];
                const bf16x8 a = {l[0], l[1], l[2], l[3], h[0], h[1], h[2], h[3]};
                acc[i] = MFMA16(a, pb[y], acc[i]);
            }
        o[d2] = acc[0]; o[d2 + 1] = acc[1];
        __builtin_amdgcn_sched_barrier(0);
    }
}

__device__ __forceinline__ void swa_prompt_unit(LAS unsigned char* lds, int unit, const bf16_t* QA, bf16_t* QAo, const bf16_t* GA, const bf16_t* KA, const bf16_t* VA, const float* sinks, int wave, int lane, const int tid) {
    const int b = unit >> 5, blk = (unit >> 1) & 15, kvh = unit & 1;
    const int R0 = b * SEQ + blk * 128;
    const int fr = lane & 15, fq = lane >> 4;
    LAS unsigned char* KI = lds + KI_OFF; LAS unsigned char* VI = lds + VI_OFF;
    const int hq = kvh * 8 + wave;
    const size_t qbase = (size_t)(R0 + fr) * DM + hq * 64;
    bf16x8 qf[8][2];
#pragma unroll
    for (int qt = 0; qt < 8; ++qt)
#pragma unroll
        for (int kk = 0; kk < 2; ++kk) qf[qt][kk] = *(const bf16x8*)(QA + qbase + (size_t)qt * 16 * DM + 32 * kk + 8 * fq);
#pragma unroll
    for (int i = 0; i < 4; ++i) {
        const int idx = tid + 512 * i, key = idx >> 3, ch = idx & 7;
        u32x4 kk = {0u, 0u, 0u, 0u}, vv = {0u, 0u, 0u, 0u};
        if (blk > 0 || key >= 128) { const size_t g = (size_t)(R0 - 128 + key) * 128 + kvh * 64 + ch * 8; kk = *(const u32x4*)(KA + g); vv = *(const u32x4*)(VA + g); }
        *(LAS u32x4*)(KI + key * KVP + ch * 16) = kk; *(LAS u32x4*)(VI + key * KVP + ch * 16) = vv;
    }
    const float sink = sinks[hq] * 1.4426950408889634f;
    __syncthreads();
#pragma unroll
    for (int qt = 0; qt < 8; ++qt) {
        const size_t idx0 = qbase + (size_t)qt * 16 * DM + 4 * fq;
        u32x2 gw[4];
#pragma unroll
        for (int dt = 0; dt < 4; ++dt) gw[dt] = *(const u32x2*)(GA + idx0 + 16 * dt);
        const int tq = 16 * qt + fr;
        f32x4 o[4];
        if (blk > 0) attn_core<true>(KI, VI, qt, qf[qt], tq, tq + 128, sink, fr, fq, o);
        else attn_core<false>(KI, VI, qt, qf[qt], tq > 128 ? tq : 128, tq + 128, sink, fr, fq, o);
#pragma unroll
        for (int dt = 0; dt < 4; ++dt) {
            u32x2 w; w.x = pk2(o[dt][0] * bflo(gw[dt].x), o[dt][1] * bfhi(gw[dt].x)); w.y = pk2(o[dt][2] * bflo(gw[dt].y), o[dt][3] * bfhi(gw[dt].y));
            *(u32x2*)(QAo + idx0 + 16 * dt) = w;
        }
    }
    __syncthreads();
}

__device__ __forceinline__ void swa_sample_unit(LAS unsigned char* lds, int unit, const bf16_t* QA, bf16_t* QAo, const bf16_t* GA, const bf16_t* KA, const bf16_t* VA, const float* ck, const float* cv, const float* sinks, int wave, int lane, const int tid) {
    const int n = unit >> 1, kvh = unit & 1;
    const size_t row = (size_t)(TP + n);
    const int fr = lane & 15, fq = lane >> 4;
    LAS unsigned char* KI = lds + KI_OFF; LAS unsigned char* VI = lds + VI_OFF;
    const int hq = kvh * 8 + (fr & 7);
    bf16x8 qf[2];
#pragma unroll
    for (int kk = 0; kk < 2; ++kk) qf[kk] = *(const bf16x8*)(QA + row * DM + hq * 64 + 32 * kk + 8 * fq);
#pragma unroll
    for (int i = 0; i < 3; ++i) {
        const int idx = tid + 512 * i, key = idx >> 3, ch = idx & 7;
        if (key < 144) {
            u32x4 kk = {0u, 0u, 0u, 0u}, vv = {0u, 0u, 0u, 0u};
            if (key < 128) {
                const size_t g = ((size_t)(n * 128 + key) * 2 + kvh) * 64 + ch * 8;
                const f32x4 k0 = *(const f32x4*)(ck + g), k1 = *(const f32x4*)(ck + g + 4), v0 = *(const f32x4*)(cv + g), v1 = *(const f32x4*)(cv + g + 4);
                kk.x = pk2(k0.x, k0.y); kk.y = pk2(k0.z, k0.w); kk.z = pk2(k1.x, k1.y); kk.w = pk2(k1.z, k1.w);
                vv.x = pk2(v0.x, v0.y); vv.y = pk2(v0.z, v0.w); vv.z = pk2(v1.x, v1.y); vv.w = pk2(v1.z, v1.w);
            } else if (key == 128) { const size_t g = row * 128 + kvh * 64 + ch * 8; kk = *(const u32x4*)(KA + g); vv = *(const u32x4*)(VA + g); }
            *(LAS u32x4*)(KI + key * KVP + ch * 16) = kk; *(LAS u32x4*)(VI + key * KVP + ch * 16) = vv;
        }
    }
    const float sink = sinks[hq] * 1.4426950408889634f;
    __syncthreads();
    if (wave == 0) {
        const size_t idx0 = row * DM + hq * 64 + 4 * fq;
        u32x2 gw[4];
#pragma unroll
        for (int dt = 0; dt < 4; ++dt) gw[dt] = *(const u32x2*)(GA + idx0 + 16 * dt);
        f32x4 o[4];
        attn_core<false>(KI, VI, 0, qf, 0, 128, sink, fr, fq, o);
        if (fr < 8) {
#pragma unroll
            for (int dt = 0; dt < 4; ++dt) {
                u32x2 w; w.x = pk2(o[dt][0] * bflo(gw[dt].x), o[dt][1] * bfhi(gw[dt].x)); w.y = pk2(o[dt][2] * bflo(gw[dt].y), o[dt][3] * bfhi(gw[dt].y));
                *(u32x2*)(QAo + idx0 + 16 * dt) = w;
            }
        }
    }
    __syncthreads();
}

__global__ void __launch_bounds__(NWAVES * 64, 2) yoco_fwd(Args args) {
    extern __shared__ __attribute__((aligned(16))) unsigned char lds_raw[];
    LAS unsigned char* lds = (LAS unsigned char*)lds_raw;
    volatile LAS unsigned* MISC = (volatile LAS unsigned*)(lds + MISC_OFF);
    const int G = gridDim.x, bx = blockIdx.x;
    { const int tid = threadIdx.x;
      for (int u = tid; u < (LDS_BYTES - LDSCTL_OFF) / 4; u += NWAVES * 64) ((LAS unsigned*)(lds + LDSCTL_OFF))[u] = 0u; }
    __syncthreads();
    XcdBarrier bar = xcd_barrier_post((unsigned*)(args.ws + WS_CTL) + CW_BAR, MISC + 8);
    const int lo = args.ph_lo, hi = args.ph_hi;
#define IN(k) (lo <= (k) && (k) < hi)
#define SEAM(k) do { if (IN(k) && IN((k) + 1)) { for (int rep = 0; rep < NREP(9); ++rep) xcd_barrier(bar); } } while (0)
#define PHASE_LOCALS() KArgPtr ap = kargs(); unsigned char* ws = ap->ws; const int tid = fresh_tid(), lane = tid & 63, wave = __builtin_amdgcn_readfirstlane(tid >> 6); (void)lane; (void)wave; (void)ws

    if (IN(0)) { for (int rep = 0; rep < NREP(0); ++rep) { PHASE_LOCALS(); p0_prologue(ap, lds, wave, lane); } }
    SEAM(0);

#define S_IN_A(l_)  do { EpiHgrnIn Es{ws, (l_), (const LAS float*)(lds + RSTD_OFF)}; const bf16_t* Bs = (const bf16_t*)(ws + ((l_) == 0 ? WS_WIN0 : WS_WIN1)); \
        for (int u = bx; u < 256; u += G) sgemm_unit<64, 32>(lds, (const bf16_t*)(ws + WS_HB) + (size_t)TP * DM, Bs, u, Es, wave, lane, tid); } while (0)
#define S_OUT(WOFF, u0_, ustep_) do { EpiResid Es{ws}; const bf16_t* Bs = (const bf16_t*)(ws + (WOFF)); \
        for (int u = (u0_); u < 256; u += (ustep_)) sgemm_unit<32, 16>(lds, (const bf16_t*)(ws + WS_Q) + (size_t)TP * DM, Bs, u, Es, wave, lane, tid); } while (0)
#define S_STEP(l_)  sample_rec_units(lds, ws, ap->in[2] + (size_t)(l_) * 1024 * 16384, ap->out + O_STS + (size_t)(l_) * 1024 * 16384, bx, G, tid)
#define S_ATTN(j_)  do { const float* sk = ap->in[14] + (j_) * 16; \
        for (int u = bx; u < 256; u += G) swa_sample_unit(lds, u, (const bf16_t*)(ws + WS_Q), (bf16_t*)(ws + WS_Q), (const bf16_t*)(ws + WS_G), (const bf16_t*)(ws + WS_KA), (const bf16_t*)(ws + WS_VA), ap->in[3], ap->in[4], sk, wave, lane, tid); } while (0)

#pragma unroll 1
    for (int l = 0; l < 2; ++l) {
        const int pb = 1 + 5 * l;
        if (IN(pb)) {
            PHASE_LOCALS();
            const bf16_t* Bt = (const bf16_t*)(ws + (l == 0 ? WS_WIN0 : WS_WIN1));
            const int vcu = (bx & 7) * (G >> 3) + (bx >> 3);
            pg8::Gemm g{(const bf16_t*)(ws + WS_HB), Bt, TP, 4096, 1024}; pg8::HeadPairOrder S; S.pm = vcu >> 2; S.hp = vcu & 3; S.rot = (vcu >> 5) & 3; { int n4 = 4; asm volatile("" : "+s"(n4)); S.nu = n4; }
            EpiHgrnIn E{ws, l, (const LAS float*)(lds + RSTD_OFF)};
            stage_row_tables(ws, S.pm, lds, false, tid);
            S_IN_A(l);
            pg8::gemm_phase<EpiHgrnIn, pg8::HeadPairOrder, PG8_ALIGN, PG8_SP2>(lds + RING_OFF, g, S, E, tid);
        }
        if (IN(pb)) {
            PHASE_LOCALS();
            __syncthreads();
            const int vcu = (bx & 7) * (G >> 3) + (bx >> 3);
            const int pm_ = vcu >> 2, hp_ = vcu & 3, bq = pm_ >> 3, c0 = 4 * (pm_ & 7);
            const bf16_t* Qp = (const bf16_t*)(ws + WS_Q); const bf16_t* Kp = (const bf16_t*)(ws + WS_K); const bf16_t* Lp = (const bf16_t*)(ws + WS_LF); const bf16_t* Vp = (const bf16_t*)(ws + WS_V);
            {
                ChunkIn r; f32x4 ds0[8]; float lam0[4] = {0.f, 0.f, 0.f, 0.f};
#pragma unroll
                for (int i = 0; i < 8; ++i) ds0[i] = (f32x4){0.f, 0.f, 0.f, 0.f};
                bf16_t* Qo = (bf16_t*)(ws + WS_Q); bf16_t* LFo = (bf16_t*)(ws + WS_LF); bf16_t* DSp = (bf16_t*)(ws + WS_DS); float* LAMp = (float*)(ws + WS_LAM);
                const int ub = (bq * 8 + 2 * hp_) * 32 + c0;
                chunk_load(r, ub, Qp, Kp, Lp, Vp, tid);
                chunk_A1(lds, 0, r, tid);
                chunk_load(r, ub + 1, Qp, Kp, Lp, Vp, tid);
                LDS_BARRIER();
                chunk_A2(lds, 0, ub, 0, lam0, Qo, LAMp, wave, lane);
                LDS_BARRIER();
#pragma unroll 1
                for (int k = 0; k < 8; ++k) {
                    const int u = ub + (k >> 2) * 32 + (k & 3), s = k & 1;
                    const bool has_next = k < 7;
                    const int k1 = k < 7 ? k + 1 : 7, un = ub + (k1 >> 2) * 32 + (k1 & 3), k2 = k + 2 < 8 ? k + 2 : 7, u2 = ub + (k2 >> 2) * 32 + (k2 & 3);
                    if (has_next) { chunk_A1(lds, s ^ 1, r, tid); chunk_load(r, u2, Qp, Kp, Lp, Vp, tid); }
                    __builtin_amdgcn_sched_barrier(0);
                    chunk_B(lds, s, wave, lane);
                    LDS_BARRIER();
                    if (has_next) chunk_A2(lds, s ^ 1, un, k1 & 3, lam0, Qo, LAMp, wave, lane);
                    __builtin_amdgcn_sched_barrier(0);
                    switch (k & 3) {
                        case 0: chunk_C<0>(lds, s, u, ds0, LFo, DSp, wave, lane); break;
                        case 1: chunk_C<1>(lds, s, u, ds0, LFo, DSp, wave, lane); break;
                        case 2: chunk_C<2>(lds, s, u, ds0, LFo, DSp, wave, lane); break;
                        default: chunk_C<3>(lds, s, u, ds0, LFo, DSp, wave, lane); break;
                    }
                    LDS_BARRIER();
                }
            }
        }
        SEAM(pb);
        if (IN(pb + 3)) {
            PHASE_LOCALS();
            for (int rep = 0; rep < NREP(10); ++rep) {
                bf16_t* qo = (bf16_t*)(ws + (DUMMY(10, rep) ? WS_DUM0 : WS_Q));
                const bf16_t* Qp = (const bf16_t*)(ws + WS_Q); const bf16_t* Op = (const bf16_t*)(ws + WS_LF); const bf16_t* Gp = (const bf16_t*)(ws + WS_G); const bf16_t* Sp = (const bf16_t*)(ws + WS_DS);
                const int vcu = (bx & 7) * (G >> 3) + (bx >> 3), qp = vcu & 7, bh0 = (vcu >> 5) * 8 + ((vcu >> 3) & 3), bh1 = bh0 + 4, qd0 = bh0 * 8 + qp, qd1 = bh1 * 8 + (7 - qp);
                InterIn cur; InterSc sc, sc1;
                quad_prefix(lds, sc, sc1, bh0, bh1, qp, Sp, (const float*)(ws + WS_LAM), ap->out + O_STP + (size_t)l * 64 * 16384, wave, lane, tid);
                inter_load(cur, 4 * qd0, Qp, Op, Gp, Sp, wave, lane, tid);
#pragma unroll 1
                for (int k = 0; k < 2; ++k) {
                    const int qd = k == 0 ? qd0 : qd1, qn = qd1;
#pragma unroll 1
                    for (int jj = 0; jj < 3; ++jj) {
                        InterIn nxt; SampleIn sin;
                        const int su = bx + G * (2 * k + (jj >> 1)), half = jj & 1;
                        inter_load(nxt, 4 * qd + jj + 1, Qp, Op, Gp, Sp, wave, lane, tid);
                        sample_load(sin, su, half, Qp, (const bf16_t*)(ws + WS_K), Op, (const bf16_t*)(ws + WS_V), Gp, ap->in[2] + ((size_t)l * 1024 + su) * 16384, tid);
                        inter_compute(lds, 4 * qd + jj, jj & 1, cur, sc, qo, wave, lane, tid);
                        sample_compute(lds + 112640, su, half, sin, (bf16_t*)(ws + WS_Q), ap->out + O_STS + ((size_t)l * 1024 + su) * 16384, tid);
                        cur = nxt;
                    }
                    InterIn nxt; SampleIn sin;
                    const int su = bx + G * (2 * k + 1);
                    inter_load(nxt, 4 * qn, Qp, Op, Gp, Sp, wave, lane, tid);
                    sample_load(sin, su, 1, Qp, (const bf16_t*)(ws + WS_K), Op, (const bf16_t*)(ws + WS_V), Gp, ap->in[2] + ((size_t)l * 1024 + su) * 16384, tid);
                    inter_compute(lds, 4 * qd + 3, 1, cur, sc, qo, wave, lane, tid);
                    sample_compute(lds + 112640, su, 1, sin, (bf16_t*)(ws + WS_Q), ap->out + O_STS + ((size_t)l * 1024 + su) * 16384, tid);
                    cur = nxt; sc = sc1;
                }
            }
        }
        SEAM(pb + 3);
        if (IN(pb + 4)) {
            PHASE_LOCALS();
            const bf16_t* Bt = (const bf16_t*)(ws + (l == 0 ? WS_WOUT0 : WS_WOUT1));
            pg8::Gemm g{(const bf16_t*)(ws + WS_Q), Bt, TP, 1024, 1024}; pg8::StaticOrder S; S.init(TP, 1024, G, bx);
            EpiResid E{ws};
            S_OUT((l == 0 ? WS_WOUT0 : WS_WOUT1), bx, G);
            pg8::gemm_phase<EpiResid, pg8::StaticOrder, PG8_ALIGN, PG8_SP2>(lds + RING_OFF, g, S, E, tid);
        }
        SEAM(pb + 4);
    }
#pragma unroll 1
    for (int j = 0; j < 2; ++j) {
        const int pb = 11 + 3 * j;
        if (IN(pb)) {
            PHASE_LOCALS();
            const int N = j == 0 ? 2304 : 2048;
            const bf16_t* Bt = (const bf16_t*)(ws + (j == 0 ? WS_WINB0 : WS_WINB1));
            const int vcu = (bx & 7) * (G >> 3) + (bx >> 3);
            pg8::Gemm g{(const bf16_t*)(ws + WS_HB), Bt, TP, N, 1024}; pg8::PmOrder S; S.pm = vcu >> 2; S.q = vcu & 3; S.nN = N >> 8;
            EpiSwaIn E{ws, ap->out, (const LAS float*)(lds + RSTD_OFF), (const LAS float*)(lds + ROPEL_OFF)};
            stage_row_tables(ws, S.pm, lds, true, tid);
            if (j == 0) {
                const int rank = S.q < 2 ? -1 : (S.pm * 2 + S.q - 2), nr = G >> 1;
                if (rank >= 0) for (int u = rank; u < N / 16; u += nr) sgemm_unit<64, 32>(lds, g.A + (size_t)TP * DM, Bt, u, E, wave, lane, tid);
                pg8::gemm_phase<EpiSwaIn, pg8::PmOrder, PG8_ALIGN, PG8_SP2, true>(lds + RING_OFF, g, S, E, tid);
            } else {
                for (int u = bx; u < N / 8; u += G) sgemm_unit<32, 32>(lds, g.A + (size_t)TP * DM, Bt, u, E, wave, lane, tid);
                pg8::gemm_phase<EpiSwaIn, pg8::PmOrder, PG8_ALIGN, PG8_SP2, false>(lds + RING_OFF, g, S, E, tid);
            }
        }
        SEAM(pb);
        if (IN(pb + 1)) {
            PHASE_LOCALS();
            const float* sinks = ap->in[14] + j * 16;
            for (int rep = 0; rep < NREP(6); ++rep) {
            bf16_t* qo = (bf16_t*)(ws + (DUMMY(6, rep) ? WS_DUM0 : WS_Q));
            for (int u = (bx & 7) * (G >> 3) + (bx >> 3); u < 256; u += G) swa_prompt_unit(lds, u, (const bf16_t*)(ws + WS_Q), qo,
            (const bf16_t*)(ws + WS_G), (const bf16_t*)(ws + WS_KA), (const bf16_t*)(ws + WS_VA), sinks, wave, lane, tid);
            }
            S_ATTN(j);
        }
        SEAM(pb + 1);
        if (IN(pb + 2)) {
            PHASE_LOCALS();
            const bf16_t* Bt = (const bf16_t*)(ws + (j == 0 ? WS_WOUTB0 : WS_WOUTB1));
            pg8::Gemm g{(const bf16_t*)(ws + WS_Q), Bt, TP, 1024, 1024}; pg8::StaticOrder S; S.init(TP, 1024, G, bx);
            EpiResid E{ws};
            S_OUT((j == 0 ? WS_WOUTB0 : WS_WOUTB1), bx, G);
            pg8::gemm_phase<EpiResid, pg8::StaticOrder, PG8_ALIGN, PG8_SP2>(lds + RING_OFF, g, S, E, tid);
        }
        SEAM(pb + 2);
    }
    if (IN(17)) {
        PHASE_LOCALS();
        const int gw = bx * NWAVES + wave, NGW = G * NWAVES;
        const f32x4* fn = (const f32x4*)ap->in[16] + lane;
        const float* SSQ = (const float*)(ws + WS_SSQ); const bf16_t* HBf = (const bf16_t*)(ws + WS_HB); float* outp = ap->out;
        f32x4 gn[4];
#pragma unroll
        for (int j = 0; j < 4; ++j) gn[j] = fn[64 * j];
        const int vcu = (bx & 7) * (G >> 3) + (bx >> 3), vw = vcu * NWAVES + wave;
        for (int rep = 0; rep < NREP(8); ++rep)
        for (int i = 0; i < 9; ++i) {
            const int m = i < 8 ? (vw >> 8) * SEQ + (vw & 255) + 256 * i : TP + vw;
            if (m >= TP + TS) break;
            const float rs = m < TP ? row_rstd(SSQ, m) : row_rstd_s((const float*)(ws + WS_SSQS), m - TP);
            const u32x2* hr = (const u32x2*)(HBf + (size_t)m * DM) + lane; f32x4* o = (f32x4*)(outp + (size_t)m * DM) + lane;
#pragma unroll
            for (int j = 0; j < 4; ++j) { const u32x2 hw = hr[64 * j]; __builtin_nontemporal_store((f32x4){bflo(hw.x), bfhi(hw.x), bflo(hw.y), bfhi(hw.y)} * rs * gn[j], &o[64 * j]); }
        }
    }
#undef S_IN_A
#undef S_OUT
#undef S_STEP
#undef S_ATTN
#undef IN
#undef SEAM
#undef PHASE_LOCALS
}

#ifndef MK_PER_PHASE
#define MK_PER_PHASE 0
#endif
extern "C" void kernel_launch(void* const* d_in, const int* in_sizes, int n_in, void* d_out, int out_size, void* d_ws, size_t ws_size, hipStream_t stream) {
    static int grid = 0;
    if (grid == 0) {
        if (n_in != 17 || ws_size < WS_END) { fprintf(stderr, "kernel_launch: unexpected inputs (n_in %d, ws %zu)\n", n_in, ws_size); grid = -1; return; }
        int dev = 0, cus = 0;
        if (hipGetDevice(&dev) != hipSuccess || hipDeviceGetAttribute(&cus, hipDeviceAttributeMultiprocessorCount, dev) != hipSuccess) { grid = -1; return; }
        if (hipFuncSetAttribute((const void*)yoco_fwd, hipFuncAttributeMaxDynamicSharedMemorySize, LDS_BYTES) != hipSuccess) { grid = -1; return; }
        (void)hipGetLastError();
        grid = cus;
    }
    if (grid < 0) return;
    (void)hipMemsetAsync((char*)d_ws + WS_CTL, 0, CTL_ZERO_BYTES, stream);
    Args a{};
    for (int i = 0; i < 17; ++i) a.in[i] = (const float*)d_in[i];
    a.out = (float*)d_out; a.ws = (unsigned char*)d_ws;
#if MK_PER_PHASE
    for (int p = 0; p < 18; ++p) { a.ph_lo = p; a.ph_hi = p + 1; hipLaunchKernelGGL(yoco_fwd, dim3(grid), dim3(NWAVES * 64), LDS_BYTES, stream, a); }
#else
    a.ph_lo = 0; a.ph_hi = 18;
    hipLaunchKernelGGL(yoco_fwd, dim3(grid), dim3(NWAVES * 64), LDS_BYTES, stream, a);
#endif
}
```

```cpp
#include <hip/hip_runtime.h>
#include <cstdio>
#include <cstdint>

#define LAS __attribute__((address_space(3)))
#define GAS __attribute__((address_space(1)))
typedef unsigned short bf16_t;
typedef short bf16x8 __attribute__((ext_vector_type(8)));
typedef short s16x4 __attribute__((ext_vector_type(4)));
typedef float f32x4 __attribute__((ext_vector_type(4)));
typedef float f32x2 __attribute__((ext_vector_type(2)));
typedef unsigned u32x4 __attribute__((ext_vector_type(4)));
typedef unsigned u32x2 __attribute__((ext_vector_type(2)));

constexpr int DM = 1024;
constexpr int TP = 16384;
constexpr int TS = 128;
constexpr int MT = 16640;
constexpr int SEQ = 2048;
constexpr float NORM_EPS = 1e-6f;
constexpr size_t O_YP = 0, O_YS = 16777216, O_STP = 16908288, O_STS = 19005440, O_KWP = 52559872, O_VWP = 52690944, O_KNS = 52822016, O_VNS = 52838400;
constexpr size_t MiB = 1u << 20;
constexpr size_t WS_CTL = 0, CTL_ZERO_BYTES = 65536;
constexpr size_t WS_LB1 = 1 * MiB, WS_ROPE = 1 * MiB + 8192, WS_SSQS = 1 * MiB + 262144;
constexpr size_t WS_WIN0 = 2 * MiB, WS_WIN1 = 10 * MiB, WS_WOUT0 = 18 * MiB, WS_WOUT1 = 20 * MiB, WS_WINB0 = 22 * MiB, WS_WINB1 = 27 * MiB, WS_WOUTB0 = 31 * MiB, WS_WOUTB1 = 33 * MiB;
constexpr size_t WS_SSQ = 35 * MiB, WS_HB = 37 * MiB, WS_H = 70 * MiB, WS_Q = 136 * MiB, WS_K = 169 * MiB, WS_V = 202 * MiB, WS_G = 235 * MiB, WS_LF = 268 * MiB;
constexpr size_t WS_DS = 334 * MiB, WS_LAM = 398 * MiB, WS_KA = 399 * MiB, WS_VA = 404 * MiB, WS_END = 409 * MiB;
constexpr int CW_BAR = 4096;
constexpr size_t WS_DUM0 = 409 * MiB, WS_DUM1 = 442 * MiB;
#ifndef DUP_MASK
#define DUP_MASK 0
#endif
#define NREP(id) (((DUP_MASK >> (id)) & 1) ? 2 : 1)
#define DUMMY(id, rep) (((DUP_MASK >> (id)) & 1) && (rep) == 0)

typedef float f32x2_t __attribute__((ext_vector_type(2))); typedef __bf16 bf16x2_t __attribute__((ext_vector_type(2)));
__device__ __forceinline__ unsigned pk2(float lo, float hi) { f32x2_t v = {lo, hi}; bf16x2_t b = __builtin_convertvector(v, bf16x2_t); return __builtin_bit_cast(unsigned, b); }
__device__ __forceinline__ unsigned f2bf(float f) { return pk2(f, f) & 0xffffu; }
__device__ __forceinline__ float bflo(unsigned w) { return __builtin_bit_cast(float, w << 16); }
__device__ __forceinline__ float bfhi(unsigned w) { return __builtin_bit_cast(float, w & 0xffff0000u); }
__device__ __forceinline__ float bf1(bf16_t b) { return __builtin_bit_cast(float, (unsigned)b << 16); }
__device__ __forceinline__ float fast_rcp(float x) { return __builtin_amdgcn_rcpf(x); }
__device__ __forceinline__ float silu_f(float u) { return u * fast_rcp(1.0f + __expf(-u)); }
__device__ __forceinline__ float fast_log(float x) { return __builtin_amdgcn_logf(x) * 0.6931471805599453f; }
__device__ __forceinline__ float wave_sum(float v) {
#pragma unroll
    for (int o = 1; o < 64; o <<= 1) v += __shfl_xor(v, o);
    return v;
}
__device__ __forceinline__ float wave_max(float v) {
#pragma unroll
    for (int o = 1; o < 64; o <<= 1) v = fmaxf(v, __shfl_xor(v, o));
    return v;
}
#define LDS_WAIT() asm volatile("s_waitcnt lgkmcnt(0)" ::: "memory")
#define VM_WAIT() asm volatile("s_waitcnt vmcnt(0)" ::: "memory")
#define MFMA16(a, b, c) __builtin_amdgcn_mfma_f32_16x16x32_bf16((a), (b), (c), 0, 0, 0)

namespace pg8 {
constexpr int BM = 256, BK = 64, HALF = 128, HTB = HALF * BK * 2, STAGE_BYTES = 8 * HTB, NXCD = 8, WGM = 8;
__host__ __device__ __forceinline__ int lds_byte(int r, int c) { const int st = (r >> 4) * 2 + (c >> 5), rr = r & 15, cc = c & 31, ob = rr * 64 + cc * 2; return st * 1024 + (ob ^ (((ob >> 9) & 1) << 5)); }
__host__ __device__ __forceinline__ void stage_rc(int b, int& R, int& C) { const int st = b / 1024, sb = b % 1024, swz = sb ^ (((sb >> 9) & 1) << 5); R = (st >> 1) * 16 + swz / 64; C = (st & 1) * 32 + (swz % 64) / 2; }
__host__ __device__ __forceinline__ int perm32(int rho) { const int n = rho >> 4, i = rho & 15; return 8 * (i >> 2) + 4 * n + (i & 3); }
struct Unit { int pm, pn, hs; };
struct Gemm { const bf16_t* A; const bf16_t* Bt; int M, N, K; };
struct StaticOrder {
    int nM, nN, nwg, G, c;
    __host__ __device__ void init(int M, int N, int G_, int c_) { nM = M / BM; nN = N / BM; nwg = nM * nN; G = G_; c = c_; }
    __host__ __device__ __forceinline__ bool next(int i, Unit& u) const {
        const long L = (long)i * G + c; if (L >= nwg) return false;
        int wgid = (int)L; { const int q = nwg / NXCD, r = nwg % NXCD, xcd = wgid % NXCD, off = wgid / NXCD; wgid = (xcd < r ? xcd * (q + 1) : r * (q + 1) + (xcd - r) * q) + off; }
        const int nig = WGM * nN, gid = wgid / nig, fm = gid * WGM, gsz = (nM - fm) < WGM ? (nM - fm) : WGM;
        u.pm = fm + ((wgid % nig) % gsz); u.pn = (wgid % nig) / gsz; u.hs = 0; return true;
    }
    __device__ __forceinline__ void a_ready(const Unit&) const {}
    __device__ __forceinline__ void done(const Unit&) const {}
};
struct HeadPairOrder {
    int pm, hp, nu, rot;
    __device__ __forceinline__ bool next(int i, Unit& u) const { if (i >= nu) return false; u.pm = pm; u.pn = hp + 4 * ((i + rot) & 3); u.hs = 0; return true; }
    __device__ __forceinline__ void a_ready(const Unit&) const {}
    __device__ __forceinline__ void done(const Unit&) const {}
};
struct PmOrder {
    int pm, q, nN;
    __device__ __forceinline__ bool next(int i, Unit& u) const {
        u.pm = pm; u.hs = 0;
        if (i < 2) { u.pn = q + 4 * i; return true; }
        if (i == 2 && nN == 9 && q < 2) { u.pn = 8; u.hs = q + 1; return true; }
        return false; }
    __device__ __forceinline__ void a_ready(const Unit&) const {}
    __device__ __forceinline__ void done(const Unit&) const {}
};
template <class Epi, class Sched, bool ALIGN_EPI = false, bool SP2 = false, bool HALFN = false>
__device__ __forceinline__ void gemm_phase(LAS unsigned char* lds, const Gemm g, const Sched& S, const Epi& E, const int tid) {
    const int wid = __builtin_amdgcn_readfirstlane(tid >> 6), lane = tid & 63, wr = wid >> 2, wc = wid & 3, fr = lane & 15, fq = lane >> 4;
    const int K = g.K, nt = K / BK;
    unsigned voffA[2], voffB[2];
#pragma unroll
    for (int i = 0; i < 2; ++i) { int R, C; stage_rc(tid * 16 + i * 8192, R, C); const int Rb = Epi::PERM ? ((R & ~31) + perm32(R & 31)) : R;
        voffA[i] = (unsigned)(R * K + C) * 2u; voffB[i] = (unsigned)(Rb * K + C) * 2u; }
    const size_t kstep = (size_t)(BK * 2);
    const size_t hstep = (size_t)HALF * K * 2;
    const size_t tstep = 2 * hstep;
    const unsigned ldsw = (unsigned)wid * 1024u;
    const int aoff = lds_byte(wr * 64 + fr, fq * 8), boff = lds_byte(wc * 32 + fr, fq * 8);
#define PG8_SA(b, h) (((b) * 2 + (h)) * HTB)
#define PG8_SB(b, h) ((4 + (b) * 2 + (h)) * HTB)
#define PG8_STAGE(bufoff, gbase, voff) do { _Pragma("unroll") for (int _i = 0; _i < 2; ++_i) \
        __builtin_amdgcn_global_load_lds((const unsigned*)((const char*)(gbase) + (voff)[_i]), (LAS unsigned*)(lds + (bufoff) + ldsw + _i * 8192), 16, 0, 0); } while (0)
#define PG8_LDA(dst, b, h) do { _Pragma("unroll") for (int m = 0; m < 4; ++m) _Pragma("unroll") for (int k = 0; k < 2; ++k) dst[m][k] = *(const LAS bf16x8*)(lds + PG8_SA(b, h) + aoff + m * 2048 + k * 1024); } while (0)
#define PG8_LDB(dst, b, h) do { _Pragma("unroll") for (int n = 0; n < 2; ++n) _Pragma("unroll") for (int k = 0; k < 2; ++k) dst[n][k] = *(const LAS bf16x8*)(lds + PG8_SB(b, h) + boff + n * 2048 + k * 1024); } while (0)
#define PG8_MMA(ai, bj, At, Bt) do { __builtin_amdgcn_s_setprio(1); _Pragma("unroll") for (int m = 0; m < 4; ++m) _Pragma("unroll") for (int n = 0; n < 2; ++n) _Pragma("unroll") for (int k = 0; k < 2; ++k) \
        acc[ai][bj][m][n] = __builtin_amdgcn_mfma_f32_16x16x32_bf16(Bt[n][k], At[m][k], acc[ai][bj][m][n], 0, 0, 0); __builtin_amdgcn_s_setprio(0); } while (0)
#define PG8_MMA2(ai) do { if constexpr (HALFN) { if (cur.hs != 2) PG8_MMA(ai, 0, At, B0); if (cur.hs != 1) PG8_MMA(ai, 1, At, B1); } else { PG8_MMA(ai, 0, At, B0); PG8_MMA(ai, 1, At, B1); } } while (0)
#define PG8_WAIT_V(n) asm volatile("s_waitcnt vmcnt(" #n ")" ::: "memory")
#define PG8_WAIT_L(n) asm volatile("s_waitcnt lgkmcnt(" #n ")" ::: "memory")
#define PG8_BAR __builtin_amdgcn_s_barrier()
#define PG8_SCHED __builtin_amdgcn_sched_barrier(0)
    Unit cur, nxt; int ui = 0;
    if (!S.next(0, cur)) return;
    f32x4 acc[2][2][4][2];
#pragma unroll
    for (int a = 0; a < 2; ++a)
#pragma unroll
        for (int b = 0; b < 2; ++b)
#pragma unroll
            for (int m = 0; m < 4; ++m)
#pragma unroll
                for (int n = 0; n < 2; ++n) acc[a][b][m][n] = (f32x4){0.f, 0.f, 0.f, 0.f};
    bf16x8 At[4][2], B0[2][2], B1[2][2];
    const char* cA = (const char*)g.A + (size_t)cur.pm * tstep; const char* cB = (const char*)g.Bt + (size_t)cur.pn * tstep;
    S.a_ready(cur);
    if constexpr (SP2) {
        PG8_STAGE(PG8_SB(0, 0), cB, voffB); PG8_STAGE(PG8_SB(0, 1), cB + hstep, voffB); PG8_STAGE(PG8_SA(0, 0), cA, voffA); PG8_STAGE(PG8_SA(0, 1), cA + hstep, voffA);
        if (wr == 1) PG8_BAR;
        PG8_WAIT_V(2); PG8_BAR;
        PG8_STAGE(PG8_SB(1, 0), cB + kstep, voffB); PG8_STAGE(PG8_SA(1, 0), cA + kstep, voffA); PG8_STAGE(PG8_SB(1, 1), cB + hstep + kstep, voffB);
        PG8_WAIT_V(6); PG8_BAR;
    } else {
        PG8_STAGE(PG8_SB(0, 0), cB, voffB); PG8_STAGE(PG8_SA(0, 0), cA, voffA); PG8_STAGE(PG8_SB(0, 1), cB + hstep, voffB); PG8_STAGE(PG8_SA(0, 1), cA + hstep, voffA);
        if (wr == 1) PG8_BAR;
        PG8_WAIT_V(4); PG8_BAR;
        PG8_STAGE(PG8_SB(1, 0), cB + kstep, voffB); PG8_STAGE(PG8_SA(1, 0), cA + kstep, voffA); PG8_STAGE(PG8_SB(1, 1), cB + hstep + kstep, voffB);
        PG8_WAIT_V(6); PG8_BAR;
    }
    for (;;) {
        const bool has_next = S.next(ui + 1, nxt);
        const char* nA = has_next ? (const char*)g.A + (size_t)nxt.pm * tstep : cA; const char* nB = has_next ? (const char*)g.Bt + (size_t)nxt.pn * tstep : cB;
        for (int t = 0; t < nt; t += 2) {
            const bool last = (t == nt - 2);
            const char* a1 = cA + (size_t)(t + 1) * kstep;
            const char* a2 = last ? nA : cA + (size_t)(t + 2) * kstep; const char* b2 = last ? nB : cB + (size_t)(t + 2) * kstep;
            const char* a3 = a2 + kstep; const char* b3 = b2 + kstep;
            if (last && has_next) S.a_ready(nxt);
            if constexpr (SP2) {
            PG8_LDB(B0, 0, 0); PG8_LDB(B1, 0, 1); PG8_SCHED; PG8_LDA(At, 0, 0); PG8_STAGE(PG8_SA(1, 1), a1 + hstep, voffA);
            PG8_WAIT_V(8); PG8_WAIT_L(0); PG8_BAR; PG8_MMA2(0); PG8_BAR; PG8_SCHED;
            PG8_LDA(At, 0, 1); PG8_STAGE(PG8_SB(0, 0), b2, voffB); PG8_STAGE(PG8_SB(0, 1), b2 + hstep, voffB); PG8_STAGE(PG8_SA(0, 0), a2, voffA);
            PG8_WAIT_V(8); PG8_WAIT_L(0); PG8_BAR; PG8_MMA2(1); PG8_BAR; PG8_SCHED;
            PG8_LDB(B0, 1, 0); PG8_LDB(B1, 1, 1); PG8_SCHED; PG8_LDA(At, 1, 0); PG8_STAGE(PG8_SA(0, 1), a2 + hstep, voffA);
            PG8_WAIT_V(8); PG8_WAIT_L(0); PG8_BAR; PG8_MMA2(0); PG8_BAR; PG8_SCHED;
            PG8_LDA(At, 1, 1); PG8_STAGE(PG8_SB(1, 0), b3, voffB); PG8_STAGE(PG8_SB(1, 1), b3 + hstep, voffB); PG8_STAGE(PG8_SA(1, 0), a3, voffA);
            PG8_WAIT_V(8); PG8_WAIT_L(0); PG8_BAR; PG8_MMA2(1); PG8_BAR; PG8_SCHED;
            } else {
            PG8_LDB(B0, 0, 0); PG8_SCHED; PG8_LDA(At, 0, 0); PG8_STAGE(PG8_SA(1, 1), a1 + hstep, voffA);
            PG8_WAIT_L(8); PG8_BAR; PG8_WAIT_L(0); PG8_MMA(0, 0, At, B0); PG8_BAR; PG8_SCHED;
            PG8_LDB(B1, 0, 1); PG8_STAGE(PG8_SB(0, 0), b2, voffB);
            PG8_BAR; PG8_WAIT_L(0); PG8_MMA(0, 1, At, B1); PG8_BAR;
            PG8_LDA(At, 0, 1); PG8_STAGE(PG8_SA(0, 0), a2, voffA);
            PG8_BAR; PG8_WAIT_L(0); PG8_MMA(1, 0, At, B0); PG8_BAR; PG8_SCHED;
            PG8_STAGE(PG8_SB(0, 1), b2 + hstep, voffB);
            PG8_WAIT_V(6); PG8_BAR; PG8_MMA(1, 1, At, B1); PG8_BAR;
            PG8_LDB(B0, 1, 0); PG8_SCHED; PG8_LDA(At, 1, 0); PG8_STAGE(PG8_SA(0, 1), a2 + hstep, voffA);
            PG8_WAIT_L(8); PG8_BAR; PG8_WAIT_L(0); PG8_MMA(0, 0, At, B0); PG8_BAR; PG8_SCHED;
            PG8_LDB(B1, 1, 1); PG8_STAGE(PG8_SB(1, 0), b3, voffB);
            PG8_BAR; PG8_WAIT_L(0); PG8_MMA(0, 1, At, B1); PG8_BAR;
            PG8_LDA(At, 1, 1); PG8_STAGE(PG8_SA(1, 0), a3, voffA);
            PG8_BAR; PG8_WAIT_L(0); PG8_MMA(1, 0, At, B0); PG8_BAR; PG8_SCHED;
            PG8_STAGE(PG8_SB(1, 1), b3 + hstep, voffB);
            PG8_WAIT_V(6); PG8_BAR; PG8_MMA(1, 1, At, B1); PG8_BAR;
            }
        }
        if constexpr (ALIGN_EPI) { if (wr == 0) PG8_BAR; }
        E(acc, cur, wr, wc, fr, fq);
        if (!has_next) break;
#pragma unroll
        for (int a = 0; a < 2; ++a)
#pragma unroll
            for (int b = 0; b < 2; ++b)
#pragma unroll
                for (int m = 0; m < 4; ++m)
#pragma unroll
                    for (int n = 0; n < 2; ++n) acc[a][b][m][n] = (f32x4){0.f, 0.f, 0.f, 0.f};
        cur = nxt; cA = nA; cB = nB; ++ui;
        if constexpr (ALIGN_EPI) { if (wr == 1) PG8_BAR; }
    }
    PG8_WAIT_V(0);
    if constexpr (!ALIGN_EPI) { if (wr == 0) PG8_BAR; }
    PG8_BAR;
#undef PG8_SA
#undef PG8_SB
#undef PG8_STAGE
#undef PG8_LDA
#undef PG8_LDB
#undef PG8_MMA
#undef PG8_MMA2
#undef PG8_WAIT_V
#undef PG8_WAIT_L
#undef PG8_BAR
#undef PG8_SCHED
}
}
#ifndef PG8_SP2
#define PG8_SP2 true
#endif
#ifndef PG8_ALIGN
#define PG8_ALIGN true
#endif

__device__ __forceinline__ float row_rstd(const float* ssq, int row) {
    const f32x4* p = (const f32x4*)(ssq + (size_t)row * 16);
    const f32x4 a = p[0], b = p[1], c = p[2], d = p[3];
    const float s = ((a.x + a.y) + (a.z + a.w)) + ((b.x + b.y) + (b.z + b.w)) + ((c.x + c.y) + (c.z + c.w)) + ((d.x + d.y) + (d.z + d.w));
    return rsqrtf(s * (1.0f / DM) + NORM_EPS);
}
__device__ __forceinline__ float row_rstd_s(const float* ssqs, int n) {
    const f32x4* p = (const f32x4*)(ssqs + (size_t)n * 64); float s = 0.f;
#pragma unroll
    for (int i = 0; i < 16; ++i) { const f32x4 a = p[i]; s += (a.x + a.y) + (a.z + a.w); }
    return rsqrtf(s * (1.0f / DM) + NORM_EPS);
}
struct SsqQ { f32x4 s[4]; };
__device__ __forceinline__ SsqQ ssqs_quarter(const float* ssqs, int n, int fq) { SsqQ r; const f32x4* p = (const f32x4*)(ssqs + (size_t)n * 64 + 16 * fq);
#pragma unroll
    for (int i = 0; i < 4; ++i) r.s[i] = p[i];
    return r; }
__device__ __forceinline__ float ssqs_rstd(const SsqQ& r) {
    float s = 0.f;
#pragma unroll
    for (int i = 0; i < 4; ++i) s += (r.s[i].x + r.s[i].y) + (r.s[i].z + r.s[i].w);
    s += __shfl_xor(s, 16); s += __shfl_xor(s, 32);
    return rsqrtf(s * (1.0f / DM) + NORM_EPS);
}
__device__ __forceinline__ u32x4 pack8(const float (&v)[8]) { u32x4 w; w.x = pk2(v[0], v[1]); w.y = pk2(v[2], v[3]); w.z = pk2(v[4], v[5]); w.w = pk2(v[6], v[7]); return w; }

struct EpiHgrnIn {
    static constexpr bool PERM = true;
    unsigned char* ws; int layer; const LAS float* rstd_lds;
#define EHI_PTRS const float* ssq = (const float*)(ws + WS_SSQ); bf16_t* Q = (bf16_t*)(ws + WS_Q); bf16_t* Kb = (bf16_t*)(ws + WS_K); bf16_t* LF = (bf16_t*)(ws + WS_LF); bf16_t* V = (bf16_t*)(ws + WS_V); bf16_t* G = (bf16_t*)(ws + WS_G); \
    const float* lb = layer == 0 ? (const float*)nullptr : (const float*)(ws + WS_LB1); const float* ssqs = (const float*)(ws + WS_SSQS); (void)ssq; (void)Q; (void)Kb; (void)LF; (void)V; (void)G; (void)lb; (void)ssqs
    struct Pre { SsqQ q; f32x4 l4; };
    __device__ __forceinline__ Pre sample_pre(int row, int col, int fq) const {
        EHI_PTRS; Pre p; p.q = ssqs_quarter(ssqs, row - TP, fq); p.l4 = (f32x4){0.f, 0.f, 0.f, 0.f};
        if ((col >> 10) == 1 && lb) p.l4 = *(const f32x4*)(lb + (col & 1023));
        return p; }
    __device__ __forceinline__ void sample(const f32x4 a, int row, int col, int u, int fq, const Pre& pre) const {
        EHI_PTRS;
        const float rs = ssqs_rstd(pre.q); const int sec = col >> 10, ch = col & 1023; const size_t idx = (size_t)row * DM + ch;
        float v[4] = {a[0] * rs, a[1] * rs, a[2] * rs, a[3] * rs};
        if (sec == 0) {
#pragma unroll
            for (int j = 0; j < 4; ++j) v[j] = silu_f(v[j]);
            u32x2 w; w.x = pk2(v[0], v[1]); w.y = pk2(v[2], v[3]); *(u32x2*)(Q + idx) = w;
        } else if (sec == 1) {
            const f32x4 l4 = pre.l4;
            float lf[4];
#pragma unroll
            for (int j = 0; j < 4; ++j) { const float e = __expf(-v[j]); const float s = fast_rcp(1.0f + e); lf[j] = fast_log(l4[j] + (1.0f - l4[j]) * s); }
            { u32x2 wl; wl.x = pk2(lf[0], lf[1]); wl.y = pk2(lf[2], lf[3]); *(u32x2*)(LF + idx) = wl; }
        } else if (sec == 2) {
            u32x2 w; w.x = pk2(v[0], v[1]); w.y = pk2(v[2], v[3]); *(u32x2*)(V + idx) = w;
        } else {
#pragma unroll
            for (int j = 0; j < 4; ++j) v[j] = silu_f(v[j]);
            u32x2 w; w.x = pk2(v[0], v[1]); w.y = pk2(v[2], v[3]); *(u32x2*)(G + idx) = w;
        }
    }
    __device__ __forceinline__ void operator()(const f32x4 (&acc)[2][2][4][2], const pg8::Unit& u, int wr, int wc, int fr_, int fq_) const {
        int fr = fr_, fq = fq_; asm volatile("" : "+v"(fr), "+v"(fq));
        EHI_PTRS;
        const int sec = u.pn >> 2;
        const int colb = (u.pn & 3) * 256 + wc * 32 + 8 * fq;
        float lbu[2][8];
#pragma unroll
        for (int bj = 0; bj < 2; ++bj) {
            if (sec == 1 && lb) { const f32x4 l0 = *(const f32x4*)(lb + colb + bj * 128), l1 = *(const f32x4*)(lb + colb + bj * 128 + 4); lbu[bj][0] = l0.x; lbu[bj][1] = l0.y; lbu[bj][2] = l0.z; lbu[bj][3] = l0.w; lbu[bj][4] = l1.x; lbu[bj][5] = l1.y; lbu[bj][6] = l1.z; lbu[bj][7] = l1.w; }
            else {
#pragma unroll
                for (int j = 0; j < 8; ++j) lbu[bj][j] = 0.f; }
        }
#pragma unroll
        for (int ai = 0; ai < 2; ++ai)
#pragma unroll
            for (int m = 0; m < 4; ++m) {
                const int row = u.pm * 256 + ai * 128 + wr * 64 + m * 16 + fr;
                const float rs = rstd_lds[ai * 128 + wr * 64 + m * 16 + fr];
#pragma unroll
                for (int bj = 0; bj < 2; ++bj) {
                    const int col = colb + bj * 128; const size_t idx = (size_t)row * DM + col;
                    float v[8];
#pragma unroll
                    for (int j = 0; j < 4; ++j) { v[j] = acc[ai][bj][m][0][j] * rs; v[4 + j] = acc[ai][bj][m][1][j] * rs; }
                    if (sec == 0) {
#pragma unroll
                        for (int j = 0; j < 8; ++j) v[j] = silu_f(v[j]);
                        *(u32x4*)(Q + idx) = pack8(v);
                    } else if (sec == 1) {
                        float lbv[8];
#pragma unroll
                        for (int j = 0; j < 8; ++j) lbv[j] = lbu[bj][j];
                        float lf[8];
#pragma unroll
                        for (int j = 0; j < 8; ++j) { const float e = __expf(-v[j]); const float s = fast_rcp(1.0f + e); lf[j] = fast_log(lbv[j] + (1.0f - lbv[j]) * s); }
                        *(u32x4*)(LF + idx) = pack8(lf);
                    } else if (sec == 2) {
                        *(u32x4*)(V + idx) = pack8(v);
                    } else {
#pragma unroll
                        for (int j = 0; j < 8; ++j) v[j] = silu_f(v[j]);
                        *(u32x4*)(G + idx) = pack8(v);
                    }
                }
            }
    }
};

struct EpiResid {
    static constexpr bool PERM = true;
    unsigned char* ws;
#define ERS_PTRS const bf16_t* Hold = (const bf16_t*)(ws + WS_HB); bf16_t* HB = (bf16_t*)(ws + WS_HB); float* ssq = (float*)(ws + WS_SSQ); float* ssqs = (float*)(ws + WS_SSQS); (void)ssq; (void)ssqs
    struct Pre { u32x2 hw; };
    __device__ __forceinline__ Pre sample_pre(int row, int col, int fq) const { ERS_PTRS; Pre p; p.hw = *(const u32x2*)(Hold + (size_t)row * DM + col); return p; }
    __device__ __forceinline__ void sample(const f32x4 a, int row, int col, int u, int fq, const Pre& pre) const {
        ERS_PTRS;
        const size_t idx = (size_t)row * DM + col;
        const u32x2 hw = pre.hw;
        f32x4 o = {bflo(hw.x), bfhi(hw.x), bflo(hw.y), bfhi(hw.y)}; o += a;
        u32x2 w; w.x = pk2(o.x, o.y); w.y = pk2(o.z, o.w); *(u32x2*)(HB + idx) = w;
        float part = (o.x * o.x + o.y * o.y) + (o.z * o.z + o.w * o.w);
        part += __shfl_xor(part, 16); part += __shfl_xor(part, 32);
        if (fq == 0) ssqs[(size_t)(row - TP) * 64 + u] = part;
    }
    __device__ __forceinline__ void operator()(const f32x4 (&acc)[2][2][4][2], const pg8::Unit& u, int wr, int wc, int fr_, int fq_) const {
        int fr = fr_, fq = fq_; asm volatile("" : "+v"(fr), "+v"(fq));
        ERS_PTRS;
        const int col0 = u.pn * 256 + wc * 32 + 8 * fq;
#pragma unroll
        for (int ai = 0; ai < 2; ++ai) {
        u32x4 hpre[4][2];
#pragma unroll
            for (int m = 0; m < 4; ++m)
#pragma unroll
                for (int bj = 0; bj < 2; ++bj) hpre[m][bj] = *(const u32x4*)(Hold + (size_t)(u.pm * 256 + ai * 128 + wr * 64 + m * 16 + fr) * DM + col0 + bj * 128);
        __builtin_amdgcn_sched_barrier(0);
#pragma unroll
            for (int m = 0; m < 4; ++m) {
                const int row = u.pm * 256 + ai * 128 + wr * 64 + m * 16 + fr;
                float part = 0.f;
#pragma unroll
                for (int bj = 0; bj < 2; ++bj) {
                    const int col = col0 + bj * 128; const size_t idx = (size_t)row * DM + col;
                    const u32x4 hw = hpre[m][bj];
                    f32x4 o0 = {bflo(hw.x), bfhi(hw.x), bflo(hw.y), bfhi(hw.y)}, o1 = {bflo(hw.z), bfhi(hw.z), bflo(hw.w), bfhi(hw.w)};
                    o0 += acc[ai][bj][m][0]; o1 += acc[ai][bj][m][1];
                    u32x4 w; w.x = pk2(o0.x, o0.y); w.y = pk2(o0.z, o0.w); w.z = pk2(o1.x, o1.y); w.w = pk2(o1.z, o1.w);
                    *(u32x4*)(HB + idx) = w;
                    part += (o0.x * o0.x + o0.y * o0.y) + (o0.z * o0.z + o0.w * o0.w) + (o1.x * o1.x + o1.y * o1.y) + (o1.z * o1.z + o1.w * o1.w);
                }
                part += __shfl_xor(part, 16); part += __shfl_xor(part, 32);
                if (fq == 0) ssq[(size_t)row * 16 + u.pn * 4 + wc] = part;
            }
        }
    }
};

struct EpiSwaIn {
    static constexpr bool PERM = true;
    unsigned char* ws; float* out; const LAS float* rstd_lds; const LAS float* rope_lds;
#define ESI_PTRS const float* ssq = (const float*)(ws + WS_SSQ); const float* rope = (const float*)(ws + WS_ROPE); bf16_t* QA = (bf16_t*)(ws + WS_Q); bf16_t* GA = (bf16_t*)(ws + WS_G); bf16_t* KA = (bf16_t*)(ws + WS_KA); bf16_t* VA = (bf16_t*)(ws + WS_VA); \
    const float* ssqs = (const float*)(ws + WS_SSQS); (void)ssq; (void)rope; (void)QA; (void)GA; (void)KA; (void)VA; (void)ssqs
    struct Pre { SsqQ q; f32x4 c4, s4; };
    __device__ __forceinline__ Pre sample_pre(int row, int col, int fq) const {
        ESI_PTRS; Pre p; p.q = ssqs_quarter(ssqs, row - TP, fq);
        const float* rp = rope + (size_t)SEQ * 16 + ((4 * fq) & 7); p.c4 = *(const f32x4*)rp; p.s4 = *(const f32x4*)(rp + 8);
        return p; }
    __device__ __forceinline__ void sample(const f32x4 a, int row, int col, int u, int fq, const Pre& pre) const {
        ESI_PTRS;
        const float rs = ssqs_rstd(pre.q);
        float v[4] = {a[0] * rs, a[1] * rs, a[2] * rs, a[3] * rs};
        const int sec = col < 1024 ? 0 : col < 2048 ? 1 : col < 2176 ? 2 : 3;
        if ((sec == 0 || sec == 2) && ((16 * u) & 63) == 0) {
#pragma unroll
            for (int r = 0; r < 4; ++r) { const float pr = __shfl_xor(v[r], 32); const float c = pre.c4[r], s = pre.s4[r];
                v[r] = fq < 2 ? v[r] * c - pr * s : v[r] * c + pr * s; }
        }
        if (sec == 0) {
#pragma unroll
            for (int j = 0; j < 4; ++j) v[j] *= 0.18033688011112042f;
            u32x2 w; w.x = pk2(v[0], v[1]); w.y = pk2(v[2], v[3]); *(u32x2*)(QA + (size_t)row * DM + col) = w;
        } else if (sec == 1) {
#pragma unroll
            for (int j = 0; j < 4; ++j) v[j] = silu_f(v[j]);
            u32x2 w; w.x = pk2(v[0], v[1]); w.y = pk2(v[2], v[3]); *(u32x2*)(GA + (size_t)row * DM + (col - 1024)) = w;
        } else {
            const int kc = sec == 2 ? col - 2048 : col - 2176;
            u32x2 w; w.x = pk2(v[0], v[1]); w.y = pk2(v[2], v[3]); *(u32x2*)((sec == 2 ? KA : VA) + (size_t)row * 128 + kc) = w;
            *(f32x4*)(out + (sec == 2 ? O_KNS : O_VNS) + (size_t)(row - TP) * 128 + kc) = (f32x4){v[0], v[1], v[2], v[3]};
        }
    }
    __device__ __forceinline__ void operator()(const f32x4 (&acc)[2][2][4][2], const pg8::Unit& u, int wr, int wc, int fr_, int fq_) const {
        int fr = fr_, fq = fq_; asm volatile("" : "+v"(fr), "+v"(fq));
        ESI_PTRS;
        const int sec = u.pn >> 2;
        const int colb = (u.pn & 3) * 256 + wc * 32 + 8 * fq;
        const bool rot_wave = (wc & 1) == 0;
#pragma unroll
        for (int ai = 0; ai < 2; ++ai)
#pragma unroll
            for (int m = 0; m < 4; ++m) {
                const int row = u.pm * 256 + ai * 128 + wr * 64 + m * 16 + fr;
                const int rl = ai * 128 + wr * 64 + m * 16 + fr;
                const float rs = rstd_lds[rl];
                float cs[8], sn[8];
                if (sec != 1 && rot_wave) {
                    const LAS f32x4* rp = (const LAS f32x4*)(rope_lds + rl * 16);
                    const f32x4 c0 = rp[0], c1 = rp[1], s0 = rp[2], s1 = rp[3];
                    cs[0] = c0.x; cs[1] = c0.y; cs[2] = c0.z; cs[3] = c0.w; cs[4] = c1.x; cs[5] = c1.y; cs[6] = c1.z; cs[7] = c1.w;
                    sn[0] = s0.x; sn[1] = s0.y; sn[2] = s0.z; sn[3] = s0.w; sn[4] = s1.x; sn[5] = s1.y; sn[6] = s1.z; sn[7] = s1.w;
                }
#pragma unroll
                for (int bj = 0; bj < 2; ++bj) {
                    if (u.hs != 0 && bj != u.hs - 1) continue;
                    float v[8];
#pragma unroll
                    for (int j = 0; j < 4; ++j) { v[j] = acc[ai][bj][m][0][j] * rs; v[4 + j] = acc[ai][bj][m][1][j] * rs; }
                    if (sec == 0) {
                        const int col = colb + bj * 128; const size_t idx = (size_t)row * DM + col;
                        if (rot_wave) {
                            float pr[8];
#pragma unroll
                            for (int j = 0; j < 8; ++j) pr[j] = __shfl_xor(v[j], 16);
                            if (fq < 2) { const float sg = fq == 0 ? -1.0f : 1.0f;
#pragma unroll
                                for (int j = 0; j < 8; ++j) v[j] = v[j] * cs[j] + sg * pr[j] * sn[j]; }
                        }
#pragma unroll
                        for (int j = 0; j < 8; ++j) v[j] *= 0.18033688011112042f;
                        *(u32x4*)(QA + idx) = pack8(v);
                    } else if (sec == 1) {
                        const int col = colb + bj * 128; const size_t idx = (size_t)row * DM + col;
#pragma unroll
                        for (int j = 0; j < 8; ++j) v[j] = silu_f(v[j]);
                        *(u32x4*)(GA + idx) = pack8(v);
                    } else {
                        const int kc = wc * 32 + 8 * fq;
                        const size_t idx = (size_t)row * 128 + kc;
                        if (bj == 0 && rot_wave) {
                            float pr[8];
#pragma unroll
                            for (int j = 0; j < 8; ++j) pr[j] = __shfl_xor(v[j], 16);
                            if (fq < 2) { const float sg = fq == 0 ? -1.0f : 1.0f;
#pragma unroll
                                for (int j = 0; j < 8; ++j) v[j] = v[j] * cs[j] + sg * pr[j] * sn[j]; }
                        }
                        *(u32x4*)((bj == 0 ? KA : VA) + idx) = pack8(v);
                        float* dst = nullptr;
                        if (row < TP) { const int t = row & (SEQ - 1); if (t >= SEQ - 128) dst = out + (bj == 0 ? O_KWP : O_VWP) + ((size_t)((row >> 11) * 128 + (t - (SEQ - 128))) * 128 + kc); }
                        else if (row < TP + TS) dst = out + (bj == 0 ? O_KNS : O_VNS) + ((size_t)(row - TP) * 128 + kc);
                        if (dst) { *(f32x4*)dst = (f32x4){v[0], v[1], v[2], v[3]}; *(f32x4*)(dst + 4) = (f32x4){v[4], v[5], v[6], v[7]}; }
                    }
                }
            }
    }
};

#define LDS_BARRIER() asm volatile("s_waitcnt lgkmcnt(0)\n\ts_barrier" ::: "memory")
template <int ROWS, int COLS, class Epi>
__device__ __forceinline__ void sgemm_unit(LAS unsigned char* lds, const bf16_t* HBs, const bf16_t* Bt, int u, const Epi& E, int wave, int lane, const int tid) {
    constexpr int KC = 256, NCH = 1024 / KC;
    constexpr int XP = KC * 2 + 16, XBUF = (ROWS + COLS) * XP;
    constexpr int NLX = ROWS / 16, NLW = (COLS * 32 + 511) / 512;
    constexpr int NRG = 128 / ROWS;
    const int cgu = u / NRG, row0 = ROWS * (u % NRG), col0 = COLS * cgu;
    const int fr = lane & 15, fq = lane >> 4;
    const int rt = COLS == 16 ? wave : (wave & 3), ct = COLS == 16 ? 0 : (wave >> 2);
    const int lr = tid >> 5, lc = tid & 31;
    const bool wl = COLS * 32 >= 512 || tid < COLS * 32;
    const bf16_t* xa = HBs + (size_t)(row0 + lr) * DM + lc * 8;
    const bf16_t* wa = Bt + (size_t)(col0 + (lr & (COLS - 1))) * DM + lc * 8;
    u32x4 xr[NCH][NLX], wv[NCH][NLW];
#pragma unroll
    for (int c = 0; c < NCH; ++c) {
#pragma unroll
        for (int i = 0; i < NLX; ++i) xr[c][i] = *(const u32x4*)(xa + (size_t)16 * i * DM + KC * c);
#pragma unroll
        for (int i = 0; i < NLW; ++i) { if (wl) wv[c][i] = *(const u32x4*)(wa + (size_t)16 * i * DM + KC * c); }
    }
    const int srow = TP + row0 + 16 * rt + fr, scol = col0 + 16 * ct + 4 * fq;
    typename Epi::Pre pre;
    if (16 * rt < ROWS) pre = E.sample_pre(srow, scol, fq);
    f32x4 acc = {0.f, 0.f, 0.f, 0.f};
#pragma unroll
    for (int c = 0; c < NCH; ++c) {
        LAS unsigned char* buf = lds + (c & 1) * XBUF;
#pragma unroll
        for (int i = 0; i < NLX; ++i) *(LAS u32x4*)(buf + (lr + 16 * i) * XP + lc * 16) = xr[c][i];
#pragma unroll
        for (int i = 0; i < NLW; ++i) { if (wl) *(LAS u32x4*)(buf + (ROWS + lr + 16 * i) * XP + lc * 16) = wv[c][i]; }
        LDS_BARRIER();
        if (16 * rt < ROWS) {
#pragma unroll
            for (int k4 = 0; k4 < KC / 32; k4 += 4) {
                bf16x8 xf[4], wf[4];
#pragma unroll
                for (int i = 0; i < 4; ++i) {
                    xf[i] = *(const LAS bf16x8*)(buf + (16 * rt + fr) * XP + (32 * (k4 + i) + 8 * fq) * 2);
                    wf[i] = *(const LAS bf16x8*)(buf + (ROWS + 16 * ct + fr) * XP + (32 * (k4 + i) + 8 * fq) * 2); }
                __builtin_amdgcn_sched_barrier(0);
#pragma unroll
                for (int i = 0; i < 4; ++i) acc = MFMA16(wf[i], xf[i], acc);
                __builtin_amdgcn_sched_barrier(0);
            }
        }
    }
    LDS_BARRIER();
    if (16 * rt < ROWS) E.sample(acc, srow, scol, (col0 >> 4) + ct, fq, pre);
}

#define XB_TMO      128
#define XB_XCNT(j)  (256  + 64 * (j))
#define XB_XSUB(j)  (1280 + 64 * (j))
#define XB_XGEN(j)  (2304 + 64 * (j))
#define XB_TOP      3328
#define XB_TOPGEN   3392
#define XCD_BAR_WORDS 3456
#define XB_SPIN_CAP (1u << 18)
__device__ __forceinline__ unsigned xb_ld(unsigned* p)              { return __hip_atomic_load(p, __ATOMIC_RELAXED, __HIP_MEMORY_SCOPE_AGENT); }
__device__ __forceinline__ unsigned xb_add(unsigned* p, unsigned v) { return __hip_atomic_fetch_add(p, v, __ATOMIC_RELAXED, __HIP_MEMORY_SCOPE_AGENT); }
__device__ __forceinline__ unsigned xb_xcc_id() { return (unsigned)__builtin_amdgcn_s_getreg((3 << 11) | 20) & 0xFu; }
#define XB_SPIN(cond, bar) do { unsigned _sp = 0; while (cond) { __builtin_amdgcn_s_sleep(1); \
    if ((++_sp & 255u) == 0u) { if (xb_ld(&(bar)[XB_TMO])) break; if (_sp > XB_SPIN_CAP) { atomicAdd(&(bar)[XB_TMO], 1u); break; } } } } while (0)
struct XcdBarrier { unsigned* bar; unsigned x; volatile LAS unsigned* st; };
__device__ __forceinline__ XcdBarrier xcd_barrier_post(unsigned* bar, volatile LAS unsigned* st) {
    XcdBarrier b; b.bar = bar; b.x = xb_xcc_id(); b.st = st;
    if (threadIdx.x == 0) (void)xb_add(&bar[XB_XCNT(b.x)], 1u);
    return b;
}
__device__ __forceinline__ void xcd_barrier_complete(unsigned* bar, unsigned x, unsigned& nloc, unsigned& nx) {
    const unsigned G = gridDim.x * gridDim.y * gridDim.z;
    unsigned sum, cnt, mine, sp = 0u;
    for (;;) {
        sum = 0u; cnt = 0u; mine = 0u;
#pragma unroll
        for (unsigned j = 0; j < 16; ++j) { const unsigned c = xb_ld(&bar[XB_XCNT(j)]); sum += c; cnt += (c > 0u) ? 1u : 0u; mine = (j == x) ? c : mine; }
        if (sum == G) break;
        __builtin_amdgcn_s_sleep(1);
        if ((++sp & 255u) == 0u) { if (xb_ld(&bar[XB_TMO])) break; if (sp > XB_SPIN_CAP) { atomicAdd(&bar[XB_TMO], 1u); break; } }
    }
    nloc = mine > 0u ? mine : 1u; nx = cnt > 0u ? cnt : 1u;
}
__device__ __forceinline__ void xcd_barrier(const XcdBarrier& b) {
    asm volatile("s_waitcnt vmcnt(0)" ::: "memory");
    __syncthreads();
    if (threadIdx.x == 0) {
        unsigned* bar = b.bar;
        __builtin_amdgcn_s_waitcnt(0);
        unsigned nloc = b.st[0], nx = b.st[1];
        if (nloc == 0u) { xcd_barrier_complete(bar, b.x, nloc, nx); b.st[0] = nloc; b.st[1] = nx; }
        const unsigned old = xb_add(&bar[XB_XSUB(b.x)], 1u);
        const unsigned gen = old / nloc;
        if (old + 1u == (gen + 1u) * nloc) {
            __builtin_amdgcn_fence(__ATOMIC_RELEASE, "agent");
            asm volatile("s_waitcnt vmcnt(0)" ::: "memory");
            const unsigned og = xb_add(&bar[XB_TOP], 1u);
            const unsigned tg = og / nx;
            if (og + 1u == (tg + 1u) * nx) xb_add(&bar[XB_TOPGEN], 1u);
            else XB_SPIN(xb_ld(&bar[XB_TOPGEN]) == tg, bar);
            __builtin_amdgcn_fence(__ATOMIC_ACQUIRE, "agent");
            xb_add(&bar[XB_XGEN(b.x)], 1u);
            asm volatile("s_waitcnt vmcnt(0)" ::: "memory");
        } else {
            XB_SPIN(xb_ld(&bar[XB_XGEN(b.x)]) == gen, bar);
            __builtin_amdgcn_fence(__ATOMIC_ACQUIRE, "agent");
            asm volatile("s_waitcnt vmcnt(0)" ::: "memory");
        }
    }
    __syncthreads();
}

constexpr int RING_OFF = 0, RING_BYTES = 131072;
constexpr int LDSCTL_OFF = RING_BYTES, MISC_OFF = LDSCTL_OFF + 320;
constexpr int RSTD_OFF = 131584, ROPEL_OFF = 132608;
constexpr int LDS_BYTES = 155648;
constexpr int NWAVES = 8;

struct Args {
    const float* in[17]; float* out; unsigned char* ws; int ph_lo, ph_hi;
};
typedef const Args __attribute__((address_space(4)))* KArgPtr;
__device__ __forceinline__ KArgPtr kargs() { KArgPtr p = (KArgPtr)__builtin_amdgcn_kernarg_segment_ptr(); asm volatile("" : "+s"(p)); return p; }
__device__ __forceinline__ int fresh_tid() { int t = threadIdx.x; asm volatile("" : "+v"(t)); return t; }

__device__ __forceinline__ void stage_row_tables(unsigned char* ws, int pm, LAS unsigned char* lds, bool with_rope, const int tid) {
    if (tid < 256) ((LAS float*)(lds + RSTD_OFF))[tid] = row_rstd((const float*)(ws + WS_SSQ), pm * 256 + tid);
    if (with_rope) {
        const f32x4* rope = (const f32x4*)(ws + WS_ROPE);
#pragma unroll
        for (int i = 0; i < 2; ++i) { const int v = tid + 512 * i, r = v >> 2, part = v & 3; ((LAS f32x4*)(lds + ROPEL_OFF))[v] = rope[(size_t)((pm * 256 + r) & (SEQ - 1)) * 4 + part]; }
    }
    __syncthreads();
}

__device__ __forceinline__ void p0_transpose_item(const float* W, const float* scale, int smask, int K, int N, bf16_t* WT, int row_off, LAS float* scr, int item, int lane) {
    const int nblk = N / 32, kb = item / nblk, nb = item % nblk, k0 = 64 * kb, n0 = 32 * nb;
#pragma unroll 8
    for (int i = 0; i < 32; ++i) { const int kk = 2 * i + (lane >> 5); const float sc = scale ? scale[(k0 + kk) & smask] : 1.0f;
        scr[kk * 33 + (lane & 31)] = __builtin_nontemporal_load(W + (size_t)(k0 + kk) * N + n0 + (lane & 31)) * sc; }
    LDS_WAIT(); asm volatile("" ::: "memory");
    const int c = lane & 7;
#pragma unroll
    for (int j = 0; j < 4; ++j) { const int n = (lane >> 3) + 8 * j; const LAS float* s = scr + (8 * c) * 33 + n;
        u32x4 o; o.x = pk2(s[0 * 33], s[1 * 33]); o.y = pk2(s[2 * 33], s[3 * 33]); o.z = pk2(s[4 * 33], s[5 * 33]); o.w = pk2(s[6 * 33], s[7 * 33]);
        *(u32x4*)(WT + (size_t)(row_off + n0 + n) * K + k0 + 8 * c) = o; }
    LDS_WAIT(); asm volatile("" ::: "memory");
}

__device__ __forceinline__ void p0_prologue(KArgPtr Ap, LAS unsigned char* lds, int wave, int lane) {
    unsigned char* ws = Ap->ws;
    LAS float* scr = (LAS float*)(lds + RING_OFF + wave * 16384);
    const int G = gridDim.x, gw = blockIdx.x * NWAVES + wave, NGW = G * NWAVES;
    constexpr int I_AIN = 16 * 128, I_SQ = 16 * 32, I_BIN = 16 * 64, I_KV = 16 * 8;
    constexpr int NITEMS = 2 * I_AIN + 2 * I_SQ + 2 * I_BIN + I_KV + 2 * I_SQ;
    for (int it = gw; it < NITEMS; it += NGW) {
        int r = it;
        if (r < I_AIN) { p0_transpose_item(Ap->in[6], Ap->in[5], 1023, 1024, 4096, (bf16_t*)(ws + WS_WIN0), 0, scr, r, lane); continue; } r -= I_AIN;
        if (r < I_AIN) { p0_transpose_item(Ap->in[6] + (size_t)1024 * 4096, Ap->in[5] + 1024, 1023, 1024, 4096, (bf16_t*)(ws + WS_WIN1), 0, scr, r, lane); continue; } r -= I_AIN;
        if (r < I_SQ) { p0_transpose_item(Ap->in[9], Ap->in[8], 127, 1024, 1024, (bf16_t*)(ws + WS_WOUT0), 0, scr, r, lane); continue; } r -= I_SQ;
        if (r < I_SQ) { p0_transpose_item(Ap->in[9] + (size_t)1024 * 1024, Ap->in[8] + 128, 127, 1024, 1024, (bf16_t*)(ws + WS_WOUT1), 0, scr, r, lane); continue; } r -= I_SQ;
        if (r < I_BIN) { p0_transpose_item(Ap->in[13], Ap->in[12], 1023, 1024, 2048, (bf16_t*)(ws + WS_WINB0), 0, scr, r, lane); continue; } r -= I_BIN;
        if (r < I_BIN) { p0_transpose_item(Ap->in[13] + (size_t)1024 * 2048, Ap->in[12] + 1024, 1023, 1024, 2048, (bf16_t*)(ws + WS_WINB1), 0, scr, r, lane); continue; } r -= I_BIN;
        if (r < I_KV) { p0_transpose_item(Ap->in[11], Ap->in[10], 1023, 1024, 256, (bf16_t*)(ws + WS_WINB0), 2048, scr, r, lane); continue; } r -= I_KV;
        if (r < I_SQ) { p0_transpose_item(Ap->in[15], nullptr, 0, 1024, 1024, (bf16_t*)(ws + WS_WOUTB0), 0, scr, r, lane); continue; } r -= I_SQ;
        p0_transpose_item(Ap->in[15] + (size_t)1024 * 1024, nullptr, 0, 1024, 1024, (bf16_t*)(ws + WS_WOUTB1), 0, scr, r, lane);
    }
    bf16_t* HB = (bf16_t*)(ws + WS_HB); float* SSQ = (float*)(ws + WS_SSQ);
    float* SSQS = (float*)(ws + WS_SSQS);
    for (int m = gw; m < TP + TS; m += NGW) {
        f32x4 v[4]; float s = 0.f;
        if (m < TP + TS) {
            const f32x4* xr = (const f32x4*)(m < TP ? Ap->in[0] + (size_t)m * DM : Ap->in[1] + (size_t)(m - TP) * DM) + lane;
#pragma unroll
            for (int j = 0; j < 4; ++j) { v[j] = __builtin_nontemporal_load(xr + 64 * j); s += (v[j].x * v[j].x + v[j].y * v[j].y) + (v[j].z * v[j].z + v[j].w * v[j].w); }
        } else {
#pragma unroll
            for (int j = 0; j < 4; ++j) v[j] = (f32x4){0.f, 0.f, 0.f, 0.f};
        }
        s = wave_sum(s);
        u32x2* o8 = (u32x2*)(HB + (size_t)m * DM) + lane;
#pragma unroll
        for (int j = 0; j < 4; ++j) { u32x2 w; w.x = pk2(v[j].x, v[j].y); w.y = pk2(v[j].z, v[j].w); o8[64 * j] = w; }
        if (m < TP) { if (lane < 16) SSQ[(size_t)m * 16 + lane] = lane == 0 ? s : 0.f; }
        else SSQS[(size_t)(m - TP) * 64 + lane] = lane == 0 ? s : 0.f;
    }
    const int gt = blockIdx.x * (NWAVES * 64) + threadIdx.x, NGT = G * NWAVES * 64;
    float* LB1 = (float*)(ws + WS_LB1); float* ROPE = (float*)(ws + WS_ROPE);
    for (int i = gt; i < 1024; i += NGT) { const float l0 = Ap->in[7][i], l1 = Ap->in[7][1024 + i]; LB1[i] = 1.0f / (1.0f + expf(l0 - l1)); }
    for (int i = gt; i < (SEQ + 1) * 8; i += NGT) {
        const int p = i >> 3, j = i & 7; const double pos = p < SEQ ? (double)p : 8192.0;
        const double invf[8] = {1.0, 0.19392274474868576, 0.03760603093086393, 0.007292664737217109, 0.001414213562373095, 0.0002742481756762073, 5.318295896944988e-05, 1.031338537721246e-05};
        double fr_ = invf[0];
#pragma unroll
        for (int q = 1; q < 8; ++q) fr_ = (j == q) ? invf[q] : fr_;
        const double x = pos * fr_;
        const double qd = __builtin_rint(x * 0.6366197723675814);
        const double r = (x - qd * 1.5707963267948966) - qd * 6.123233995736766e-17;
        const double r2 = r * r;
        const double sr = r * (1.0 + r2 * (-1.0 / 6 + r2 * (1.0 / 120 + r2 * (-1.0 / 5040 + r2 * (1.0 / 362880 + r2 * (-1.0 / 39916800 + r2 * (1.0 / 6227020800.0)))))));
        const double cr = 1.0 + r2 * (-0.5 + r2 * (1.0 / 24 + r2 * (-1.0 / 720 + r2 * (1.0 / 40320 + r2 * (-1.0 / 3628800 + r2 * (1.0 / 479001600.0 + r2 * (-1.0 / 87178291200.0)))))));
        const int qi = ((int)((long long)qd)) & 3;
        const double sv = (qi == 0) ? sr : (qi == 1) ? cr : (qi == 2) ? -sr : -cr;
        const double cv = (qi == 0) ? cr : (qi == 1) ? -sr : (qi == 2) ? -cr : sr;
        ROPE[(size_t)p * 16 + j] = (float)cv; ROPE[(size_t)p * 16 + 8 + j] = (float)sv;
    }
}

constexpr int CP = 288, LFI_OFF = 0, QI_OFF = 18432, KI2_OFF = 36864, VI2_OFF = 55296, AM_OFF = 73728, BETA_OFF = 82944, EM_OFF = 83456, LAM1_OFF = 83968;
__device__ __forceinline__ s16x4 tr_read(const LAS unsigned char* p) { return __builtin_bit_cast(s16x4, __builtin_amdgcn_ds_read_tr16_b64_v4i16((LAS s16x4*)p)); }
struct ChunkIn { u32x4 lw[2], qv[2], vv[2]; };
__device__ __forceinline__ void chunk_load(ChunkIn& r, int unit, const bf16_t* Q, const bf16_t* Kb, const bf16_t* LF, const bf16_t* V, const int tid) {
    const int c = unit & 31, bh = unit >> 5, h = bh & 7, b = bh >> 3;
    const size_t g = ((size_t)b * SEQ + (size_t)c * 64 + (tid >> 3)) * DM + h * 128 + (tid & 7) * 8;
#pragma unroll
    for (int i = 0; i < 2; ++i) { r.lw[i] = *(const u32x4*)(LF + g + 64 * i); r.qv[i] = *(const u32x4*)(Q + g + 64 * i); r.vv[i] = *(const u32x4*)(V + g + 64 * i); }
}
__device__ __forceinline__ bf16x8 tr_frag(const LAS unsigned char* img, int kk, int col0, int fr, int fq) {
    const LAS unsigned char* p = img + (32 * kk + 4 * fq + (fr >> 2)) * CP + (col0 + 4 * (fr & 3)) * 2;
    const s16x4 lo = tr_read(p), hi = tr_read(p + 16 * CP);
    return (bf16x8){lo[0], lo[1], lo[2], lo[3], hi[0], hi[1], hi[2], hi[3]};
}
__device__ __forceinline__ void chunk_stepA(LAS unsigned char* lds, int unit, const int pos, float (&lam0)[4], const ChunkIn& r, bf16_t* Qo, float* LAM, int wave, int lane, const int tid) {
    const int c = unit & 31, bh = unit >> 5, h = bh & 7, b = bh >> 3;
    const size_t row0 = (size_t)b * SEQ + (size_t)c * 64;
    const int fr = lane & 15, fq = lane >> 4;
    LAS unsigned char* LFI = lds + LFI_OFF; LAS unsigned char* QI = lds + QI_OFF; LAS unsigned char* KI = lds + KI2_OFF; LAS unsigned char* VI = lds + VI2_OFF;
    LAS float* BETA = (LAS float*)(lds + BETA_OFF); LAS float* EM = (LAS float*)(lds + EM_OFF); LAS float* LAM1 = (LAS float*)(lds + LAM1_OFF);
    { const int lo = (tid >> 3) * CP + (tid & 7) * 16;
#pragma unroll
      for (int i = 0; i < 2; ++i) { *(LAS u32x4*)(LFI + lo + 128 * i) = r.lw[i]; *(LAS u32x4*)(QI + lo + 128 * i) = r.qv[i]; *(LAS u32x4*)(VI + lo + 128 * i) = r.vv[i]; } }
    LDS_BARRIER();
    f32x4 bt[4];
#pragma unroll
    for (int tt = 0; tt < 4; ++tt) {
        f32x4 acc = {0.f, 0.f, 0.f, 0.f};
#pragma unroll
        for (int kk = 0; kk < 2; ++kk) if (32 * kk <= 16 * tt + 15) {
            const bf16x8 a = tr_frag(LFI, kk, 16 * wave, fr, fq);
            const int t = 16 * tt + fr, s0 = 32 * kk + 4 * fq;
            bf16x8 tri;
#pragma unroll
            for (int jj = 0; jj < 8; ++jj) tri[jj] = (s0 + (jj < 4 ? jj : 12 + jj)) <= t ? (short)0x3F80 : (short)0;
            acc = MFMA16(a, tri, acc);
        }
        bt[tt] = acc;
    }
    float bmid[4], em[4];
#pragma unroll
    for (int j = 0; j < 4; ++j) {
        bmid[j] = __shfl(bt[1][j], (lane & 48) | 15);
        const float bend = __shfl(bt[3][j], (lane & 48) | 15);
        em[j] = __expf(bmid[j]);
        const float lam = __expf(bend);
        const int d = 16 * wave + 4 * fq + j;
        if (fr == 0) { BETA[d] = __expf(bend - bmid[j]); if (pos > 0) { EM[d] = em[j]; LAM1[d] = lam; } if (pos == 3) LAM[(size_t)(((unit >> 5) << 3) + ((unit & 31) >> 2)) * 128 + d] = lam0[j] * lam; }
        if (pos > 0) { em[j] *= lam0[j]; lam0[j] *= lam; } else lam0[j] = lam;
    }
#pragma unroll
    for (int tt = 0; tt < 4; ++tt) {
        const int ao = (16 * tt + fr) * CP + (16 * wave + 4 * fq) * 2;
        const u32x2 qw = *(const LAS u32x2*)(QI + ao), lw = *(const LAS u32x2*)(LFI + ao);
        const float qf[4] = {bflo(qw.x), bfhi(qw.x), bflo(qw.y), bfhi(qw.y)};
        const float kf[4] = {1.0f - __expf(bflo(lw.x)), 1.0f - __expf(bfhi(lw.x)), 1.0f - __expf(bflo(lw.y)), 1.0f - __expf(bfhi(lw.y))};
        float qt[4], kt[4], qh[4];
#pragma unroll
        for (int j = 0; j < 4; ++j) { const float e1 = __expf(bt[tt][j] - bmid[j]), e2 = __expf(bmid[j] - bt[tt][j]); qt[j] = qf[j] * e1; kt[j] = kf[j] * e2; qh[j] = qt[j] * em[j]; }
        u32x2 w; w.x = pk2(qt[0], qt[1]); w.y = pk2(qt[2], qt[3]); *(LAS u32x2*)(QI + ao) = w;
        w.x = pk2(kt[0], kt[1]); w.y = pk2(kt[2], kt[3]); *(LAS u32x2*)(KI + ao) = w;
        w.x = pk2(qh[0], qh[1]); w.y = pk2(qh[2], qh[3]); *(u32x2*)(Qo + (row0 + 16 * tt + fr) * DM + h * 128 + 16 * wave + 4 * fq) = w;
    }
    LDS_BARRIER();
}
__device__ __forceinline__ void chunk_stepBC(LAS unsigned char* lds, int unit, const int pos, f32x4 (&ds0)[8], bf16_t* LFo, bf16_t* DS, int wave, int lane) {
    const int c = unit & 31, bh = unit >> 5, h = bh & 7, b = bh >> 3;
    const size_t row0 = (size_t)b * SEQ + (size_t)c * 64;
    const int fr = lane & 15, fq = lane >> 4;
    LAS unsigned char* QI = lds + QI_OFF; LAS unsigned char* KI = lds + KI2_OFF; LAS unsigned char* VI = lds + VI2_OFF;
    LAS bf16_t* AM = (LAS bf16_t*)(lds + AM_OFF); LAS float* BETA = (LAS float*)(lds + BETA_OFF); LAS float* EM = (LAS float*)(lds + EM_OFF); LAS float* LAM1 = (LAS float*)(lds + LAM1_OFF);
#pragma unroll
    for (int ii = 0; ii < 2; ++ii) {
        const int idx = 2 * wave + ii, st = idx >> 2, tt = idx & 3;
        f32x4 acc = {0.f, 0.f, 0.f, 0.f};
        if (st <= tt) {
#pragma unroll
            for (int kk = 0; kk < 4; ++kk) {
                const bf16x8 a = *(const LAS bf16x8*)(KI + (16 * st + fr) * CP + (32 * kk + 8 * fq) * 2);
                const bf16x8 bq = *(const LAS bf16x8*)(QI + (16 * tt + fr) * CP + (32 * kk + 8 * fq) * 2);
                acc = MFMA16(a, bq, acc);
            }
        }
        const int t = 16 * tt + fr, s0 = 16 * st + 4 * fq;
        float m0 = (s0 + 0 <= t) ? acc[0] : 0.f, m1 = (s0 + 1 <= t) ? acc[1] : 0.f, m2 = (s0 + 2 <= t) ? acc[2] : 0.f, m3 = (s0 + 3 <= t) ? acc[3] : 0.f;
        u32x2 w; w.x = pk2(m0, m1); w.y = pk2(m2, m3);
        *(LAS u32x2*)(AM + t * 72 + s0) = w;
    }
    LDS_BARRIER();
    bf16x8 va[2];
#pragma unroll
    for (int kk = 0; kk < 2; ++kk) va[kk] = tr_frag(VI, kk, 16 * wave, fr, fq);
    bf16x8 sf[4];
    if (pos > 0) {
#pragma unroll
        for (int kk = 0; kk < 4; ++kk) {
            const f32x4 e0 = *(const LAS f32x4*)(EM + 32 * kk + 4 * fq), e1 = *(const LAS f32x4*)(EM + 32 * kk + 16 + 4 * fq);
            const f32x4 x0 = ds0[2 * kk] * e0, x1 = ds0[2 * kk + 1] * e1;
            u32x4 w; w.x = pk2(x0[0], x0[1]); w.y = pk2(x0[2], x0[3]); w.z = pk2(x1[0], x1[1]); w.w = pk2(x1[2], x1[3]);
            sf[kk] = __builtin_bit_cast(bf16x8, w);
        }
    }
#pragma unroll
    for (int tt = 0; tt < 4; ++tt) {
        f32x4 acc = {0.f, 0.f, 0.f, 0.f};
        if (pos > 0) {
#pragma unroll
            for (int kk = 0; kk < 4; ++kk) {
                const LAS unsigned char* qp = QI + (16 * tt + fr) * CP + (32 * kk + 4 * fq) * 2;
                const u32x2 lo = *(const LAS u32x2*)qp, hi = *(const LAS u32x2*)(qp + 32);
                u32x4 w; w.x = lo.x; w.y = lo.y; w.z = hi.x; w.w = hi.y;
                acc = MFMA16(sf[kk], __builtin_bit_cast(bf16x8, w), acc);
            }
        }
#pragma unroll
        for (int kk = 0; kk < 2; ++kk) {
            const LAS bf16_t* ap = AM + (16 * tt + fr) * 72 + 32 * kk + 4 * fq;
            const u32x2 lo = *(const LAS u32x2*)ap, hi = *(const LAS u32x2*)(ap + 16);
            u32x4 w; w.x = lo.x; w.y = lo.y; w.z = hi.x; w.w = hi.y;
            acc = MFMA16(va[kk], __builtin_bit_cast(bf16x8, w), acc);
        }
        { u32x2 wo; wo.x = pk2(acc[0], acc[1]); wo.y = pk2(acc[2], acc[3]); *(u32x2*)(LFo + (row0 + 16 * tt + fr) * DM + h * 128 + 16 * wave + 4 * fq) = wo; }
    }
#pragma unroll
    for (int dt = 0; dt < 8; ++dt) {
        f32x4 acc = {0.f, 0.f, 0.f, 0.f};
#pragma unroll
        for (int kk = 0; kk < 2; ++kk) { const bf16x8 ak = tr_frag(KI, kk, 16 * dt, fr, fq); acc = MFMA16(ak, va[kk], acc); }
        const f32x4 be = *(const LAS f32x4*)(BETA + 16 * dt + 4 * fq);
        acc *= be;
        if (pos > 0) acc += ds0[dt] * *(const LAS f32x4*)(LAM1 + 16 * dt + 4 * fq);
        if (pos == 3) {
            u32x2 w; w.x = pk2(acc[0], acc[1]); w.y = pk2(acc[2], acc[3]);
            *(u32x2*)(DS + (((size_t)(((unit >> 5) << 3) + ((unit & 31) >> 2)) * 64 + dt * 8 + wave) * 64 + lane) * 4) = w;
        } else ds0[dt] = acc;
    }
    LDS_BARRIER();
}

constexpr int C2_SETB = 65536, C2_QI = 0, C2_KI = 18432, C2_VI = 36864, C2_AM = 55296, C2_AMP = 80, C2_SM0 = 150016, C2_SM1 = 151552, C2_LFI = 131584;
__device__ __forceinline__ LAS unsigned char* c2_set(LAS unsigned char* lds, int s) { return lds + s * C2_SETB; }
__device__ __forceinline__ LAS float* c2_small(LAS unsigned char* lds, int s) { return (LAS float*)(lds + (s ? C2_SM1 : C2_SM0)); }
__device__ __forceinline__ void chunk_A1(LAS unsigned char* lds, int s, const ChunkIn& r, const int tid) {
    LAS unsigned char* sb = c2_set(lds, s); LAS unsigned char* LFI = lds + C2_LFI;
    const int lo = (tid >> 3) * CP + (tid & 7) * 16;
#pragma unroll
    for (int i = 0; i < 2; ++i) { *(LAS u32x4*)(LFI + lo + 128 * i) = r.lw[i]; *(LAS u32x4*)(sb + C2_QI + lo + 128 * i) = r.qv[i]; *(LAS u32x4*)(sb + C2_VI + lo + 128 * i) = r.vv[i]; }
}
__device__ __forceinline__ void chunk_A2(LAS unsigned char* lds, int s, int unit, const int pos, float (&lam0)[4], bf16_t* Qo, float* LAM, int wave, int lane) {
    const int c = unit & 31, bh = unit >> 5, h = bh & 7, b = bh >> 3;
    const size_t row0 = (size_t)b * SEQ + (size_t)c * 64;
    const int fr = lane & 15, fq = lane >> 4;
    LAS unsigned char* sb = c2_set(lds, s); LAS unsigned char* LFI = lds + C2_LFI; LAS unsigned char* QI = sb + C2_QI; LAS unsigned char* KI = sb + C2_KI;
    LAS float* BETA = c2_small(lds, s); LAS float* EM = BETA + 128; LAS float* LAM1 = BETA + 256;
    f32x4 bt[4];
#pragma unroll
    for (int tt = 0; tt < 4; ++tt) {
        f32x4 acc = {0.f, 0.f, 0.f, 0.f};
#pragma unroll
        for (int kk = 0; kk < 2; ++kk) if (32 * kk <= 16 * tt + 15) {
            const bf16x8 a = tr_frag(LFI, kk, 16 * wave, fr, fq);
            const int t = 16 * tt + fr, s0 = 32 * kk + 4 * fq;
            bf16x8 tri;
#pragma unroll
            for (int jj = 0; jj < 8; ++jj) tri[jj] = (s0 + (jj < 4 ? jj : 12 + jj)) <= t ? (short)0x3F80 : (short)0;
            acc = MFMA16(a, tri, acc);
        }
        bt[tt] = acc;
    }
    float bmid[4], em[4];
#pragma unroll
    for (int j = 0; j < 4; ++j) {
        bmid[j] = __shfl(bt[1][j], (lane & 48) | 15);
        const float bend = __shfl(bt[3][j], (lane & 48) | 15);
        em[j] = __expf(bmid[j]);
        const float lam = __expf(bend);
        const int d = 16 * wave + 4 * fq + j;
        if (fr == 0) { BETA[d] = __expf(bend - bmid[j]); if (pos > 0) { EM[d] = em[j]; LAM1[d] = lam; } if (pos == 3) LAM[(size_t)(((unit >> 5) << 3) + ((unit & 31) >> 2)) * 128 + d] = lam0[j] * lam; }
        if (pos > 0) { em[j] *= lam0[j]; lam0[j] *= lam; } else lam0[j] = lam;
    }
#pragma unroll
    for (int tt = 0; tt < 4; ++tt) {
        const int ao = (16 * tt + fr) * CP + (16 * wave + 4 * fq) * 2;
        const u32x2 qw = *(const LAS u32x2*)(QI + ao), lw = *(const LAS u32x2*)(LFI + ao);
        const float qf[4] = {bflo(qw.x), bfhi(qw.x), bflo(qw.y), bfhi(qw.y)};
        const float kf[4] = {1.0f - __expf(bflo(lw.x)), 1.0f - __expf(bfhi(lw.x)), 1.0f - __expf(bflo(lw.y)), 1.0f - __expf(bfhi(lw.y))};
        float qt[4], kt[4], qh[4];
#pragma unroll
        for (int j = 0; j < 4; ++j) { const float e1 = __expf(bt[tt][j] - bmid[j]), e2 = __expf(bmid[j] - bt[tt][j]); qt[j] = qf[j] * e1; kt[j] = kf[j] * e2; qh[j] = qt[j] * em[j]; }
        u32x2 w; w.x = pk2(qt[0], qt[1]); w.y = pk2(qt[2], qt[3]); *(LAS u32x2*)(QI + ao) = w;
        w.x = pk2(kt[0], kt[1]); w.y = pk2(kt[2], kt[3]); *(LAS u32x2*)(KI + ao) = w;
        w.x = pk2(qh[0], qh[1]); w.y = pk2(qh[2], qh[3]); *(u32x2*)(Qo + (row0 + 16 * tt + fr) * DM + h * 128 + 16 * wave + 4 * fq) = w;
    }
}
__device__ __forceinline__ void chunk_B(LAS unsigned char* lds, int s, int wave, int lane) {
    const int fr = lane & 15, fq = lane >> 4;
    LAS unsigned char* sb = c2_set(lds, s); LAS unsigned char* QI = sb + C2_QI; LAS unsigned char* KI = sb + C2_KI; LAS bf16_t* AM = (LAS bf16_t*)(sb + C2_AM);
    bf16x8 ka[2][4], qa[2][4];
#pragma unroll
    for (int ii = 0; ii < 2; ++ii) {
        const int idx = 2 * wave + ii, st = idx >> 2, tt = idx & 3;
#pragma unroll
        for (int kk = 0; kk < 4; ++kk) {
            ka[ii][kk] = *(const LAS bf16x8*)(KI + (16 * st + fr) * CP + (32 * kk + 8 * fq) * 2);
            qa[ii][kk] = *(const LAS bf16x8*)(QI + (16 * tt + fr) * CP + (32 * kk + 8 * fq) * 2);
        }
    }
    __builtin_amdgcn_sched_barrier(0);
    f32x4 acc[2] = {{0.f, 0.f, 0.f, 0.f}, {0.f, 0.f, 0.f, 0.f}};
#pragma unroll
    for (int kk = 0; kk < 4; ++kk)
#pragma unroll
        for (int ii = 0; ii < 2; ++ii) acc[ii] = MFMA16(ka[ii][kk], qa[ii][kk], acc[ii]);
#pragma unroll
    for (int ii = 0; ii < 2; ++ii) {
        const int idx = 2 * wave + ii, st = idx >> 2, tt = idx & 3;
        const int t = 16 * tt + fr, s0 = 16 * st + 4 * fq;
        float m0 = (s0 + 0 <= t) ? acc[ii][0] : 0.f, m1 = (s0 + 1 <= t) ? acc[ii][1] : 0.f, m2 = (s0 + 2 <= t) ? acc[ii][2] : 0.f, m3 = (s0 + 3 <= t) ? acc[ii][3] : 0.f;
        u32x2 w; w.x = pk2(m0, m1); w.y = pk2(m2, m3);
        *(LAS u32x2*)(AM + t * C2_AMP + 32 * (st >> 1) + 8 * fq + 4 * (st & 1)) = w;
    }
}
template <int POS>
__device__ __forceinline__ void chunk_C(LAS unsigned char* lds, int s, int unit, f32x4 (&ds0)[8], bf16_t* LFo, bf16_t* DS, int wave, int lane) {
    const int c = unit & 31, bh = unit >> 5, h = bh & 7, b = bh >> 3;
    const size_t row0 = (size_t)b * SEQ + (size_t)c * 64;
    const int fr = lane & 15, fq = lane >> 4;
    LAS unsigned char* sb = c2_set(lds, s); LAS unsigned char* QI = sb + C2_QI; LAS unsigned char* KI = sb + C2_KI; LAS unsigned char* VI = sb + C2_VI; LAS bf16_t* AM = (LAS bf16_t*)(sb + C2_AM);
    LAS float* BETA = c2_small(lds, s); LAS float* EM = BETA + 128; LAS float* LAM1 = BETA + 256;
    bf16x8 va[2];
#pragma unroll
    for (int kk = 0; kk < 2; ++kk) va[kk] = tr_frag(VI, kk, 16 * wave, fr, fq);
    bf16x8 sf[4];
    if constexpr (POS > 0) {
        f32x4 ev[8];
#pragma unroll
        for (int i = 0; i < 8; ++i) ev[i] = *(const LAS f32x4*)(EM + 16 * i + 4 * fq);
#pragma unroll
        for (int kk = 0; kk < 4; ++kk) {
            const f32x4 x0 = ds0[2 * kk] * ev[2 * kk], x1 = ds0[2 * kk + 1] * ev[2 * kk + 1];
            u32x4 w; w.x = pk2(x0[0], x0[1]); w.y = pk2(x0[2], x0[3]); w.z = pk2(x1[0], x1[1]); w.w = pk2(x1[2], x1[3]);
            sf[kk] = __builtin_bit_cast(bf16x8, w);
        }
    }
#pragma unroll
    for (int tp = 0; tp < 2; ++tp) {
        u32x4 qf[2][4], af[2][2];
#pragma unroll
        for (int t2 = 0; t2 < 2; ++t2) {
            const int tt = 2 * tp + t2;
            if constexpr (POS > 0) {
#pragma unroll
                for (int kk = 0; kk < 4; ++kk) {
                    const LAS unsigned char* qp = QI + (16 * tt + fr) * CP + (32 * kk + 4 * fq) * 2;
                    const u32x2 lo = *(const volatile LAS u32x2*)qp, hi = *(const volatile LAS u32x2*)(qp + 32);
                    qf[t2][kk] = (u32x4){lo.x, lo.y, hi.x, hi.y};
                }
            }
#pragma unroll
            for (int kk = 0; kk < 2; ++kk) {
                af[t2][kk] = *(const LAS u32x4*)(AM + (16 * tt + fr) * C2_AMP + 32 * kk + 8 * fq);
            }
        }
        __builtin_amdgcn_sched_barrier(0);
#pragma unroll
        for (int t2 = 0; t2 < 2; ++t2) {
            const int tt = 2 * tp + t2;
            f32x4 acc = {0.f, 0.f, 0.f, 0.f};
            if constexpr (POS > 0) {
#pragma unroll
                for (int kk = 0; kk < 4; ++kk) acc = MFMA16(sf[kk], __builtin_bit_cast(bf16x8, qf[t2][kk]), acc);
            }
#pragma unroll
            for (int kk = 0; kk < 2; ++kk) acc = MFMA16(va[kk], __builtin_bit_cast(bf16x8, af[t2][kk]), acc);
            u32x2 wo; wo.x = pk2(acc[0], acc[1]); wo.y = pk2(acc[2], acc[3]); *(u32x2*)(LFo + (row0 + 16 * tt + fr) * DM + h * 128 + 16 * wave + 4 * fq) = wo;
        }
    }
#pragma unroll
    for (int dq = 0; dq < 2; ++dq) {
        bf16x8 kfr[4][2]; f32x4 be[4], l1[4];
#pragma unroll
        for (int d4 = 0; d4 < 4; ++d4) {
            const int dt = 4 * dq + d4;
#pragma unroll
            for (int kk = 0; kk < 2; ++kk) kfr[d4][kk] = tr_frag(KI, kk, 16 * dt, fr, fq);
            be[d4] = *(const LAS f32x4*)(BETA + 16 * dt + 4 * fq);
            if constexpr (POS > 0) l1[d4] = *(const LAS f32x4*)(LAM1 + 16 * dt + 4 * fq);
        }
        __builtin_amdgcn_sched_barrier(0);
#pragma unroll
        for (int d4 = 0; d4 < 4; ++d4) {
            const int dt = 4 * dq + d4;
            f32x4 acc = {0.f, 0.f, 0.f, 0.f};
#pragma unroll
            for (int kk = 0; kk < 2; ++kk) acc = MFMA16(kfr[d4][kk], va[kk], acc);
            acc *= be[d4];
            if constexpr (POS > 0) acc += ds0[dt] * l1[d4];
            if constexpr (POS == 3) {
                u32x2 w; w.x = pk2(acc[0], acc[1]); w.y = pk2(acc[2], acc[3]);
                *(u32x2*)(DS + (((size_t)(((unit >> 5) << 3) + ((unit & 31) >> 2)) * 64 + dt * 8 + wave) * 64 + lane) * 4) = w;
            } else ds0[dt] = acc;
        }
    }
}

__device__ __forceinline__ void hgrn_scan_phase(const bf16_t* DS, bf16_t* SCo, const float* LAM, float* stp_layer, int gt, int ngt) {
    for (int item = gt; item < 64 * 4096; item += ngt) {
        const int bh = item >> 12, tl = item & 4095, tile = tl >> 6, ln = tl & 63, dt = tile >> 3, et = tile & 7, fq = ln >> 4, fr = ln & 15;
        float S0 = 0.f, S1 = 0.f, S2 = 0.f, S3 = 0.f;
        const size_t boff = ((size_t)bh * 32768 + tile * 64 + ln) * 4;
        const float* lbase = LAM + (size_t)bh * 8 * 128 + 16 * dt + 4 * fq;
#pragma unroll 1
        for (int c0 = 0; c0 < 8; c0 += 8) {
            u32x2 dw[8]; f32x4 lam[8];
#pragma unroll
            for (int j = 0; j < 8; ++j) { dw[j] = *(const u32x2*)(DS + boff + (size_t)(c0 + j) * 16384); lam[j] = *(const f32x4*)(lbase + (c0 + j) * 128); }
#pragma unroll
            for (int j = 0; j < 8; ++j) {
                u32x2 sc; sc.x = pk2(S0, S1); sc.y = pk2(S2, S3); *(u32x2*)(SCo + boff + (size_t)(c0 + j) * 16384) = sc;
                S0 = S0 * lam[j].x + bflo(dw[j].x); S1 = S1 * lam[j].y + bfhi(dw[j].x); S2 = S2 * lam[j].z + bflo(dw[j].y); S3 = S3 * lam[j].w + bfhi(dw[j].y);
            }
        }
        float* o = stp_layer + (size_t)bh * 16384 + (size_t)(16 * dt + 4 * fq) * 128 + 16 * et + fr;
        o[0] = S0; o[128] = S1; o[256] = S2; o[384] = S3;
    }
}

struct InterIn { u32x4 q[2], o[2], g[2]; };
struct InterSc { u32x2 sc[8]; };
__device__ __forceinline__ void inter_load(InterIn& r, int unit, const bf16_t* Q, const bf16_t* OI, const bf16_t* G, const bf16_t* SC, int wave, int lane, const int tid) {
    const int c = unit & 31, bh = unit >> 5, h = bh & 7, b = bh >> 3;
    const size_t g0 = ((size_t)b * SEQ + (size_t)c * 64 + (tid >> 3)) * DM + h * 128 + (tid & 7) * 8;
#pragma unroll
    for (int i = 0; i < 2; ++i) { r.q[i] = *(const u32x4*)(Q + g0 + 64 * i); r.o[i] = *(const u32x4*)(OI + g0 + 64 * i); r.g[i] = *(const u32x4*)(G + g0 + 64 * i); }
}
__device__ __forceinline__ void inter_load_sc(InterSc& s, int unit, const bf16_t* SC, int wave, int lane) {
    const size_t su = (size_t)(((unit >> 5) << 3) + ((unit & 31) >> 2));
#pragma unroll
    for (int dt = 0; dt < 8; ++dt) s.sc[dt] = *(const u32x2*)(SC + ((su * 64 + dt * 8 + wave) * 64 + lane) * 4);
}
__device__ __forceinline__ void quad_prefix(LAS unsigned char* lds, InterSc& sc0, InterSc& sc1, int bh0, int bh1, int qp, const bf16_t* DS, const float* LAM, float* stp_layer, int wave, int lane, const int tid) {
    LAS float* lam_l = (LAS float*)lds;
    const int last_bh = qp == 7 ? bh0 : (qp == 0 ? bh1 : -1);
#define QP_SU(i_) ((i_) < 7 ? ((i_) < qp ? bh0 * 8 + (i_) : bh1 * 8 + (i_) - qp) : (last_bh >= 0 ? last_bh * 8 + 7 : bh1 * 8 + 6 - qp + (qp == 7 ? 8 * (bh0 - bh1) + 7 : 0)))
#pragma unroll
    for (int r = 0; r < 2; ++r) { const int v = tid + 512 * r, i = v >> 7, d = v & 127; lam_l[v] = LAM[(size_t)QP_SU(i) * 128 + d]; }
#define QP_LOAD(dst, i_) do { const size_t su_ = (size_t)QP_SU(i_); _Pragma("unroll") for (int dt = 0; dt < 8; ++dt) dst.sc[dt] = *(const u32x2*)(DS + ((su_ * 64 + dt * 8 + wave) * 64 + lane) * 4); } while (0)
    InterSc dq[8];
#pragma unroll
    for (int i = 0; i < 8; ++i) QP_LOAD(dq[i], i);
    __syncthreads();
    const int fq = lane >> 4, fr = lane & 15;
    f32x4 S[8];
#pragma unroll
    for (int dt = 0; dt < 8; ++dt) { S[dt] = (f32x4){0.f, 0.f, 0.f, 0.f}; sc0.sc[dt].x = 0u; sc0.sc[dt].y = 0u; }
#pragma unroll
    for (int i = 0; i < 7; ++i) {
        if (i == qp) {
#pragma unroll
            for (int dt = 0; dt < 8; ++dt) { sc0.sc[dt].x = pk2(S[dt][0], S[dt][1]); sc0.sc[dt].y = pk2(S[dt][2], S[dt][3]); S[dt] = (f32x4){0.f, 0.f, 0.f, 0.f}; }
        }
#pragma unroll
        for (int dt = 0; dt < 8; ++dt) { const f32x4 lm = *(const LAS f32x4*)(lam_l + i * 128 + 16 * dt + 4 * fq);
            S[dt] = S[dt] * lm + (f32x4){bflo(dq[i].sc[dt].x), bfhi(dq[i].sc[dt].x), bflo(dq[i].sc[dt].y), bfhi(dq[i].sc[dt].y)}; }
    }
#pragma unroll
    for (int dt = 0; dt < 8; ++dt) {
        const unsigned wx = pk2(S[dt][0], S[dt][1]), wy = pk2(S[dt][2], S[dt][3]);
        if (qp == 7) { sc0.sc[dt].x = wx; sc0.sc[dt].y = wy; sc1.sc[dt].x = 0u; sc1.sc[dt].y = 0u; } else { sc1.sc[dt].x = wx; sc1.sc[dt].y = wy; }
    }
    if (last_bh >= 0) {
        float* o = stp_layer + (size_t)last_bh * 16384 + 16 * wave + fr;
#pragma unroll
        for (int dt = 0; dt < 8; ++dt) { const f32x4 lm = *(const LAS f32x4*)(lam_l + 7 * 128 + 16 * dt + 4 * fq);
            const f32x4 e = S[dt] * lm + (f32x4){bflo(dq[7].sc[dt].x), bfhi(dq[7].sc[dt].x), bflo(dq[7].sc[dt].y), bfhi(dq[7].sc[dt].y)};
#pragma unroll
            for (int r = 0; r < 4; ++r) o[(size_t)(16 * dt + 4 * fq + r) * 128] = e[r]; }
    }
#undef QP_SU
#undef QP_LOAD
    __syncthreads();
}
__device__ __forceinline__ void inter_compute(LAS unsigned char* lds, int unit, int par, const InterIn& r, const InterSc& s, bf16_t* Qo, int wave, int lane, const int tid) {
    const int c = unit & 31, bh = unit >> 5, h = bh & 7, b = bh >> 3, fr = lane & 15, fq = lane >> 4;
    LAS bf16_t* QH = (LAS bf16_t*)(lds + par * 52224); LAS bf16_t* OT = QH + 8704; LAS bf16_t* GT = OT + 8704;
    LAS float* red = (LAS float*)(lds + 104448 + par * 2048);
    const int so = (tid >> 3) * 136 + (tid & 7) * 8;
#pragma unroll
    for (int i = 0; i < 2; ++i) { *(LAS u32x4*)(QH + so + 64 * i) = r.q[i]; *(LAS u32x4*)(OT + so + 64 * i) = r.o[i]; *(LAS u32x4*)(GT + so + 64 * i) = r.g[i]; }
    LDS_BARRIER();
    f32x4 o[4];
#pragma unroll
    for (int tt = 0; tt < 4; ++tt) { const u32x2 ow = *(const LAS u32x2*)(OT + (16 * tt + fr) * 136 + 16 * wave + 4 * fq); o[tt] = (f32x4){bflo(ow.x), bfhi(ow.x), bflo(ow.y), bfhi(ow.y)}; }
#pragma unroll
    for (int k2 = 0; k2 < 4; k2 += 2) {
        u32x4 qfr[2][4];
#pragma unroll
        for (int i = 0; i < 2; ++i)
#pragma unroll
            for (int tt = 0; tt < 4; ++tt) {
                const LAS bf16_t* qp = QH + (16 * tt + fr) * 136 + 32 * (k2 + i) + 4 * fq;
                const u32x2 lo = *(const volatile LAS u32x2*)qp, hi = *(const volatile LAS u32x2*)(qp + 16);
                qfr[i][tt] = (u32x4){lo.x, lo.y, hi.x, hi.y};
            }
        __builtin_amdgcn_sched_barrier(0);
#pragma unroll
        for (int i = 0; i < 2; ++i) {
            const int kk = k2 + i;
            u32x4 aw; aw.x = s.sc[2 * kk].x; aw.y = s.sc[2 * kk].y; aw.z = s.sc[2 * kk + 1].x; aw.w = s.sc[2 * kk + 1].y;
            const bf16x8 af = __builtin_bit_cast(bf16x8, aw);
#pragma unroll
            for (int tt = 0; tt < 4; ++tt) o[tt] = MFMA16(af, __builtin_bit_cast(bf16x8, qfr[i][tt]), o[tt]);
        }
        __builtin_amdgcn_sched_barrier(0);
    }
#pragma unroll
    for (int tt = 0; tt < 4; ++tt) {
        float p = (o[tt][0] * o[tt][0] + o[tt][1] * o[tt][1]) + (o[tt][2] * o[tt][2] + o[tt][3] * o[tt][3]);
        p += __shfl_xor(p, 16); p += __shfl_xor(p, 32);
        if (fq == 0) red[wave * 64 + 16 * tt + fr] = p;
    }
    LDS_BARRIER();
#pragma unroll
    for (int tt = 0; tt < 4; ++tt) {
        float tot = 0.f;
#pragma unroll
        for (int w2 = 0; w2 < 8; ++w2) tot += red[w2 * 64 + 16 * tt + fr];
        const float rs = rsqrtf(tot * (1.0f / 128.0f) + NORM_EPS);
        const int po = (16 * tt + fr) * 136 + 16 * wave + 4 * fq;
        const u32x2 gw = *(const LAS u32x2*)(GT + po);
        u32x2 w; w.x = pk2(o[tt][0] * rs * bflo(gw.x), o[tt][1] * rs * bfhi(gw.x)); w.y = pk2(o[tt][2] * rs * bflo(gw.y), o[tt][3] * rs * bfhi(gw.y));
        *(LAS u32x2*)(OT + po) = w;
    }
    LDS_BARRIER();
    const size_t g0 = ((size_t)b * SEQ + (size_t)c * 64 + (tid >> 3)) * DM + h * 128 + (tid & 7) * 8;
#pragma unroll
    for (int i = 0; i < 2; ++i) *(u32x4*)(Qo + g0 + 64 * i) = *(const LAS u32x4*)(OT + so + 64 * i);
}

struct SampleIn { f32x4 sv[4]; u32x2 vw; bf16_t q, lf, g; };
__device__ __forceinline__ void sample_load(SampleIn& r, int unit, int half, const bf16_t* Q, const bf16_t* Kb, const bf16_t* LF, const bf16_t* V, const bf16_t* G, const float* s0, const int tid) {
    const int n = unit >> 3, h = unit & 7;
    const size_t rb = (size_t)(TP + n) * DM + h * 128;
    const int dg = tid >> 5, e4 = (tid & 31) * 4;
#pragma unroll
    for (int dd = 0; dd < 4; ++dd) r.sv[dd] = __builtin_nontemporal_load((const f32x4*)(s0 + (size_t)(dg * 8 + half * 4 + dd) * 128 + e4));
    r.vw = *(const u32x2*)(V + rb + e4);
    const int t7 = tid & 127;
    r.q = Q[rb + t7]; r.lf = LF[rb + t7]; r.g = G[rb + t7];
}
__device__ __forceinline__ void sample_compute(LAS unsigned char* lds, int unit, int half, const SampleIn& r, bf16_t* Qo, float* s1, const int tid) {
    const int n = unit >> 3, h = unit & 7;
    const size_t rb = (size_t)(TP + n) * DM + h * 128;
    LAS float* qs = (LAS float*)lds; LAS float* ks = qs + 128; LAS float* fs = qs + 256; LAS float* part = qs + 384;
    LAS float* redw = qs + 384 + 4096;
    if (half == 0) {
        if (tid < 128) { const float f = __expf(bf1(r.lf)); qs[tid] = bf1(r.q); ks[tid] = 1.0f - f; fs[tid] = f; }
        LDS_BARRIER();
    }
    const int dg = tid >> 5, e4 = (tid & 31) * 4;
    const f32x4 v4 = {bflo(r.vw.x), bfhi(r.vw.x), bflo(r.vw.y), bfhi(r.vw.y)};
    f32x4 o4 = {0.f, 0.f, 0.f, 0.f};
#pragma unroll
    for (int dd = 0; dd < 4; ++dd) {
        const int d = dg * 8 + half * 4 + dd;
        const f32x4 sn = r.sv[dd] * fs[d] + v4 * ks[d];
        __builtin_nontemporal_store(sn, (f32x4*)(s1 + (size_t)d * 128 + e4));
        o4 += sn * qs[d];
    }
    *(LAS f32x4*)(part + (dg * 2 + half) * 128 + e4) = o4;
    if (half == 1) {
        LDS_BARRIER();
        float o = 0.f;
        if (tid < 128) {
#pragma unroll
            for (int i = 0; i < 32; ++i) o += part[i * 128 + tid];
        }
        float sq = wave_sum(o * o);
        if ((tid & 63) == 0) redw[tid >> 6] = sq;
        LDS_BARRIER();
        if (tid < 128) {
            const float tot = redw[0] + redw[1];
            const float rs = rsqrtf(tot * (1.0f / 128.0f) + NORM_EPS);
            Qo[rb + tid] = (bf16_t)f2bf(o * rs * bf1(r.g));
        }
    }
}

__device__ __forceinline__ void sample_rec_units(LAS unsigned char* lds, unsigned char* ws, const float* st_in, float* st_out, int bx, int G, const int tid) {
    const bf16_t* Qp = (const bf16_t*)(ws + WS_Q); const bf16_t* Kp = (const bf16_t*)(ws + WS_K); const bf16_t* Lp = (const bf16_t*)(ws + WS_LF); const bf16_t* Vp = (const bf16_t*)(ws + WS_V); const bf16_t* Gp = (const bf16_t*)(ws + WS_G);
    bf16_t* Qo = (bf16_t*)(ws + WS_Q);
    SampleIn c0, c1, n0, n1;
    sample_load(c0, bx, 0, Qp, Kp, Lp, Vp, Gp, st_in + (size_t)bx * 16384, tid); sample_load(c1, bx, 1, Qp, Kp, Lp, Vp, Gp, st_in + (size_t)bx * 16384, tid);
#pragma unroll 1
    for (int k = 0; k < 4; ++k) {
        const int su = bx + G * k, sn = k < 3 ? su + G : su;
        sample_load(n0, sn, 0, Qp, Kp, Lp, Vp, Gp, st_in + (size_t)sn * 16384, tid); sample_load(n1, sn, 1, Qp, Kp, Lp, Vp, Gp, st_in + (size_t)sn * 16384, tid);
        sample_compute(lds + 112640, su, 0, c0, Qo, st_out + (size_t)su * 16384, tid);
        sample_compute(lds + 112640, su, 1, c1, Qo, st_out + (size_t)su * 16384, tid);
        c0 = n0; c1 = n1;
    }
    __syncthreads();
}

constexpr int KI_OFF = 0, VI_OFF = 40960, KVP = 160;
template <bool MIDFULL>
__device__ __forceinline__ void attn_core(const LAS unsigned char* KI, const LAS unsigned char* VI, int kt0, const bf16x8 (&qf)[2], int jlo, int jhi, float sink, int fr, int fq, f32x4 (&o)[4]) {
    f32x4 s[9];
    const LAS unsigned char* kb = KI + (16 * kt0 + fr) * KVP + 16 * fq;
#pragma unroll
    for (int x3 = 0; x3 < 9; x3 += 3) {
        bf16x8 ka[3][2];
#pragma unroll
        for (int i = 0; i < 3; ++i)
#pragma unroll
            for (int kk = 0; kk < 2; ++kk) ka[i][kk] = *(const LAS bf16x8*)(kb + (x3 + i) * 16 * KVP + kk * 64);
        __builtin_amdgcn_sched_barrier(0);
#pragma unroll
        for (int i = 0; i < 3; ++i) s[x3 + i] = (f32x4){0.f, 0.f, 0.f, 0.f};
#pragma unroll
        for (int kk = 0; kk < 2; ++kk)
#pragma unroll
            for (int i = 0; i < 3; ++i) s[x3 + i] = MFMA16(ka[i][kk], qf[kk], s[x3 + i]);
        __builtin_amdgcn_sched_barrier(0);
    }
    float mx = sink;
    const int j0 = 16 * kt0 + 4 * fq;
#pragma unroll
    for (int x = 0; x < 9; ++x)
#pragma unroll
        for (int r = 0; r < 4; ++r) {
            float sv = s[x][r];
            if (!MIDFULL || x == 0 || x == 8) { const int j = j0 + 16 * x + r; const bool valid = (j >= jlo) && (j <= jhi); sv = valid ? sv : -1e30f; s[x][r] = sv; }
            mx = fmaxf(mx, sv); }
    mx = fmaxf(mx, __shfl_xor(mx, 16)); mx = fmaxf(mx, __shfl_xor(mx, 32));
    float sum = 0.f;
#pragma unroll
    for (int x = 0; x < 9; ++x)
#pragma unroll
        for (int r = 0; r < 4; ++r) { const float p = __builtin_amdgcn_exp2f(s[x][r] - mx); s[x][r] = p; sum += p; }
    sum += __shfl_xor(sum, 16); sum += __shfl_xor(sum, 32);
    const float inv = fast_rcp(sum + __builtin_amdgcn_exp2f(sink - mx));
    bf16x8 pb[5];
#pragma unroll
    for (int y = 0; y < 5; ++y) {
        u32x4 w; w.x = pk2(s[2 * y][0] * inv, s[2 * y][1] * inv); w.y = pk2(s[2 * y][2] * inv, s[2 * y][3] * inv);
        if (y < 4) { w.z = pk2(s[2 * y + 1][0] * inv, s[2 * y + 1][1] * inv); w.w = pk2(s[2 * y + 1][2] * inv, s[2 * y + 1][3] * inv); } else { w.z = 0u; w.w = 0u; }
        pb[y] = __builtin_bit_cast(bf16x8, w);
    }
    const LAS unsigned char* vb = VI + (16 * kt0 + 4 * fq + (fr >> 2)) * KVP + 8 * (fr & 3);
#pragma unroll
    for (int d2 = 0; d2 < 4; d2 += 2) {
        s16x4 lo[2][5], hi[2][4];
#pragma unroll
        for (int i = 0; i < 2; ++i)
#pragma unroll
            for (int y = 0; y < 5; ++y) { lo[i][y] = tr_read(vb + (32 * y) * KVP + 32 * (d2 + i)); if (y < 4) hi[i][y] = tr_read(vb + (32 * y + 16) * KVP + 32 * (d2 + i)); }
        __builtin_amdgcn_sched_barrier(0);
        f32x4 acc[2] = {{0.f, 0.f, 0.f, 0.f}, {0.f, 0.f, 0.f, 0.f}};
#pragma unroll
        for (int y = 0; y < 5; ++y)
#pragma unroll
            for (int i = 0; i < 2; ++i) {
                const s16x4 l = lo[i][y]; s16x4 h = {0, 0, 0, 0}; if (y < 4) h = hi[i][y];
                const bf16x8 a = {l[0], l[1], l[2], l[3], h[0], h[1], h[2], h[3]};
                acc[i] = MFMA16(a, pb[y], acc[i]);
            }
        o[d2] = acc[0]; o[d2 + 1] = acc[1];
        __builtin_amdgcn_sched_barrier(0);
    }
}

__device__ __forceinline__ void swa_prompt_unit(LAS unsigned char* lds, int unit, const bf16_t* QA, bf16_t* QAo, const bf16_t* GA, const bf16_t* KA, const bf16_t* VA, const float* sinks, int wave, int lane, const int tid) {
    const int b = unit >> 5, blk = (unit >> 1) & 15, kvh = unit & 1;
    const int R0 = b * SEQ + blk * 128;
    const int fr = lane & 15, fq = lane >> 4;
    LAS unsigned char* KI = lds + KI_OFF; LAS unsigned char* VI = lds + VI_OFF;
    const int hq = kvh * 8 + wave;
    const size_t qbase = (size_t)(R0 + fr) * DM + hq * 64;
    bf16x8 qf[8][2];
#pragma unroll
    for (int qt = 0; qt < 8; ++qt)
#pragma unroll
        for (int kk = 0; kk < 2; ++kk) qf[qt][kk] = *(const bf16x8*)(QA + qbase + (size_t)qt * 16 * DM + 32 * kk + 8 * fq);
#pragma unroll
    for (int i = 0; i < 4; ++i) {
        const int idx = tid + 512 * i, key = idx >> 3, ch = idx & 7;
        u32x4 kk = {0u, 0u, 0u, 0u}, vv = {0u, 0u, 0u, 0u};
        if (blk > 0 || key >= 128) { const size_t g = (size_t)(R0 - 128 + key) * 128 + kvh * 64 + ch * 8; kk = *(const u32x4*)(KA + g); vv = *(const u32x4*)(VA + g); }
        *(LAS u32x4*)(KI + key * KVP + ch * 16) = kk; *(LAS u32x4*)(VI + key * KVP + ch * 16) = vv;
    }
    const float sink = sinks[hq] * 1.4426950408889634f;
    __syncthreads();
#pragma unroll
    for (int qt = 0; qt < 8; ++qt) {
        const size_t idx0 = qbase + (size_t)qt * 16 * DM + 4 * fq;
        u32x2 gw[4];
#pragma unroll
        for (int dt = 0; dt < 4; ++dt) gw[dt] = *(const u32x2*)(GA + idx0 + 16 * dt);
        const int tq = 16 * qt + fr;
        f32x4 o[4];
        if (blk > 0) attn_core<true>(KI, VI, qt, qf[qt], tq, tq + 128, sink, fr, fq, o);
        else attn_core<false>(KI, VI, qt, qf[qt], tq > 128 ? tq : 128, tq + 128, sink, fr, fq, o);
#pragma unroll
        for (int dt = 0; dt < 4; ++dt) {
            u32x2 w; w.x = pk2(o[dt][0] * bflo(gw[dt].x), o[dt][1] * bfhi(gw[dt].x)); w.y = pk2(o[dt][2] * bflo(gw[dt].y), o[dt][3] * bfhi(gw[dt].y));
            *(u32x2*)(QAo + idx0 + 16 * dt) = w;
        }
    }
    __syncthreads();
}

__device__ __forceinline__ void swa_sample_unit(LAS unsigned char* lds, int unit, const bf16_t* QA, bf16_t* QAo, const bf16_t* GA, const bf16_t* KA, const bf16_t* VA, const float* ck, const float* cv, const float* sinks, int wave, int lane, const int tid) {
    const int n = unit >> 1, kvh = unit & 1;
    const size_t row = (size_t)(TP + n);
    const int fr = lane & 15, fq = lane >> 4;
    LAS unsigned char* KI = lds + KI_OFF; LAS unsigned char* VI = lds + VI_OFF;
    const int hq = kvh * 8 + (fr & 7);
    bf16x8 qf[2];
#pragma unroll
    for (int kk = 0; kk < 2; ++kk) qf[kk] = *(const bf16x8*)(QA + row * DM + hq * 64 + 32 * kk + 8 * fq);
#pragma unroll
    for (int i = 0; i < 3; ++i) {
        const int idx = tid + 512 * i, key = idx >> 3, ch = idx & 7;
        if (key < 144) {
            u32x4 kk = {0u, 0u, 0u, 0u}, vv = {0u, 0u, 0u, 0u};
            if (key < 128) {
                const size_t g = ((size_t)(n * 128 + key) * 2 + kvh) * 64 + ch * 8;
                const f32x4 k0 = *(const f32x4*)(ck + g), k1 = *(const f32x4*)(ck + g + 4), v0 = *(const f32x4*)(cv + g), v1 = *(const f32x4*)(cv + g + 4);
                kk.x = pk2(k0.x, k0.y); kk.y = pk2(k0.z, k0.w); kk.z = pk2(k1.x, k1.y); kk.w = pk2(k1.z, k1.w);
                vv.x = pk2(v0.x, v0.y); vv.y = pk2(v0.z, v0.w); vv.z = pk2(v1.x, v1.y); vv.w = pk2(v1.z, v1.w);
            } else if (key == 128) { const size_t g = row * 128 + kvh * 64 + ch * 8; kk = *(const u32x4*)(KA + g); vv = *(const u32x4*)(VA + g); }
            *(LAS u32x4*)(KI + key * KVP + ch * 16) = kk; *(LAS u32x4*)(VI + key * KVP + ch * 16) = vv;
        }
    }
    const float sink = sinks[hq] * 1.4426950408889634f;
    __syncthreads();
    if (wave == 0) {
        const size_t idx0 = row * DM + hq * 64 + 4 * fq;
        u32x2 gw[4];
#pragma unroll
        for (int dt = 0; dt < 4; ++dt) gw[dt] = *(const u32x2*)(GA + idx0 + 16 * dt);
        f32x4 o[4];
        attn_core<false>(KI, VI, 0, qf, 0, 128, sink, fr, fq, o);
        if (fr < 8) {
#pragma unroll
            for (int dt = 0; dt < 4; ++dt) {
                u32x2 w; w.x = pk2(o[dt][0] * bflo(gw[dt].x), o[dt][1] * bfhi(gw[dt].x)); w.y = pk2(o[dt][2] * bflo(gw[dt].y), o[dt][3] * bfhi(gw[dt].y));
                *(u32x2*)(QAo + idx0 + 16 * dt) = w;
            }
        }
    }
    __syncthreads();
}

__global__ void __launch_bounds__(NWAVES * 64, 2) yoco_fwd(Args args) {
    extern __shared__ __attribute__((aligned(16))) unsigned char lds_raw[];
    LAS unsigned char* lds = (LAS unsigned char*)lds_raw;
    volatile LAS unsigned* MISC = (volatile LAS unsigned*)(lds + MISC_OFF);
    const int G = gridDim.x, bx = blockIdx.x;
    { const int tid = threadIdx.x;
      for (int u = tid; u < (LDS_BYTES - LDSCTL_OFF) / 4; u += NWAVES * 64) ((LAS unsigned*)(lds + LDSCTL_OFF))[u] = 0u; }
    __syncthreads();
    XcdBarrier bar = xcd_barrier_post((unsigned*)(args.ws + WS_CTL) + CW_BAR, MISC + 8);
    const int lo = args.ph_lo, hi = args.ph_hi;
#define IN(k) (lo <= (k) && (k) < hi)
#define SEAM(k) do { if (IN(k) && IN((k) + 1)) { for (int rep = 0; rep < NREP(9); ++rep) xcd_barrier(bar); } } while (0)
#define PHASE_LOCALS() KArgPtr ap = kargs(); unsigned char* ws = ap->ws; const int tid = fresh_tid(), lane = tid & 63, wave = __builtin_amdgcn_readfirstlane(tid >> 6); (void)lane; (void)wave; (void)ws

    if (IN(0)) { for (int rep = 0; rep < NREP(0); ++rep) { PHASE_LOCALS(); p0_prologue(ap, lds, wave, lane); } }
    SEAM(0);

#define S_IN_A(l_)  do { EpiHgrnIn Es{ws, (l_), (const LAS float*)(lds + RSTD_OFF)}; const bf16_t* Bs = (const bf16_t*)(ws + ((l_) == 0 ? WS_WIN0 : WS_WIN1)); \
        for (int u = bx; u < 256; u += G) sgemm_unit<64, 32>(lds, (const bf16_t*)(ws + WS_HB) + (size_t)TP * DM, Bs, u, Es, wave, lane, tid); } while (0)
#define S_OUT(WOFF, u0_, ustep_) do { EpiResid Es{ws}; const bf16_t* Bs = (const bf16_t*)(ws + (WOFF)); \
        for (int u = (u0_); u < 256; u += (ustep_)) sgemm_unit<32, 16>(lds, (const bf16_t*)(ws + WS_Q) + (size_t)TP * DM, Bs, u, Es, wave, lane, tid); } while (0)
#define S_STEP(l_)  sample_rec_units(lds, ws, ap->in[2] + (size_t)(l_) * 1024 * 16384, ap->out + O_STS + (size_t)(l_) * 1024 * 16384, bx, G, tid)
#define S_ATTN(j_)  do { const float* sk = ap->in[14] + (j_) * 16; \
        for (int u = bx; u < 256; u += G) swa_sample_unit(lds, u, (const bf16_t*)(ws + WS_Q), (bf16_t*)(ws + WS_Q), (const bf16_t*)(ws + WS_G), (const bf16_t*)(ws + WS_KA), (const bf16_t*)(ws + WS_VA), ap->in[3], ap->in[4], sk, wave, lane, tid); } while (0)

#pragma unroll 1
    for (int l = 0; l < 2; ++l) {
        const int pb = 1 + 5 * l;
        if (IN(pb)) {
            PHASE_LOCALS();
            const bf16_t* Bt = (const bf16_t*)(ws + (l == 0 ? WS_WIN0 : WS_WIN1));
            const int vcu = (bx & 7) * (G >> 3) + (bx >> 3);
            pg8::Gemm g{(const bf16_t*)(ws + WS_HB), Bt, TP, 4096, 1024}; pg8::HeadPairOrder S; S.pm = vcu >> 2; S.hp = vcu & 3; S.rot = (vcu >> 5) & 3; { int n4 = 4; asm volatile("" : "+s"(n4)); S.nu = n4; }
            EpiHgrnIn E{ws, l, (const LAS float*)(lds + RSTD_OFF)};
            stage_row_tables(ws, S.pm, lds, false, tid);
            S_IN_A(l);
            pg8::gemm_phase<EpiHgrnIn, pg8::HeadPairOrder, PG8_ALIGN, PG8_SP2>(lds + RING_OFF, g, S, E, tid);
        }
        if (IN(pb)) {
            PHASE_LOCALS();
            __syncthreads();
            const int vcu = (bx & 7) * (G >> 3) + (bx >> 3);
            const int pm_ = vcu >> 2, hp_ = vcu & 3, bq = pm_ >> 3, c0 = 4 * (pm_ & 7);
            const bf16_t* Qp = (const bf16_t*)(ws + WS_Q); const bf16_t* Kp = (const bf16_t*)(ws + WS_K); const bf16_t* Lp = (const bf16_t*)(ws + WS_LF); const bf16_t* Vp = (const bf16_t*)(ws + WS_V);
            {
                ChunkIn r; f32x4 ds0[8]; float lam0[4] = {0.f, 0.f, 0.f, 0.f};
#pragma unroll
                for (int i = 0; i < 8; ++i) ds0[i] = (f32x4){0.f, 0.f, 0.f, 0.f};
                bf16_t* Qo = (bf16_t*)(ws + WS_Q); bf16_t* LFo = (bf16_t*)(ws + WS_LF); bf16_t* DSp = (bf16_t*)(ws + WS_DS); float* LAMp = (float*)(ws + WS_LAM);
                const int ub = (bq * 8 + 2 * hp_) * 32 + c0;
                chunk_load(r, ub, Qp, Kp, Lp, Vp, tid);
                chunk_A1(lds, 0, r, tid);
                chunk_load(r, ub + 1, Qp, Kp, Lp, Vp, tid);
                LDS_BARRIER();
                chunk_A2(lds, 0, ub, 0, lam0, Qo, LAMp, wave, lane);
                LDS_BARRIER();
#pragma unroll 1
                for (int k = 0; k < 8; ++k) {
                    const int u = ub + (k >> 2) * 32 + (k & 3), s = k & 1;
                    const bool has_next = k < 7;
                    const int k1 = k < 7 ? k + 1 : 7, un = ub + (k1 >> 2) * 32 + (k1 & 3), k2 = k + 2 < 8 ? k + 2 : 7, u2 = ub + (k2 >> 2) * 32 + (k2 & 3);
                    if (has_next) { chunk_A1(lds, s ^ 1, r, tid); chunk_load(r, u2, Qp, Kp, Lp, Vp, tid); }
                    __builtin_amdgcn_sched_barrier(0);
                    chunk_B(lds, s, wave, lane);
                    LDS_BARRIER();
                    if (has_next) chunk_A2(lds, s ^ 1, un, k1 & 3, lam0, Qo, LAMp, wave, lane);
                    __builtin_amdgcn_sched_barrier(0);
                    switch (k & 3) {
                        case 0: chunk_C<0>(lds, s, u, ds0, LFo, DSp, wave, lane); break;
                        case 1: chunk_C<1>(lds, s, u, ds0, LFo, DSp, wave, lane); break;
                        case 2: chunk_C<2>(lds, s, u, ds0, LFo, DSp, wave, lane); break;
                        default: chunk_C<3>(lds, s, u, ds0, LFo, DSp, wave, lane); break;
                    }
                    LDS_BARRIER();
                }
            }
        }
        SEAM(pb);
        if (IN(pb + 3)) {
            PHASE_LOCALS();
            for (int rep = 0; rep < NREP(10); ++rep) {
                bf16_t* qo = (bf16_t*)(ws + (DUMMY(10, rep) ? WS_DUM0 : WS_Q));
                const bf16_t* Qp = (const bf16_t*)(ws + WS_Q); const bf16_t* Op = (const bf16_t*)(ws + WS_LF); const bf16_t* Gp = (const bf16_t*)(ws + WS_G); const bf16_t* Sp = (const bf16_t*)(ws + WS_DS);
                const int vcu = (bx & 7) * (G >> 3) + (bx >> 3), qp = vcu & 7, bh0 = (vcu >> 5) * 8 + ((vcu >> 3) & 3), bh1 = bh0 + 4, qd0 = bh0 * 8 + qp, qd1 = bh1 * 8 + (7 - qp);
                InterIn cur; InterSc sc, sc1;
                quad_prefix(lds, sc, sc1, bh0, bh1, qp, Sp, (const float*)(ws + WS_LAM), ap->out + O_STP + (size_t)l * 64 * 16384, wave, lane, tid);
                inter_load(cur, 4 * qd0, Qp, Op, Gp, Sp, wave, lane, tid);
#pragma unroll 1
                for (int k = 0; k < 2; ++k) {
                    const int qd = k == 0 ? qd0 : qd1, qn = qd1;
#pragma unroll 1
                    for (int jj = 0; jj < 3; ++jj) {
                        InterIn nxt; SampleIn sin;
                        const int su = bx + G * (2 * k + (jj >> 1)), half = jj & 1;
                        inter_load(nxt, 4 * qd + jj + 1, Qp, Op, Gp, Sp, wave, lane, tid);
                        sample_load(sin, su, half, Qp, (const bf16_t*)(ws + WS_K), Op, (const bf16_t*)(ws + WS_V), Gp, ap->in[2] + ((size_t)l * 1024 + su) * 16384, tid);
                        inter_compute(lds, 4 * qd + jj, jj & 1, cur, sc, qo, wave, lane, tid);
                        sample_compute(lds + 112640, su, half, sin, (bf16_t*)(ws + WS_Q), ap->out + O_STS + ((size_t)l * 1024 + su) * 16384, tid);
                        cur = nxt;
                    }
                    InterIn nxt; SampleIn sin;
                    const int su = bx + G * (2 * k + 1);
                    inter_load(nxt, 4 * qn, Qp, Op, Gp, Sp, wave, lane, tid);
                    sample_load(sin, su, 1, Qp, (const bf16_t*)(ws + WS_K), Op, (const bf16_t*)(ws + WS_V), Gp, ap->in[2] + ((size_t)l * 1024 + su) * 16384, tid);
                    inter_compute(lds, 4 * qd + 3, 1, cur, sc, qo, wave, lane, tid);
                    sample_compute(lds + 112640, su, 1, sin, (bf16_t*)(ws + WS_Q), ap->out + O_STS + ((size_t)l * 1024 + su) * 16384, tid);
                    cur = nxt; sc = sc1;
                }
            }
        }
        SEAM(pb + 3);
        if (IN(pb + 4)) {
            PHASE_LOCALS();
            const bf16_t* Bt = (const bf16_t*)(ws + (l == 0 ? WS_WOUT0 : WS_WOUT1));
            pg8::Gemm g{(const bf16_t*)(ws + WS_Q), Bt, TP, 1024, 1024}; pg8::StaticOrder S; S.init(TP, 1024, G, bx);
            EpiResid E{ws};
            S_OUT((l == 0 ? WS_WOUT0 : WS_WOUT1), bx, G);
            pg8::gemm_phase<EpiResid, pg8::StaticOrder, PG8_ALIGN, PG8_SP2>(lds + RING_OFF, g, S, E, tid);
        }
        SEAM(pb + 4);
    }
#pragma unroll 1
    for (int j = 0; j < 2; ++j) {
        const int pb = 11 + 3 * j;
        if (IN(pb)) {
            PHASE_LOCALS();
            const int N = j == 0 ? 2304 : 2048;
            const bf16_t* Bt = (const bf16_t*)(ws + (j == 0 ? WS_WINB0 : WS_WINB1));
            const int vcu = (bx & 7) * (G >> 3) + (bx >> 3);
            pg8::Gemm g{(const bf16_t*)(ws + WS_HB), Bt, TP, N, 1024}; pg8::PmOrder S; S.pm = vcu >> 2; S.q = vcu & 3; S.nN = N >> 8;
            EpiSwaIn E{ws, ap->out, (const LAS float*)(lds + RSTD_OFF), (const LAS float*)(lds + ROPEL_OFF)};
            stage_row_tables(ws, S.pm, lds, true, tid);
            if (j == 0) {
                const int rank = S.q < 2 ? -1 : (S.pm * 2 + S.q - 2), nr = G >> 1;
                if (rank >= 0) for (int u = rank; u < N / 16; u += nr) sgemm_unit<64, 32>(lds, g.A + (size_t)TP * DM, Bt, u, E, wave, lane, tid);
                pg8::gemm_phase<EpiSwaIn, pg8::PmOrder, PG8_ALIGN, PG8_SP2, true>(lds + RING_OFF, g, S, E, tid);
            } else {
                for (int u = bx; u < N / 8; u += G) sgemm_unit<32, 32>(lds, g.A + (size_t)TP * DM, Bt, u, E, wave, lane, tid);
                pg8::gemm_phase<EpiSwaIn, pg8::PmOrder, PG8_ALIGN, PG8_SP2, false>(lds + RING_OFF, g, S, E, tid);
            }
        }
        SEAM(pb);
        if (IN(pb + 1)) {
            PHASE_LOCALS();
            const float* sinks = ap->in[14] + j * 16;
            for (int rep = 0; rep < NREP(6); ++rep) {
            bf16_t* qo = (bf16_t*)(ws + (DUMMY(6, rep) ? WS_DUM0 : WS_Q));
            for (int u = (bx & 7) * (G >> 3) + (bx >> 3); u < 256; u += G) swa_prompt_unit(lds, u, (const bf16_t*)(ws + WS_Q), qo,
            (const bf16_t*)(ws + WS_G), (const bf16_t*)(ws + WS_KA), (const bf16_t*)(ws + WS_VA), sinks, wave, lane, tid);
            }
            S_ATTN(j);
        }
        SEAM(pb + 1);
        if (IN(pb + 2)) {
            PHASE_LOCALS();
            const bf16_t* Bt = (const bf16_t*)(ws + (j == 0 ? WS_WOUTB0 : WS_WOUTB1));
            pg8::Gemm g{(const bf16_t*)(ws + WS_Q), Bt, TP, 1024, 1024}; pg8::StaticOrder S; S.init(TP, 1024, G, bx);
            EpiResid E{ws};
            S_OUT((j == 0 ? WS_WOUTB0 : WS_WOUTB1), bx, G);
            pg8::gemm_phase<EpiResid, pg8::StaticOrder, PG8_ALIGN, PG8_SP2>(lds + RING_OFF, g, S, E, tid);
        }
        SEAM(pb + 2);
    }
    if (IN(17)) {
        PHASE_LOCALS();
        const int gw = bx * NWAVES + wave, NGW = G * NWAVES;
        const f32x4* fn = (const f32x4*)ap->in[16] + lane;
        const float* SSQ = (const float*)(ws + WS_SSQ); const bf16_t* HBf = (const bf16_t*)(ws + WS_HB); float* outp = ap->out;
        f32x4 gn[4];
#pragma unroll
        for (int j = 0; j < 4; ++j) gn[j] = fn[64 * j];
        const int vcu = (bx & 7) * (G >> 3) + (bx >> 3), vw = vcu * NWAVES + wave;
        for (int rep = 0; rep < NREP(8); ++rep)
        for (int i = 0; i < 9; ++i) {
            const int m = i < 8 ? (vw >> 8) * SEQ + (vw & 255) + 256 * i : TP + vw;
            if (m >= TP + TS) break;
            const float rs = m < TP ? row_rstd(SSQ, m) : row_rstd_s((const float*)(ws + WS_SSQS), m - TP);
            const u32x2* hr = (const u32x2*)(HBf + (size_t)m * DM) + lane; f32x4* o = (f32x4*)(outp + (size_t)m * DM) + lane;
#pragma unroll
            for (int j = 0; j < 4; ++j) { const u32x2 hw = hr[64 * j]; __builtin_nontemporal_store((f32x4){bflo(hw.x), bfhi(hw.x), bflo(hw.y), bfhi(hw.y)} * rs * gn[j], &o[64 * j]); }
        }
    }
#undef S_IN_A
#undef S_OUT
#undef S_STEP
#undef S_ATTN
#undef IN
#undef SEAM
#undef PHASE_LOCALS
}

#ifndef MK_PER_PHASE
#define MK_PER_PHASE 0
#endif
extern "C" void kernel_launch(void* const* d_in, const int* in_sizes, int n_in, void* d_out, int out_size, void* d_ws, size_t ws_size, hipStream_t stream) {
    static int grid = 0;
    if (grid == 0) {
        if (n_in != 17 || ws_size < WS_END) { fprintf(stderr, "kernel_launch: unexpected inputs (n_in %d, ws %zu)\n", n_in, ws_size); grid = -1; return; }
        int dev = 0, cus = 0;
        if (hipGetDevice(&dev) != hipSuccess || hipDeviceGetAttribute(&cus, hipDeviceAttributeMultiprocessorCount, dev) != hipSuccess) { grid = -1; return; }
        if (hipFuncSetAttribute((const void*)yoco_fwd, hipFuncAttributeMaxDynamicSharedMemorySize, LDS_BYTES) != hipSuccess) { grid = -1; return; }
        (void)hipGetLastError();
        grid = cus;
    }
    if (grid < 0) return;
    (void)hipMemsetAsync((char*)d_ws + WS_CTL, 0, CTL_ZERO_BYTES, stream);
    Args a{};
    for (int i = 0; i < 17; ++i) a.in[i] = (const float*)d_in[i];
    a.out = (float*)d_out; a.ws = (unsigned char*)d_ws;
#if MK_PER_PHASE
    for (int p = 0; p < 18; ++p) { a.ph_lo = p; a.ph_hi = p + 1; hipLaunchKernelGGL(yoco_fwd, dim3(grid), dim3(NWAVES * 64), LDS_BYTES, stream, a); }
#else
    a.ph_lo = 0; a.ph_hi = 18;
    hipLaunchKernelGGL(yoco_fwd, dim3(grid), dim3(NWAVES * 64), LDS_BYTES, stream, a);
#endif
}
```

```cpp
#include <hip/hip_runtime.h>
#include <cstdio>
#include <cstdint>

#define LAS __attribute__((address_space(3)))
#define GAS __attribute__((address_space(1)))
typedef unsigned short bf16_t;
typedef short bf16x8 __attribute__((ext_vector_type(8)));
typedef short s16x4 __attribute__((ext_vector_type(4)));
typedef float f32x4 __attribute__((ext_vector_type(4)));
typedef float f32x2 __attribute__((ext_vector_type(2)));
typedef unsigned u32x4 __attribute__((ext_vector_type(4)));
typedef unsigned u32x2 __attribute__((ext_vector_type(2)));

constexpr int DM = 1024;
constexpr int TP = 16384;
constexpr int TS = 128;
constexpr int MT = 16640;
constexpr int SEQ = 2048;
constexpr float NORM_EPS = 1e-6f;
constexpr size_t O_YP = 0, O_YS = 16777216, O_STP = 16908288, O_STS = 19005440, O_KWP = 52559872, O_VWP = 52690944, O_KNS = 52822016, O_VNS = 52838400;
constexpr size_t MiB = 1u << 20;
constexpr size_t WS_CTL = 0, CTL_ZERO_BYTES = 65536;
constexpr size_t WS_LB1 = 1 * MiB, WS_ROPE = 1 * MiB + 8192, WS_SSQS = 1 * MiB + 262144;
constexpr size_t WS_WIN0 = 2 * MiB, WS_WIN1 = 10 * MiB, WS_WOUT0 = 18 * MiB, WS_WOUT1 = 20 * MiB, WS_WINB0 = 22 * MiB, WS_WINB1 = 27 * MiB, WS_WOUTB0 = 31 * MiB, WS_WOUTB1 = 33 * MiB;
constexpr size_t WS_SSQ = 35 * MiB, WS_HB = 37 * MiB, WS_H = 70 * MiB, WS_Q = 136 * MiB, WS_K = 169 * MiB, WS_V = 202 * MiB, WS_G = 235 * MiB, WS_LF = 268 * MiB;
constexpr size_t WS_DS = 334 * MiB, WS_LAM = 398 * MiB, WS_KA = 399 * MiB, WS_VA = 404 * MiB, WS_END = 409 * MiB;
constexpr int CW_BAR = 4096;
constexpr size_t WS_DUM0 = 409 * MiB, WS_DUM1 = 442 * MiB;
#ifndef DUP_MASK
#define DUP_MASK 0
#endif
#define NREP(id) (((DUP_MASK >> (id)) & 1) ? 2 : 1)
#define DUMMY(id, rep) (((DUP_MASK >> (id)) & 1) && (rep) == 0)

typedef float f32x2_t __attribute__((ext_vector_type(2))); typedef __bf16 bf16x2_t __attribute__((ext_vector_type(2)));
__device__ __forceinline__ unsigned pk2(float lo, float hi) { f32x2_t v = {lo, hi}; bf16x2_t b = __builtin_convertvector(v, bf16x2_t); return __builtin_bit_cast(unsigned, b); }
__device__ __forceinline__ unsigned f2bf(float f) { return pk2(f, f) & 0xffffu; }
__device__ __forceinline__ float bflo(unsigned w) { return __builtin_bit_cast(float, w << 16); }
__device__ __forceinline__ float bfhi(unsigned w) { return __builtin_bit_cast(float, w & 0xffff0000u); }
__device__ __forceinline__ float bf1(bf16_t b) { return __builtin_bit_cast(float, (unsigned)b << 16); }
__device__ __forceinline__ float fast_rcp(float x) { return __builtin_amdgcn_rcpf(x); }
__device__ __forceinline__ float silu_f(float u) { return u * fast_rcp(1.0f + __expf(-u)); }
__device__ __forceinline__ float fast_log(float x) { return __builtin_amdgcn_logf(x) * 0.6931471805599453f; }
__device__ __forceinline__ float wave_sum(float v) {
#pragma unroll
    for (int o = 1; o < 64; o <<= 1) v += __shfl_xor(v, o);
    return v;
}
__device__ __forceinline__ float wave_max(float v) {
#pragma unroll
    for (int o = 1; o < 64; o <<= 1) v = fmaxf(v, __shfl_xor(v, o));
    return v;
}
#define LDS_WAIT() asm volatile("s_waitcnt lgkmcnt(0)" ::: "memory")
#define VM_WAIT() asm volatile("s_waitcnt vmcnt(0)" ::: "memory")
#define MFMA16(a, b, c) __builtin_amdgcn_mfma_f32_16x16x32_bf16((a), (b), (c), 0, 0, 0)

namespace pg8 {
constexpr int BM = 256, BK = 64, HALF = 128, HTB = HALF * BK * 2, STAGE_BYTES = 8 * HTB, NXCD = 8, WGM = 8;
__host__ __device__ __forceinline__ int lds_byte(int r, int c) { const int st = (r >> 4) * 2 + (c >> 5), rr = r & 15, cc = c & 31, ob = rr * 64 + cc * 2; return st * 1024 + (ob ^ (((ob >> 9) & 1) << 5)); }
__host__ __device__ __forceinline__ void stage_rc(int b, int& R, int& C) { const int st = b / 1024, sb = b % 1024, swz = sb ^ (((sb >> 9) & 1) << 5); R = (st >> 1) * 16 + swz / 64; C = (st & 1) * 32 + (swz % 64) / 2; }
__host__ __device__ __forceinline__ int perm32(int rho) { const int n = rho >> 4, i = rho & 15; return 8 * (i >> 2) + 4 * n + (i & 3); }
struct Unit { int pm, pn, hs; };
struct Gemm { const bf16_t* A; const bf16_t* Bt; int M, N, K; };
struct StaticOrder {
    int nM, nN, nwg, G, c;
    __host__ __device__ void init(int M, int N, int G_, int c_) { nM = M / BM; nN = N / BM; nwg = nM * nN; G = G_; c = c_; }
    __host__ __device__ __forceinline__ bool next(int i, Unit& u) const {
        const long L = (long)i * G + c; if (L >= nwg) return false;
        int wgid = (int)L; { const int q = nwg / NXCD, r = nwg % NXCD, xcd = wgid % NXCD, off = wgid / NXCD; wgid = (xcd < r ? xcd * (q + 1) : r * (q + 1) + (xcd - r) * q) + off; }
        const int nig = WGM * nN, gid = wgid / nig, fm = gid * WGM, gsz = (nM - fm) < WGM ? (nM - fm) : WGM;
        u.pm = fm + ((wgid % nig) % gsz); u.pn = (wgid % nig) / gsz; u.hs = 0; return true;
    }
    __device__ __forceinline__ void a_ready(const Unit&) const {}
    __device__ __forceinline__ void done(const Unit&) const {}
};
struct HeadPairOrder {
    int pm, hp, nu, rot;
    __device__ __forceinline__ bool next(int i, Unit& u) const { if (i >= nu) return false; u.pm = pm; u.pn = hp + 4 * ((i + rot) & 3); u.hs = 0; return true; }
    __device__ __forceinline__ void a_ready(const Unit&) const {}
    __device__ __forceinline__ void done(const Unit&) const {}
};
struct PmOrder {
    int pm, q, nN;
    __device__ __forceinline__ bool next(int i, Unit& u) const {
        u.pm = pm; u.hs = 0;
        if (i < 2) { u.pn = q + 4 * i; return true; }
        if (i == 2 && nN == 9 && q < 2) { u.pn = 8; u.hs = q + 1; return true; }
        return false; }
    __device__ __forceinline__ void a_ready(const Unit&) const {}
    __device__ __forceinline__ void done(const Unit&) const {}
};
template <class Epi, class Sched, bool ALIGN_EPI = false, bool SP2 = false, bool HALFN = false>
__device__ __forceinline__ void gemm_phase(LAS unsigned char* lds, const Gemm g, const Sched& S, const Epi& E, const int tid) {
    const int wid = __builtin_amdgcn_readfirstlane(tid >> 6), lane = tid & 63, wr = wid >> 2, wc = wid & 3, fr = lane & 15, fq = lane >> 4;
    const int K = g.K, nt = K / BK;
    unsigned voffA[2], voffB[2];
#pragma unroll
    for (int i = 0; i < 2; ++i) { int R, C; stage_rc(tid * 16 + i * 8192, R, C); const int Rb = Epi::PERM ? ((R & ~31) + perm32(R & 31)) : R;
        voffA[i] = (unsigned)(R * K + C) * 2u; voffB[i] = (unsigned)(Rb * K + C) * 2u; }
    const size_t kstep = (size_t)(BK * 2);
    const size_t hstep = (size_t)HALF * K * 2;
    const size_t tstep = 2 * hstep;
    const unsigned ldsw = (unsigned)wid * 1024u;
    const int aoff = lds_byte(wr * 64 + fr, fq * 8), boff = lds_byte(wc * 32 + fr, fq * 8);
#define PG8_SA(b, h) (((b) * 2 + (h)) * HTB)
#define PG8_SB(b, h) ((4 + (b) * 2 + (h)) * HTB)
#define PG8_STAGE(bufoff, gbase, voff) do { _Pragma("unroll") for (int _i = 0; _i < 2; ++_i) \
        __builtin_amdgcn_global_load_lds((const unsigned*)((const char*)(gbase) + (voff)[_i]), (LAS unsigned*)(lds + (bufoff) + ldsw + _i * 8192), 16, 0, 0); } while (0)
#define PG8_LDA(dst, b, h) do { _Pragma("unroll") for (int m = 0; m < 4; ++m) _Pragma("unroll") for (int k = 0; k < 2; ++k) dst[m][k] = *(const LAS bf16x8*)(lds + PG8_SA(b, h) + aoff + m * 2048 + k * 1024); } while (0)
#define PG8_LDB(dst, b, h) do { _Pragma("unroll") for (int n = 0; n < 2; ++n) _Pragma("unroll") for (int k = 0; k < 2; ++k) dst[n][k] = *(const LAS bf16x8*)(lds + PG8_SB(b, h) + boff + n * 2048 + k * 1024); } while (0)
#define PG8_MMA(ai, bj, At, Bt) do { __builtin_amdgcn_s_setprio(1); _Pragma("unroll") for (int m = 0; m < 4; ++m) _Pragma("unroll") for (int n = 0; n < 2; ++n) _Pragma("unroll") for (int k = 0; k < 2; ++k) \
        acc[ai][bj][m][n] = __builtin_amdgcn_mfma_f32_16x16x32_bf16(Bt[n][k], At[m][k], acc[ai][bj][m][n], 0, 0, 0); __builtin_amdgcn_s_setprio(0); } while (0)
#define PG8_MMA2(ai) do { if constexpr (HALFN) { if (cur.hs != 2) PG8_MMA(ai, 0, At, B0); if (cur.hs != 1) PG8_MMA(ai, 1, At, B1); } else { PG8_MMA(ai, 0, At, B0); PG8_MMA(ai, 1, At, B1); } } while (0)
#define PG8_WAIT_V(n) asm volatile("s_waitcnt vmcnt(" #n ")" ::: "memory")
#define PG8_WAIT_L(n) asm volatile("s_waitcnt lgkmcnt(" #n ")" ::: "memory")
#define PG8_BAR __builtin_amdgcn_s_barrier()
#define PG8_SCHED __builtin_amdgcn_sched_barrier(0)
    Unit cur, nxt; int ui = 0;
    if (!S.next(0, cur)) return;
    f32x4 acc[2][2][4][2];
#pragma unroll
    for (int a = 0; a < 2; ++a)
#pragma unroll
        for (int b = 0; b < 2; ++b)
#pragma unroll
            for (int m = 0; m < 4; ++m)
#pragma unroll
                for (int n = 0; n < 2; ++n) acc[a][b][m][n] = (f32x4){0.f, 0.f, 0.f, 0.f};
    bf16x8 At[4][2], B0[2][2], B1[2][2];
    const char* cA = (const char*)g.A + (size_t)cur.pm * tstep; const char* cB = (const char*)g.Bt + (size_t)cur.pn * tstep;
    S.a_ready(cur);
    if constexpr (SP2) {
        PG8_STAGE(PG8_SB(0, 0), cB, voffB); PG8_STAGE(PG8_SB(0, 1), cB + hstep, voffB); PG8_STAGE(PG8_SA(0, 0), cA, voffA); PG8_STAGE(PG8_SA(0, 1), cA + hstep, voffA);
        if (wr == 1) PG8_BAR;
        PG8_WAIT_V(2); PG8_BAR;
        PG8_STAGE(PG8_SB(1, 0), cB + kstep, voffB); PG8_STAGE(PG8_SA(1, 0), cA + kstep, voffA); PG8_STAGE(PG8_SB(1, 1), cB + hstep + kstep, voffB);
        PG8_WAIT_V(6); PG8_BAR;
    } else {
        PG8_STAGE(PG8_SB(0, 0), cB, voffB); PG8_STAGE(PG8_SA(0, 0), cA, voffA); PG8_STAGE(PG8_SB(0, 1), cB + hstep, voffB); PG8_STAGE(PG8_SA(0, 1), cA + hstep, voffA);
        if (wr == 1) PG8_BAR;
        PG8_WAIT_V(4); PG8_BAR;
        PG8_STAGE(PG8_SB(1, 0), cB + kstep, voffB); PG8_STAGE(PG8_SA(1, 0), cA + kstep, voffA); PG8_STAGE(PG8_SB(1, 1), cB + hstep + kstep, voffB);
        PG8_WAIT_V(6); PG8_BAR;
    }
    for (;;) {
        const bool has_next = S.next(ui + 1, nxt);
        const char* nA = has_next ? (const char*)g.A + (size_t)nxt.pm * tstep : cA; const char* nB = has_next ? (const char*)g.Bt + (size_t)nxt.pn * tstep : cB;
        for (int t = 0; t < nt; t += 2) {
            const bool last = (t == nt - 2);
            const char* a1 = cA + (size_t)(t + 1) * kstep;
            const char* a2 = last ? nA : cA + (size_t)(t + 2) * kstep; const char* b2 = last ? nB : cB + (size_t)(t + 2) * kstep;
            const char* a3 = a2 + kstep; const char* b3 = b2 + kstep;
            if (last && has_next) S.a_ready(nxt);
            if constexpr (SP2) {
            PG8_LDB(B0, 0, 0); PG8_LDB(B1, 0, 1); PG8_SCHED; PG8_LDA(At, 0, 0); PG8_STAGE(PG8_SA(1, 1), a1 + hstep, voffA);
            PG8_WAIT_V(8); PG8_WAIT_L(0); PG8_BAR; PG8_MMA2(0); PG8_BAR; PG8_SCHED;
            PG8_LDA(At, 0, 1); PG8_STAGE(PG8_SB(0, 0), b2, voffB); PG8_STAGE(PG8_SB(0, 1), b2 + hstep, voffB); PG8_STAGE(PG8_SA(0, 0), a2, voffA);
            PG8_WAIT_V(8); PG8_WAIT_L(0); PG8_BAR; PG8_MMA2(1); PG8_BAR; PG8_SCHED;
            PG8_LDB(B0, 1, 0); PG8_LDB(B1, 1, 1); PG8_SCHED; PG8_LDA(At, 1, 0); PG8_STAGE(PG8_SA(0, 1), a2 + hstep, voffA);
            PG8_WAIT_V(8); PG8_WAIT_L(0); PG8_BAR; PG8_MMA2(0); PG8_BAR; PG8_SCHED;
            PG8_LDA(At, 1, 1); PG8_STAGE(PG8_SB(1, 0), b3, voffB); PG8_STAGE(PG8_SB(1, 1), b3 + hstep, voffB); PG8_STAGE(PG8_SA(1, 0), a3, voffA);
            PG8_WAIT_V(8); PG8_WAIT_L(0); PG8_BAR; PG8_MMA2(1); PG8_BAR; PG8_SCHED;
            } else {
            PG8_LDB(B0, 0, 0); PG8_SCHED; PG8_LDA(At, 0, 0); PG8_STAGE(PG8_SA(1, 1), a1 + hstep, voffA);
            PG8_WAIT_L(8); PG8_BAR; PG8_WAIT_L(0); PG8_MMA(0, 0, At, B0); PG8_BAR; PG8_SCHED;
            PG8_LDB(B1, 0, 1); PG8_STAGE(PG8_SB(0, 0), b2, voffB);
            PG8_BAR; PG8_WAIT_L(0); PG8_MMA(0, 1, At, B1); PG8_BAR;
            PG8_LDA(At, 0, 1); PG8_STAGE(PG8_SA(0, 0), a2, voffA);
            PG8_BAR; PG8_WAIT_L(0); PG8_MMA(1, 0, At, B0); PG8_BAR; PG8_SCHED;
            PG8_STAGE(PG8_SB(0, 1), b2 + hstep, voffB);
            PG8_WAIT_V(6); PG8_BAR; PG8_MMA(1, 1, At, B1); PG8_BAR;
            PG8_LDB(B0, 1, 0); PG8_SCHED; PG8_LDA(At, 1, 0); PG8_STAGE(PG8_SA(0, 1), a2 + hstep, voffA);
            PG8_WAIT_L(8); PG8_BAR; PG8_WAIT_L(0); PG8_MMA(0, 0, At, B0); PG8_BAR; PG8_SCHED;
            PG8_LDB(B1, 1, 1); PG8_STAGE(PG8_SB(1, 0), b3, voffB);
            PG8_BAR; PG8_WAIT_L(0); PG8_MMA(0, 1, At, B1); PG8_BAR;
            PG8_LDA(At, 1, 1); PG8_STAGE(PG8_SA(1, 0), a3, voffA);
            PG8_BAR; PG8_WAIT_L(0); PG8_MMA(1, 0, At, B0); PG8_BAR; PG8_SCHED;
            PG8_STAGE(PG8_SB(1, 1), b3 + hstep, voffB);
            PG8_WAIT_V(6); PG8_BAR; PG8_MMA(1, 1, At, B1); PG8_BAR;
            }
        }
        if constexpr (ALIGN_EPI) { if (wr == 0) PG8_BAR; }
        E(acc, cur, wr, wc, fr, fq);
        if (!has_next) break;
#pragma unroll
        for (int a = 0; a < 2; ++a)
#pragma unroll
            for (int b = 0; b < 2; ++b)
#pragma unroll
                for (int m = 0; m < 4; ++m)
#pragma unroll
                    for (int n = 0; n < 2; ++n) acc[a][b][m][n] = (f32x4){0.f, 0.f, 0.f, 0.f};
        cur = nxt; cA = nA; cB = nB; ++ui;
        if constexpr (ALIGN_EPI) { if (wr == 1) PG8_BAR; }
    }
    PG8_WAIT_V(0);
    if constexpr (!ALIGN_EPI) { if (wr == 0) PG8_BAR; }
    PG8_BAR;
#undef PG8_SA
#undef PG8_SB
#undef PG8_STAGE
#undef PG8_LDA
#undef PG8_LDB
#undef PG8_MMA
#undef PG8_MMA2
#undef PG8_WAIT_V
#undef PG8_WAIT_L
#undef PG8_BAR
#undef PG8_SCHED
}
}
#ifndef PG8_SP2
#define PG8_SP2 true
#endif
#ifndef PG8_ALIGN
#define PG8_ALIGN true
#endif

__device__ __forceinline__ float row_rstd(const float* ssq, int row) {
    const f32x4* p = (const f32x4*)(ssq + (size_t)row * 16);
    const f32x4 a = p[0], b = p[1], c = p[2], d = p[3];
    const float s = ((a.x + a.y) + (a.z + a.w)) + ((b.x + b.y) + (b.z + b.w)) + ((c.x + c.y) + (c.z + c.w)) + ((d.x + d.y) + (d.z + d.w));
    return rsqrtf(s * (1.0f / DM) + NORM_EPS);
}
__device__ __forceinline__ float row_rstd_s(const float* ssqs, int n) {
    const f32x4* p = (const f32x4*)(ssqs + (size_t)n * 64); float s = 0.f;
#pragma unroll
    for (int i = 0; i < 16; ++i) { const f32x4 a = p[i]; s += (a.x + a.y) + (a.z + a.w); }
    return rsqrtf(s * (1.0f / DM) + NORM_EPS);
}
struct SsqQ { f32x4 s[4]; };
__device__ __forceinline__ SsqQ ssqs_quarter(const float* ssqs, int n, int fq) { SsqQ r; const f32x4* p = (const f32x4*)(ssqs + (size_t)n * 64 + 16 * fq);
#pragma unroll
    for (int i = 0; i < 4; ++i) r.s[i] = p[i];
    return r; }
__device__ __forceinline__ float ssqs_rstd(const SsqQ& r) {
    float s = 0.f;
#pragma unroll
    for (int i = 0; i < 4; ++i) s += (r.s[i].x + r.s[i].y) + (r.s[i].z + r.s[i].w);
    s += __shfl_xor(s, 16); s += __shfl_xor(s, 32);
    return rsqrtf(s * (1.0f / DM) + NORM_EPS);
}
__device__ __forceinline__ u32x4 pack8(const float (&v)[8]) { u32x4 w; w.x = pk2(v[0], v[1]); w.y = pk2(v[2], v[3]); w.z = pk2(v[4], v[5]); w.w = pk2(v[6], v[7]); return w; }

struct EpiHgrnIn {
    static constexpr bool PERM = true;
    unsigned char* ws; int layer; const LAS float* rstd_lds;
#define EHI_PTRS const float* ssq = (const float*)(ws + WS_SSQ); bf16_t* Q = (bf16_t*)(ws + WS_Q); bf16_t* Kb = (bf16_t*)(ws + WS_K); bf16_t* LF = (bf16_t*)(ws + WS_LF); bf16_t* V = (bf16_t*)(ws + WS_V); bf16_t* G = (bf16_t*)(ws + WS_G); \
    const float* lb = layer == 0 ? (const float*)nullptr : (const float*)(ws + WS_LB1); const float* ssqs = (const float*)(ws + WS_SSQS); (void)ssq; (void)Q; (void)Kb; (void)LF; (void)V; (void)G; (void)lb; (void)ssqs
    struct Pre { SsqQ q; f32x4 l4; };
    __device__ __forceinline__ Pre sample_pre(int row, int col, int fq) const {
        EHI_PTRS; Pre p; p.q = ssqs_quarter(ssqs, row - TP, fq); p.l4 = (f32x4){0.f, 0.f, 0.f, 0.f};
        if ((col >> 10) == 1 && lb) p.l4 = *(const f32x4*)(lb + (col & 1023));
        return p; }
    __device__ __forceinline__ void sample(const f32x4 a, int row, int col, int u, int fq, const Pre& pre) const {
        EHI_PTRS;
        const float rs = ssqs_rstd(pre.q); const int sec = col >> 10, ch = col & 1023; const size_t idx = (size_t)row * DM + ch;
        float v[4] = {a[0] * rs, a[1] * rs, a[2] * rs, a[3] * rs};
        if (sec == 0) {
#pragma unroll
            for (int j = 0; j < 4; ++j) v[j] = silu_f(v[j]);
            u32x2 w; w.x = pk2(v[0], v[1]); w.y = pk2(v[2], v[3]); *(u32x2*)(Q + idx) = w;
        } else if (sec == 1) {
            const f32x4 l4 = pre.l4;
            float lf[4];
#pragma unroll
            for (int j = 0; j < 4; ++j) { const float e = __expf(-v[j]); const float s = fast_rcp(1.0f + e); lf[j] = __builtin_amdgcn_logf(l4[j] + (1.0f - l4[j]) * s); }
            { u32x2 wl; wl.x = pk2(lf[0], lf[1]); wl.y = pk2(lf[2], lf[3]); *(u32x2*)(LF + idx) = wl; }
        } else if (sec == 2) {
            u32x2 w; w.x = pk2(v[0], v[1]); w.y = pk2(v[2], v[3]); *(u32x2*)(V + idx) = w;
        } else {
#pragma unroll
            for (int j = 0; j < 4; ++j) v[j] = silu_f(v[j]);
            u32x2 w; w.x = pk2(v[0], v[1]); w.y = pk2(v[2], v[3]); *(u32x2*)(G + idx) = w;
        }
    }
    __device__ __forceinline__ void operator()(const f32x4 (&acc)[2][2][4][2], const pg8::Unit& u, int wr, int wc, int fr_, int fq_) const {
        int fr = fr_, fq = fq_; asm volatile("" : "+v"(fr), "+v"(fq));
        EHI_PTRS;
        const int sec = u.pn >> 2;
        const int colb = (u.pn & 3) * 256 + wc * 32 + 8 * fq;
        float lbu[2][8];
#pragma unroll
        for (int bj = 0; bj < 2; ++bj) {
            if (sec == 1 && lb) { const f32x4 l0 = *(const f32x4*)(lb + colb + bj * 128), l1 = *(const f32x4*)(lb + colb + bj * 128 + 4); lbu[bj][0] = l0.x; lbu[bj][1] = l0.y; lbu[bj][2] = l0.z; lbu[bj][3] = l0.w; lbu[bj][4] = l1.x; lbu[bj][5] = l1.y; lbu[bj][6] = l1.z; lbu[bj][7] = l1.w; }
            else {
#pragma unroll
                for (int j = 0; j < 8; ++j) lbu[bj][j] = 0.f; }
        }
#pragma unroll
        for (int ai = 0; ai < 2; ++ai)
#pragma unroll
            for (int m = 0; m < 4; ++m) {
                const int row = u.pm * 256 + ai * 128 + wr * 64 + m * 16 + fr;
                const float rs = rstd_lds[ai * 128 + wr * 64 + m * 16 + fr];
#pragma unroll
                for (int bj = 0; bj < 2; ++bj) {
                    const int col = colb + bj * 128; const size_t idx = (size_t)row * DM + col;
                    float v[8];
#pragma unroll
                    for (int j = 0; j < 4; ++j) { v[j] = acc[ai][bj][m][0][j] * rs; v[4 + j] = acc[ai][bj][m][1][j] * rs; }
                    if (sec == 0) {
#pragma unroll
                        for (int j = 0; j < 8; ++j) v[j] = silu_f(v[j]);
                        *(u32x4*)(Q + idx) = pack8(v);
                    } else if (sec == 1) {
                        float lbv[8];
#pragma unroll
                        for (int j = 0; j < 8; ++j) lbv[j] = lbu[bj][j];
                        float lf[8];
#pragma unroll
                        for (int j = 0; j < 8; ++j) { const float e = __expf(-v[j]); const float s = fast_rcp(1.0f + e); lf[j] = __builtin_amdgcn_logf(lbv[j] + (1.0f - lbv[j]) * s); }
                        *(u32x4*)(LF + idx) = pack8(lf);
                    } else if (sec == 2) {
                        *(u32x4*)(V + idx) = pack8(v);
                    } else {
#pragma unroll
                        for (int j = 0; j < 8; ++j) v[j] = silu_f(v[j]);
                        *(u32x4*)(G + idx) = pack8(v);
                    }
                }
            }
    }
};

struct EpiResid {
    static constexpr bool PERM = true;
    unsigned char* ws;
#define ERS_PTRS const bf16_t* Hold = (const bf16_t*)(ws + WS_HB); bf16_t* HB = (bf16_t*)(ws + WS_HB); float* ssq = (float*)(ws + WS_SSQ); float* ssqs = (float*)(ws + WS_SSQS); (void)ssq; (void)ssqs
    struct Pre { u32x2 hw; };
    __device__ __forceinline__ Pre sample_pre(int row, int col, int fq) const { ERS_PTRS; Pre p; p.hw = *(const u32x2*)(Hold + (size_t)row * DM + col); return p; }
    __device__ __forceinline__ void sample(const f32x4 a, int row, int col, int u, int fq, const Pre& pre) const {
        ERS_PTRS;
        const size_t idx = (size_t)row * DM + col;
        const u32x2 hw = pre.hw;
        f32x4 o = {bflo(hw.x), bfhi(hw.x), bflo(hw.y), bfhi(hw.y)}; o += a;
        u32x2 w; w.x = pk2(o.x, o.y); w.y = pk2(o.z, o.w); *(u32x2*)(HB + idx) = w;
        float part = (o.x * o.x + o.y * o.y) + (o.z * o.z + o.w * o.w);
        part += __shfl_xor(part, 16); part += __shfl_xor(part, 32);
        if (fq == 0) ssqs[(size_t)(row - TP) * 64 + u] = part;
    }
    __device__ __forceinline__ void operator()(const f32x4 (&acc)[2][2][4][2], const pg8::Unit& u, int wr, int wc, int fr_, int fq_) const {
        int fr = fr_, fq = fq_; asm volatile("" : "+v"(fr), "+v"(fq));
        ERS_PTRS;
        const int col0 = u.pn * 256 + wc * 32 + 8 * fq;
#pragma unroll
        for (int ai = 0; ai < 2; ++ai) {
        u32x4 hpre[4][2];
#pragma unroll
            for (int m = 0; m < 4; ++m)
#pragma unroll
                for (int bj = 0; bj < 2; ++bj) hpre[m][bj] = *(const u32x4*)(Hold + (size_t)(u.pm * 256 + ai * 128 + wr * 64 + m * 16 + fr) * DM + col0 + bj * 128);
        __builtin_amdgcn_sched_barrier(0);
#pragma unroll
            for (int m = 0; m < 4; ++m) {
                const int row = u.pm * 256 + ai * 128 + wr * 64 + m * 16 + fr;
                float part = 0.f;
#pragma unroll
                for (int bj = 0; bj < 2; ++bj) {
                    const int col = col0 + bj * 128; const size_t idx = (size_t)row * DM + col;
                    const u32x4 hw = hpre[m][bj];
                    f32x4 o0 = {bflo(hw.x), bfhi(hw.x), bflo(hw.y), bfhi(hw.y)}, o1 = {bflo(hw.z), bfhi(hw.z), bflo(hw.w), bfhi(hw.w)};
                    o0 += acc[ai][bj][m][0]; o1 += acc[ai][bj][m][1];
                    u32x4 w; w.x = pk2(o0.x, o0.y); w.y = pk2(o0.z, o0.w); w.z = pk2(o1.x, o1.y); w.w = pk2(o1.z, o1.w);
                    *(u32x4*)(HB + idx) = w;
                    part += (o0.x * o0.x + o0.y * o0.y) + (o0.z * o0.z + o0.w * o0.w) + (o1.x * o1.x + o1.y * o1.y) + (o1.z * o1.z + o1.w * o1.w);
                }
                part += __shfl_xor(part, 16); part += __shfl_xor(part, 32);
                if (fq == 0) ssq[(size_t)row * 16 + u.pn * 4 + wc] = part;
            }
        }
    }
};

struct EpiSwaIn {
    static constexpr bool PERM = true;
    unsigned char* ws; float* out; const LAS float* rstd_lds; const LAS float* rope_lds;
#define ESI_PTRS const float* ssq = (const float*)(ws + WS_SSQ); const float* rope = (const float*)(ws + WS_ROPE); bf16_t* QA = (bf16_t*)(ws + WS_Q); bf16_t* GA = (bf16_t*)(ws + WS_G); bf16_t* KA = (bf16_t*)(ws + WS_KA); bf16_t* VA = (bf16_t*)(ws + WS_VA); \
    const float* ssqs = (const float*)(ws + WS_SSQS); (void)ssq; (void)rope; (void)QA; (void)GA; (void)KA; (void)VA; (void)ssqs
    struct Pre { SsqQ q; f32x4 c4, s4; };
    __device__ __forceinline__ Pre sample_pre(int row, int col, int fq) const {
        ESI_PTRS; Pre p; p.q = ssqs_quarter(ssqs, row - TP, fq);
        const float* rp = rope + (size_t)SEQ * 16 + ((4 * fq) & 7); p.c4 = *(const f32x4*)rp; p.s4 = *(const f32x4*)(rp + 8);
        return p; }
    __device__ __forceinline__ void sample(const f32x4 a, int row, int col, int u, int fq, const Pre& pre) const {
        ESI_PTRS;
        const float rs = ssqs_rstd(pre.q);
        float v[4] = {a[0] * rs, a[1] * rs, a[2] * rs, a[3] * rs};
        const int sec = col < 1024 ? 0 : col < 2048 ? 1 : col < 2176 ? 2 : 3;
        if ((sec == 0 || sec == 2) && ((16 * u) & 63) == 0) {
#pragma unroll
            for (int r = 0; r < 4; ++r) { const float pr = __shfl_xor(v[r], 32); const float c = pre.c4[r], s = pre.s4[r];
                v[r] = fq < 2 ? v[r] * c - pr * s : v[r] * c + pr * s; }
        }
        if (sec == 0) {
#pragma unroll
            for (int j = 0; j < 4; ++j) v[j] *= 0.18033688011112042f;
            u32x2 w; w.x = pk2(v[0], v[1]); w.y = pk2(v[2], v[3]); *(u32x2*)(QA + (size_t)row * DM + col) = w;
        } else if (sec == 1) {
#pragma unroll
            for (int j = 0; j < 4; ++j) v[j] = silu_f(v[j]);
            u32x2 w; w.x = pk2(v[0], v[1]); w.y = pk2(v[2], v[3]); *(u32x2*)(GA + (size_t)row * DM + (col - 1024)) = w;
        } else {
            const int kc = sec == 2 ? col - 2048 : col - 2176;
            u32x2 w; w.x = pk2(v[0], v[1]); w.y = pk2(v[2], v[3]); *(u32x2*)((sec == 2 ? KA : VA) + (size_t)row * 128 + kc) = w;
            *(f32x4*)(out + (sec == 2 ? O_KNS : O_VNS) + (size_t)(row - TP) * 128 + kc) = (f32x4){v[0], v[1], v[2], v[3]};
        }
    }
    __device__ __forceinline__ void operator()(const f32x4 (&acc)[2][2][4][2], const pg8::Unit& u, int wr, int wc, int fr_, int fq_) const {
        int fr = fr_, fq = fq_; asm volatile("" : "+v"(fr), "+v"(fq));
        ESI_PTRS;
        const int sec = u.pn >> 2;
        const int colb = (u.pn & 3) * 256 + wc * 32 + 8 * fq;
        const bool rot_wave = (wc & 1) == 0;
#pragma unroll
        for (int ai = 0; ai < 2; ++ai)
#pragma unroll
            for (int m = 0; m < 4; ++m) {
                const int row = u.pm * 256 + ai * 128 + wr * 64 + m * 16 + fr;
                const int rl = ai * 128 + wr * 64 + m * 16 + fr;
                const float rs = rstd_lds[rl];
                float cs[8], sn[8];
                if (sec != 1 && rot_wave) {
                    const LAS f32x4* rp = (const LAS f32x4*)(rope_lds + rl * 16);
                    const f32x4 c0 = rp[0], c1 = rp[1], s0 = rp[2], s1 = rp[3];
                    cs[0] = c0.x; cs[1] = c0.y; cs[2] = c0.z; cs[3] = c0.w; cs[4] = c1.x; cs[5] = c1.y; cs[6] = c1.z; cs[7] = c1.w;
                    sn[0] = s0.x; sn[1] = s0.y; sn[2] = s0.z; sn[3] = s0.w; sn[4] = s1.x; sn[5] = s1.y; sn[6] = s1.z; sn[7] = s1.w;
                }
#pragma unroll
                for (int bj = 0; bj < 2; ++bj) {
                    if (u.hs != 0 && bj != u.hs - 1) continue;
                    float v[8];
#pragma unroll
                    for (int j = 0; j < 4; ++j) { v[j] = acc[ai][bj][m][0][j] * rs; v[4 + j] = acc[ai][bj][m][1][j] * rs; }
                    if (sec == 0) {
                        const int col = colb + bj * 128; const size_t idx = (size_t)row * DM + col;
                        if (rot_wave) {
                            float pr[8];
#pragma unroll
                            for (int j = 0; j < 8; ++j) pr[j] = __shfl_xor(v[j], 16);
                            if (fq < 2) { const float sg = fq == 0 ? -1.0f : 1.0f;
#pragma unroll
                                for (int j = 0; j < 8; ++j) v[j] = v[j] * cs[j] + sg * pr[j] * sn[j]; }
                        }
#pragma unroll
                        for (int j = 0; j < 8; ++j) v[j] *= 0.18033688011112042f;
                        *(u32x4*)(QA + idx) = pack8(v);
                    } else if (sec == 1) {
                        const int col = colb + bj * 128; const size_t idx = (size_t)row * DM + col;
#pragma unroll
                        for (int j = 0; j < 8; ++j) v[j] = silu_f(v[j]);
                        *(u32x4*)(GA + idx) = pack8(v);
                    } else {
                        const int kc = wc * 32 + 8 * fq;
                        const size_t idx = (size_t)row * 128 + kc;
                        if (bj == 0 && rot_wave) {
                            float pr[8];
#pragma unroll
                            for (int j = 0; j < 8; ++j) pr[j] = __shfl_xor(v[j], 16);
                            if (fq < 2) { const float sg = fq == 0 ? -1.0f : 1.0f;
#pragma unroll
                                for (int j = 0; j < 8; ++j) v[j] = v[j] * cs[j] + sg * pr[j] * sn[j]; }
                        }
                        *(u32x4*)((bj == 0 ? KA : VA) + idx) = pack8(v);
                        float* dst = nullptr;
                        if (row < TP) { const int t = row & (SEQ - 1); if (t >= SEQ - 128) dst = out + (bj == 0 ? O_KWP : O_VWP) + ((size_t)((row >> 11) * 128 + (t - (SEQ - 128))) * 128 + kc); }
                        else if (row < TP + TS) dst = out + (bj == 0 ? O_KNS : O_VNS) + ((size_t)(row - TP) * 128 + kc);
                        if (dst) { *(f32x4*)dst = (f32x4){v[0], v[1], v[2], v[3]}; *(f32x4*)(dst + 4) = (f32x4){v[4], v[5], v[6], v[7]}; }
                    }
                }
            }
    }
};

#define LDS_BARRIER() asm volatile("s_waitcnt lgkmcnt(0)\n\ts_barrier" ::: "memory")
template <int ROWS, int COLS, class Epi>
__device__ __forceinline__ void sgemm_unit(LAS unsigned char* lds, const bf16_t* HBs, const bf16_t* Bt, int u, const Epi& E, int wave, int lane, const int tid) {
    constexpr int KC = 256, NCH = 1024 / KC;
    constexpr int XP = KC * 2 + 16, XBUF = (ROWS + COLS) * XP;
    constexpr int NLX = ROWS / 16, NLW = (COLS * 32 + 511) / 512;
    constexpr int NRG = 128 / ROWS;
    const int cgu = u / NRG, row0 = ROWS * (u % NRG), col0 = COLS * cgu;
    const int fr = lane & 15, fq = lane >> 4;
    const int rt = COLS == 16 ? wave : (wave & 3), ct = COLS == 16 ? 0 : (wave >> 2);
    const int lr = tid >> 5, lc = tid & 31;
    const bool wl = COLS * 32 >= 512 || tid < COLS * 32;
    const bf16_t* xa = HBs + (size_t)(row0 + lr) * DM + lc * 8;
    const bf16_t* wa = Bt + (size_t)(col0 + (lr & (COLS - 1))) * DM + lc * 8;
    u32x4 xr[NCH][NLX], wv[NCH][NLW];
#pragma unroll
    for (int c = 0; c < NCH; ++c) {
#pragma unroll
        for (int i = 0; i < NLX; ++i) xr[c][i] = *(const u32x4*)(xa + (size_t)16 * i * DM + KC * c);
#pragma unroll
        for (int i = 0; i < NLW; ++i) { if (wl) wv[c][i] = *(const u32x4*)(wa + (size_t)16 * i * DM + KC * c); }
    }
    const int srow = TP + row0 + 16 * rt + fr, scol = col0 + 16 * ct + 4 * fq;
    typename Epi::Pre pre;
    if (16 * rt < ROWS) pre = E.sample_pre(srow, scol, fq);
    f32x4 acc = {0.f, 0.f, 0.f, 0.f};
#pragma unroll
    for (int c = 0; c < NCH; ++c) {
        LAS unsigned char* buf = lds + (c & 1) * XBUF;
#pragma unroll
        for (int i = 0; i < NLX; ++i) *(LAS u32x4*)(buf + (lr + 16 * i) * XP + lc * 16) = xr[c][i];
#pragma unroll
        for (int i = 0; i < NLW; ++i) { if (wl) *(LAS u32x4*)(buf + (ROWS + lr + 16 * i) * XP + lc * 16) = wv[c][i]; }
        LDS_BARRIER();
        if (16 * rt < ROWS) {
#pragma unroll
            for (int k4 = 0; k4 < KC / 32; k4 += 4) {
                bf16x8 xf[4], wf[4];
#pragma unroll
                for (int i = 0; i < 4; ++i) {
                    xf[i] = *(const LAS bf16x8*)(buf + (16 * rt + fr) * XP + (32 * (k4 + i) + 8 * fq) * 2);
                    wf[i] = *(const LAS bf16x8*)(buf + (ROWS + 16 * ct + fr) * XP + (32 * (k4 + i) + 8 * fq) * 2); }
                __builtin_amdgcn_sched_barrier(0);
#pragma unroll
                for (int i = 0; i < 4; ++i) acc = MFMA16(wf[i], xf[i], acc);
                __builtin_amdgcn_sched_barrier(0);
            }
        }
    }
    LDS_BARRIER();
    if (16 * rt < ROWS) E.sample(acc, srow, scol, (col0 >> 4) + ct, fq, pre);
}

#define XB_TMO      128
#define XB_XCNT(j)  (256  + 64 * (j))
#define XB_XSUB(j)  (1280 + 64 * (j))
#define XB_XGEN(j)  (2304 + 64 * (j))
#define XB_TOP      3328
#define XB_TOPGEN   3392
#define XB_EXIT     3456
#define XCD_BAR_WORDS 3520
__device__ unsigned g_barrier_words[XCD_BAR_WORDS];
#define XB_SPIN_CAP (1u << 18)
__device__ __forceinline__ unsigned xb_ld(unsigned* p)              { return __hip_atomic_load(p, __ATOMIC_RELAXED, __HIP_MEMORY_SCOPE_AGENT); }
__device__ __forceinline__ unsigned xb_add(unsigned* p, unsigned v) { return __hip_atomic_fetch_add(p, v, __ATOMIC_RELAXED, __HIP_MEMORY_SCOPE_AGENT); }
__device__ __forceinline__ unsigned xb_xcc_id() { return (unsigned)__builtin_amdgcn_s_getreg((3 << 11) | 20) & 0xFu; }
#define XB_SPIN(cond, bar) do { unsigned _sp = 0; while (cond) { __builtin_amdgcn_s_sleep(1); \
    if ((++_sp & 255u) == 0u) { if (xb_ld(&(bar)[XB_TMO])) break; if (_sp > XB_SPIN_CAP) { atomicAdd(&(bar)[XB_TMO], 1u); break; } } } } while (0)
struct XcdBarrier { unsigned* bar; unsigned x; volatile LAS unsigned* st; };
__device__ __forceinline__ XcdBarrier xcd_barrier_post(unsigned* bar, volatile LAS unsigned* st) {
    XcdBarrier b; b.bar = bar; b.x = xb_xcc_id(); b.st = st;
    if (threadIdx.x == 0) (void)xb_add(&bar[XB_XCNT(b.x)], 1u);
    return b;
}
__device__ __forceinline__ void xcd_barrier_complete(unsigned* bar, unsigned x, unsigned& nloc, unsigned& nx) {
    const unsigned G = gridDim.x * gridDim.y * gridDim.z;
    unsigned sum, cnt, mine, sp = 0u;
    for (;;) {
        sum = 0u; cnt = 0u; mine = 0u;
#pragma unroll
        for (unsigned j = 0; j < 16; ++j) { const unsigned c = xb_ld(&bar[XB_XCNT(j)]); sum += c; cnt += (c > 0u) ? 1u : 0u; mine = (j == x) ? c : mine; }
        if (sum == G) break;
        __builtin_amdgcn_s_sleep(1);
        if ((++sp & 255u) == 0u) { if (xb_ld(&bar[XB_TMO])) break; if (sp > XB_SPIN_CAP) { atomicAdd(&bar[XB_TMO], 1u); break; } }
    }
    nloc = mine > 0u ? mine : 1u; nx = cnt > 0u ? cnt : 1u;
}
__device__ __forceinline__ void xcd_barrier(const XcdBarrier& b) {
    asm volatile("s_waitcnt vmcnt(0)" ::: "memory");
    __syncthreads();
    if (threadIdx.x == 0) {
        unsigned* bar = b.bar;
        __builtin_amdgcn_s_waitcnt(0);
        unsigned nloc = b.st[0], nx = b.st[1];
        if (nloc == 0u) { xcd_barrier_complete(bar, b.x, nloc, nx); b.st[0] = nloc; b.st[1] = nx; }
        const unsigned old = xb_add(&bar[XB_XSUB(b.x)], 1u);
        const unsigned gen = old / nloc;
        const unsigned target = (gen + 1u) * nx;
        if (old + 1u == (gen + 1u) * nloc) {
            __builtin_amdgcn_fence(__ATOMIC_RELEASE, "agent");
            asm volatile("s_waitcnt vmcnt(0)" ::: "memory");
            const unsigned og = xb_add(&bar[XB_TOP], 1u);
            if (og + 1u != target) XB_SPIN(xb_ld(&bar[XB_TOP]) < target, bar);
        } else {
            XB_SPIN(xb_ld(&bar[XB_TOP]) < target, bar);
        }
        __builtin_amdgcn_fence(__ATOMIC_ACQUIRE, "agent");
        asm volatile("s_waitcnt vmcnt(0)" ::: "memory");
    }
    __syncthreads();
}

constexpr int RING_OFF = 0, RING_BYTES = 131072;
constexpr int LDSCTL_OFF = RING_BYTES, MISC_OFF = LDSCTL_OFF + 320;
constexpr int RSTD_OFF = 131584, ROPEL_OFF = 132608;
constexpr int LDS_BYTES = 155648;
constexpr int NWAVES = 8;

struct Args {
    const float* in[17]; float* out; unsigned char* ws; int ph_lo, ph_hi;
};
typedef const Args __attribute__((address_space(4)))* KArgPtr;
__device__ __forceinline__ KArgPtr kargs() { KArgPtr p = (KArgPtr)__builtin_amdgcn_kernarg_segment_ptr(); asm volatile("" : "+s"(p)); return p; }
__device__ __forceinline__ int fresh_tid() { int t = threadIdx.x; asm volatile("" : "+v"(t)); return t; }

__device__ __forceinline__ void stage_row_tables(unsigned char* ws, int pm, LAS unsigned char* lds, bool with_rope, const int tid) {
    if (tid < 256) ((LAS float*)(lds + RSTD_OFF))[tid] = row_rstd((const float*)(ws + WS_SSQ), pm * 256 + tid);
    if (with_rope) {
        const f32x4* rope = (const f32x4*)(ws + WS_ROPE);
#pragma unroll
        for (int i = 0; i < 2; ++i) { const int v = tid + 512 * i, r = v >> 2, part = v & 3; ((LAS f32x4*)(lds + ROPEL_OFF))[v] = rope[(size_t)((pm * 256 + r) & (SEQ - 1)) * 4 + part]; }
    }
    __syncthreads();
}

struct P0Item { const float* W; const float* scale; int smask, K, N; bf16_t* WT; int row_off, item; };
struct P0Tile { f32x4 wv[8]; float scv[8]; };
__device__ __forceinline__ void p0_item_load(P0Tile& t, const P0Item& d, int lane) {
    const int nblk = d.N / 32, kb = d.item / nblk, nb = d.item % nblk, k0 = 64 * kb, n0 = 32 * nb;
#pragma unroll
    for (int i = 0; i < 8; ++i) { const int kk = (lane >> 3) + 8 * i;
        t.wv[i] = __builtin_nontemporal_load((const f32x4*)(d.W + (size_t)(k0 + kk) * d.N + n0 + 4 * (lane & 7)));
        t.scv[i] = d.scale ? d.scale[(k0 + kk) & d.smask] : 1.0f; }
}
__device__ __forceinline__ void p0_item_finish(const P0Tile& t, const P0Item& d, LAS float* scr, int lane) {
    const int nblk = d.N / 32, kb = d.item / nblk, nb = d.item % nblk, k0 = 64 * kb, n0 = 32 * nb;
#pragma unroll
    for (int i = 0; i < 8; ++i) { const int kk = (lane >> 3) + 8 * i; LAS float* dd = scr + kk * 33 + 4 * (lane & 7);
        dd[0] = t.wv[i].x * t.scv[i]; dd[1] = t.wv[i].y * t.scv[i]; dd[2] = t.wv[i].z * t.scv[i]; dd[3] = t.wv[i].w * t.scv[i]; }
    LDS_WAIT(); asm volatile("" ::: "memory");
    const int c = lane & 7;
#pragma unroll
    for (int j = 0; j < 4; ++j) { const int n = (lane >> 3) + 8 * j; const LAS float* s = scr + (8 * c) * 33 + n;
        u32x4 o; o.x = pk2(s[0 * 33], s[1 * 33]); o.y = pk2(s[2 * 33], s[3 * 33]); o.z = pk2(s[4 * 33], s[5 * 33]); o.w = pk2(s[6 * 33], s[7 * 33]);
        *(u32x4*)(d.WT + (size_t)(d.row_off + n0 + n) * d.K + k0 + 8 * c) = o; }
    LDS_WAIT(); asm volatile("" ::: "memory");
}
__device__ __forceinline__ void p0_prologue(KArgPtr Ap, LAS unsigned char* lds, int wave, int lane) {
    unsigned char* ws = Ap->ws;
    LAS float* scr = (LAS float*)(lds + RING_OFF + wave * 16384);
    const int G = gridDim.x, gw = blockIdx.x * NWAVES + wave, NGW = G * NWAVES;
    constexpr int I_AIN = 16 * 128, I_SQ = 16 * 32, I_BIN = 16 * 64, I_KV = 16 * 8;
    constexpr int NITEMS = 2 * I_AIN + 2 * I_SQ + 2 * I_BIN + I_KV + 2 * I_SQ;
    auto item_of = [&](int it) -> P0Item {
        int r = it;
        if (r < I_AIN) return P0Item{Ap->in[6], Ap->in[5], 1023, 1024, 4096, (bf16_t*)(ws + WS_WIN0), 0, r}; r -= I_AIN;
        if (r < I_AIN) return P0Item{Ap->in[6] + (size_t)1024 * 4096, Ap->in[5] + 1024, 1023, 1024, 4096, (bf16_t*)(ws + WS_WIN1), 0, r}; r -= I_AIN;
        if (r < I_SQ) return P0Item{Ap->in[9], Ap->in[8], 127, 1024, 1024, (bf16_t*)(ws + WS_WOUT0), 0, r}; r -= I_SQ;
        if (r < I_SQ) return P0Item{Ap->in[9] + (size_t)1024 * 1024, Ap->in[8] + 128, 127, 1024, 1024, (bf16_t*)(ws + WS_WOUT1), 0, r}; r -= I_SQ;
        if (r < I_BIN) return P0Item{Ap->in[13], Ap->in[12], 1023, 1024, 2048, (bf16_t*)(ws + WS_WINB0), 0, r}; r -= I_BIN;
        if (r < I_BIN) return P0Item{Ap->in[13] + (size_t)1024 * 2048, Ap->in[12] + 1024, 1023, 1024, 2048, (bf16_t*)(ws + WS_WINB1), 0, r}; r -= I_BIN;
        if (r < I_KV) return P0Item{Ap->in[11], Ap->in[10], 1023, 1024, 256, (bf16_t*)(ws + WS_WINB0), 2048, r}; r -= I_KV;
        if (r < I_SQ) return P0Item{Ap->in[15], nullptr, 0, 1024, 1024, (bf16_t*)(ws + WS_WOUTB0), 0, r}; r -= I_SQ;
        return P0Item{Ap->in[15] + (size_t)1024 * 1024, nullptr, 0, 1024, 1024, (bf16_t*)(ws + WS_WOUTB1), 0, r};
    };
    {
        P0Item cur = item_of(gw < NITEMS ? gw : NITEMS - 1); P0Tile tc; p0_item_load(tc, cur, lane);
#pragma unroll 1
        for (int it = gw; it < NITEMS; it += NGW) {
            const int itn = it + NGW < NITEMS ? it + NGW : it;
            const P0Item nx = item_of(itn); P0Tile tn; p0_item_load(tn, nx, lane);
            p0_item_finish(tc, cur, scr, lane);
            cur = nx; tc = tn;
        }
    }
    bf16_t* HB = (bf16_t*)(ws + WS_HB); float* SSQ = (float*)(ws + WS_SSQ);
    float* SSQS = (float*)(ws + WS_SSQS);
    for (int m0 = gw; m0 < TP + TS; m0 += 2 * NGW) {
        const int m1r = m0 + NGW, m1 = m1r < TP + TS ? m1r : m0;
        f32x4 v[2][4];
#pragma unroll
        for (int r = 0; r < 2; ++r) {
            const int m = r == 0 ? m0 : m1;
            const f32x4* xr = (const f32x4*)(m < TP ? Ap->in[0] + (size_t)m * DM : Ap->in[1] + (size_t)(m - TP) * DM) + lane;
#pragma unroll
            for (int j = 0; j < 4; ++j) v[r][j] = __builtin_nontemporal_load(xr + 64 * j);
        }
#pragma unroll
        for (int r = 0; r < 2; ++r) {
            const int m = r == 0 ? m0 : m1;
            if (r == 1 && m1r >= TP + TS) break;
            float s = 0.f;
#pragma unroll
            for (int j = 0; j < 4; ++j) s += (v[r][j].x * v[r][j].x + v[r][j].y * v[r][j].y) + (v[r][j].z * v[r][j].z + v[r][j].w * v[r][j].w);
            s = wave_sum(s);
            u32x2* o8 = (u32x2*)(HB + (size_t)m * DM) + lane;
#pragma unroll
            for (int j = 0; j < 4; ++j) { u32x2 w; w.x = pk2(v[r][j].x, v[r][j].y); w.y = pk2(v[r][j].z, v[r][j].w); o8[64 * j] = w; }
            if (m < TP) { if (lane < 16) SSQ[(size_t)m * 16 + lane] = lane == 0 ? s : 0.f; }
            else SSQS[(size_t)(m - TP) * 64 + lane] = lane == 0 ? s : 0.f;
        }
    }
    const int gt = blockIdx.x * (NWAVES * 64) + threadIdx.x, NGT = G * NWAVES * 64;
    float* LB1 = (float*)(ws + WS_LB1); float* ROPE = (float*)(ws + WS_ROPE);
    for (int i = gt; i < 1024; i += NGT) { const float l0 = Ap->in[7][i], l1 = Ap->in[7][1024 + i]; LB1[i] = 1.0f / (1.0f + expf(l0 - l1)); }
    for (int i = gt; i < (SEQ + 1) * 8; i += NGT) {
        const int p = i >> 3, j = i & 7; const double pos = p < SEQ ? (double)p : 8192.0;
        const double invf[8] = {1.0, 0.19392274474868576, 0.03760603093086393, 0.007292664737217109, 0.001414213562373095, 0.0002742481756762073, 5.318295896944988e-05, 1.031338537721246e-05};
        double fr_ = invf[0];
#pragma unroll
        for (int q = 1; q < 8; ++q) fr_ = (j == q) ? invf[q] : fr_;
        const double x = pos * fr_;
        const double qd = __builtin_rint(x * 0.6366197723675814);
        const double r = (x - qd * 1.5707963267948966) - qd * 6.123233995736766e-17;
        const double r2 = r * r;
        const double sr = r * (1.0 + r2 * (-1.0 / 6 + r2 * (1.0 / 120 + r2 * (-1.0 / 5040 + r2 * (1.0 / 362880 + r2 * (-1.0 / 39916800 + r2 * (1.0 / 6227020800.0)))))));
        const double cr = 1.0 + r2 * (-0.5 + r2 * (1.0 / 24 + r2 * (-1.0 / 720 + r2 * (1.0 / 40320 + r2 * (-1.0 / 3628800 + r2 * (1.0 / 479001600.0 + r2 * (-1.0 / 87178291200.0)))))));
        const int qi = ((int)((long long)qd)) & 3;
        const double sv = (qi == 0) ? sr : (qi == 1) ? cr : (qi == 2) ? -sr : -cr;
        const double cv = (qi == 0) ? cr : (qi == 1) ? -sr : (qi == 2) ? -cr : sr;
        ROPE[(size_t)p * 16 + j] = (float)cv; ROPE[(size_t)p * 16 + 8 + j] = (float)sv;
    }
}

constexpr int CP = 288, LFI_OFF = 0, QI_OFF = 18432, KI2_OFF = 36864, VI2_OFF = 55296, AM_OFF = 73728, BETA_OFF = 82944, EM_OFF = 83456, LAM1_OFF = 83968;
__device__ __forceinline__ s16x4 tr_read(const LAS unsigned char* p) { return __builtin_bit_cast(s16x4, __builtin_amdgcn_ds_read_tr16_b64_v4i16((LAS s16x4*)p)); }
struct ChunkIn { u32x4 lw[2], qv[2], vv[2]; };
__device__ __forceinline__ void chunk_load(ChunkIn& r, int unit, const bf16_t* Q, const bf16_t* Kb, const bf16_t* LF, const bf16_t* V, const int tid) {
    const int c = unit & 31, bh = unit >> 5, h = bh & 7, b = bh >> 3;
    const size_t g = ((size_t)b * SEQ + (size_t)c * 64 + (tid >> 3)) * DM + h * 128 + (tid & 7) * 8;
#pragma unroll
    for (int i = 0; i < 2; ++i) { r.lw[i] = *(const u32x4*)(LF + g + 64 * i); r.qv[i] = *(const u32x4*)(Q + g + 64 * i); r.vv[i] = *(const u32x4*)(V + g + 64 * i); }
}
__device__ __forceinline__ bf16x8 tr_frag(const LAS unsigned char* img, int kk, int col0, int fr, int fq) {
    const LAS unsigned char* p = img + (32 * kk + 4 * fq + (fr >> 2)) * CP + (col0 + 4 * (fr & 3)) * 2;
    const s16x4 lo = tr_read(p), hi = tr_read(p + 16 * CP);
    return (bf16x8){lo[0], lo[1], lo[2], lo[3], hi[0], hi[1], hi[2], hi[3]};
}
__device__ __forceinline__ void chunk_stepA(LAS unsigned char* lds, int unit, const int pos, float (&lam0)[4], const ChunkIn& r, bf16_t* Qo, float* LAM, int wave, int lane, const int tid) {
    const int c = unit & 31, bh = unit >> 5, h = bh & 7, b = bh >> 3;
    const size_t row0 = (size_t)b * SEQ + (size_t)c * 64;
    const int fr = lane & 15, fq = lane >> 4;
    LAS unsigned char* LFI = lds + LFI_OFF; LAS unsigned char* QI = lds + QI_OFF; LAS unsigned char* KI = lds + KI2_OFF; LAS unsigned char* VI = lds + VI2_OFF;
    LAS float* BETA = (LAS float*)(lds + BETA_OFF); LAS float* EM = (LAS float*)(lds + EM_OFF); LAS float* LAM1 = (LAS float*)(lds + LAM1_OFF);
    { const int lo = (tid >> 3) * CP + (tid & 7) * 16;
#pragma unroll
      for (int i = 0; i < 2; ++i) { *(LAS u32x4*)(LFI + lo + 128 * i) = r.lw[i]; *(LAS u32x4*)(QI + lo + 128 * i) = r.qv[i]; *(LAS u32x4*)(VI + lo + 128 * i) = r.vv[i]; } }
    LDS_BARRIER();
    f32x4 bt[4];
#pragma unroll
    for (int tt = 0; tt < 4; ++tt) {
        f32x4 acc = {0.f, 0.f, 0.f, 0.f};
#pragma unroll
        for (int kk = 0; kk < 2; ++kk) if (32 * kk <= 16 * tt + 15) {
            const bf16x8 a = tr_frag(LFI, kk, 16 * wave, fr, fq);
            const int t = 16 * tt + fr, s0 = 32 * kk + 4 * fq;
            bf16x8 tri;
#pragma unroll
            for (int jj = 0; jj < 8; ++jj) tri[jj] = (s0 + (jj < 4 ? jj : 12 + jj)) <= t ? (short)0x3F80 : (short)0;
            acc = MFMA16(a, tri, acc);
        }
        bt[tt] = acc;
    }
    float bmid[4], em[4];
#pragma unroll
    for (int j = 0; j < 4; ++j) {
        bmid[j] = __shfl(bt[1][j], (lane & 48) | 15);
        const float bend = __shfl(bt[3][j], (lane & 48) | 15);
        em[j] = __expf(bmid[j]);
        const float lam = __expf(bend);
        const int d = 16 * wave + 4 * fq + j;
        if (fr == 0) { BETA[d] = __expf(bend - bmid[j]); if (pos > 0) { EM[d] = em[j]; LAM1[d] = lam; } if (pos == 3) LAM[(size_t)(((unit >> 5) << 3) + ((unit & 31) >> 2)) * 128 + d] = lam0[j] * lam; }
        if (pos > 0) { em[j] *= lam0[j]; lam0[j] *= lam; } else lam0[j] = lam;
    }
#pragma unroll
    for (int tt = 0; tt < 4; ++tt) {
        const int ao = (16 * tt + fr) * CP + (16 * wave + 4 * fq) * 2;
        const u32x2 qw = *(const LAS u32x2*)(QI + ao), lw = *(const LAS u32x2*)(LFI + ao);
        const float qf[4] = {bflo(qw.x), bfhi(qw.x), bflo(qw.y), bfhi(qw.y)};
        const float kf[4] = {1.0f - __expf(bflo(lw.x)), 1.0f - __expf(bfhi(lw.x)), 1.0f - __expf(bflo(lw.y)), 1.0f - __expf(bfhi(lw.y))};
        float qt[4], kt[4], qh[4];
#pragma unroll
        for (int j = 0; j < 4; ++j) { const float e1 = __expf(bt[tt][j] - bmid[j]), e2 = __expf(bmid[j] - bt[tt][j]); qt[j] = qf[j] * e1; kt[j] = kf[j] * e2; qh[j] = qt[j] * em[j]; }
        u32x2 w; w.x = pk2(qt[0], qt[1]); w.y = pk2(qt[2], qt[3]); *(LAS u32x2*)(QI + ao) = w;
        w.x = pk2(kt[0], kt[1]); w.y = pk2(kt[2], kt[3]); *(LAS u32x2*)(KI + ao) = w;
        w.x = pk2(qh[0], qh[1]); w.y = pk2(qh[2], qh[3]); *(u32x2*)(Qo + (row0 + 16 * tt + fr) * DM + h * 128 + 16 * wave + 4 * fq) = w;
    }
    LDS_BARRIER();
}
__device__ __forceinline__ void chunk_stepBC(LAS unsigned char* lds, int unit, const int pos, f32x4 (&ds0)[8], bf16_t* LFo, bf16_t* DS, int wave, int lane) {
    const int c = unit & 31, bh = unit >> 5, h = bh & 7, b = bh >> 3;
    const size_t row0 = (size_t)b * SEQ + (size_t)c * 64;
    const int fr = lane & 15, fq = lane >> 4;
    LAS unsigned char* QI = lds + QI_OFF; LAS unsigned char* KI = lds + KI2_OFF; LAS unsigned char* VI = lds + VI2_OFF;
    LAS bf16_t* AM = (LAS bf16_t*)(lds + AM_OFF); LAS float* BETA = (LAS float*)(lds + BETA_OFF); LAS float* EM = (LAS float*)(lds + EM_OFF); LAS float* LAM1 = (LAS float*)(lds + LAM1_OFF);
#pragma unroll
    for (int ii = 0; ii < 2; ++ii) {
        const int idx = 2 * wave + ii, st = idx >> 2, tt = idx & 3;
        f32x4 acc = {0.f, 0.f, 0.f, 0.f};
        if (st <= tt) {
#pragma unroll
            for (int kk = 0; kk < 4; ++kk) {
                const bf16x8 a = *(const LAS bf16x8*)(KI + (16 * st + fr) * CP + (32 * kk + 8 * fq) * 2);
                const bf16x8 bq = *(const LAS bf16x8*)(QI + (16 * tt + fr) * CP + (32 * kk + 8 * fq) * 2);
                acc = MFMA16(a, bq, acc);
            }
        }
        const int t = 16 * tt + fr, s0 = 16 * st + 4 * fq;
        float m0 = (s0 + 0 <= t) ? acc[0] : 0.f, m1 = (s0 + 1 <= t) ? acc[1] : 0.f, m2 = (s0 + 2 <= t) ? acc[2] : 0.f, m3 = (s0 + 3 <= t) ? acc[3] : 0.f;
        u32x2 w; w.x = pk2(m0, m1); w.y = pk2(m2, m3);
        *(LAS u32x2*)(AM + t * 72 + s0) = w;
    }
    LDS_BARRIER();
    bf16x8 va[2];
#pragma unroll
    for (int kk = 0; kk < 2; ++kk) va[kk] = tr_frag(VI, kk, 16 * wave, fr, fq);
    bf16x8 sf[4];
    if (pos > 0) {
#pragma unroll
        for (int kk = 0; kk < 4; ++kk) {
            const f32x4 e0 = *(const LAS f32x4*)(EM + 32 * kk + 4 * fq), e1 = *(const LAS f32x4*)(EM + 32 * kk + 16 + 4 * fq);
            const f32x4 x0 = ds0[2 * kk] * e0, x1 = ds0[2 * kk + 1] * e1;
            u32x4 w; w.x = pk2(x0[0], x0[1]); w.y = pk2(x0[2], x0[3]); w.z = pk2(x1[0], x1[1]); w.w = pk2(x1[2], x1[3]);
            sf[kk] = __builtin_bit_cast(bf16x8, w);
        }
    }
#pragma unroll
    for (int tt = 0; tt < 4; ++tt) {
        f32x4 acc = {0.f, 0.f, 0.f, 0.f};
        if (pos > 0) {
#pragma unroll
            for (int kk = 0; kk < 4; ++kk) {
                const LAS unsigned char* qp = QI + (16 * tt + fr) * CP + (32 * kk + 4 * fq) * 2;
                const u32x2 lo = *(const LAS u32x2*)qp, hi = *(const LAS u32x2*)(qp + 32);
                u32x4 w; w.x = lo.x; w.y = lo.y; w.z = hi.x; w.w = hi.y;
                acc = MFMA16(sf[kk], __builtin_bit_cast(bf16x8, w), acc);
            }
        }
#pragma unroll
        for (int kk = 0; kk < 2; ++kk) {
            const LAS bf16_t* ap = AM + (16 * tt + fr) * 72 + 32 * kk + 4 * fq;
            const u32x2 lo = *(const LAS u32x2*)ap, hi = *(const LAS u32x2*)(ap + 16);
            u32x4 w; w.x = lo.x; w.y = lo.y; w.z = hi.x; w.w = hi.y;
            acc = MFMA16(va[kk], __builtin_bit_cast(bf16x8, w), acc);
        }
        { u32x2 wo; wo.x = pk2(acc[0], acc[1]); wo.y = pk2(acc[2], acc[3]); *(u32x2*)(LFo + (row0 + 16 * tt + fr) * DM + h * 128 + 16 * wave + 4 * fq) = wo; }
    }
#pragma unroll
    for (int dt = 0; dt < 8; ++dt) {
        f32x4 acc = {0.f, 0.f, 0.f, 0.f};
#pragma unroll
        for (int kk = 0; kk < 2; ++kk) { const bf16x8 ak = tr_frag(KI, kk, 16 * dt, fr, fq); acc = MFMA16(ak, va[kk], acc); }
        const f32x4 be = *(const LAS f32x4*)(BETA + 16 * dt + 4 * fq);
        acc *= be;
        if (pos > 0) acc += ds0[dt] * *(const LAS f32x4*)(LAM1 + 16 * dt + 4 * fq);
        if (pos == 3) {
            u32x2 w; w.x = pk2(acc[0], acc[1]); w.y = pk2(acc[2], acc[3]);
            *(u32x2*)(DS + (((size_t)(((unit >> 5) << 3) + ((unit & 31) >> 2)) * 64 + dt * 8 + wave) * 64 + lane) * 4) = w;
        } else ds0[dt] = acc;
    }
    LDS_BARRIER();
}

constexpr int C2_SETB = 65536, C2_QI = 0, C2_KI = 18432, C2_VI = 36864, C2_AM = 55296, C2_AMP = 80, C2_SM0 = 150016, C2_SM1 = 151552, C2_LFI = 131584;
__device__ __forceinline__ LAS unsigned char* c2_set(LAS unsigned char* lds, int s) { return lds + s * C2_SETB; }
__device__ __forceinline__ LAS float* c2_small(LAS unsigned char* lds, int s) { return (LAS float*)(lds + (s ? C2_SM1 : C2_SM0)); }
__device__ __forceinline__ void chunk_A1(LAS unsigned char* lds, int s, const ChunkIn& r, const int tid) {
    LAS unsigned char* sb = c2_set(lds, s); LAS unsigned char* LFI = lds + C2_LFI;
    const int lo = (tid >> 3) * CP + (tid & 7) * 16;
#pragma unroll
    for (int i = 0; i < 2; ++i) { *(LAS u32x4*)(LFI + lo + 128 * i) = r.lw[i]; *(LAS u32x4*)(sb + C2_QI + lo + 128 * i) = r.qv[i]; *(LAS u32x4*)(sb + C2_VI + lo + 128 * i) = r.vv[i]; }
}
__device__ __forceinline__ void chunk_A2(LAS unsigned char* lds, int s, int unit, const int pos, float (&lam0)[4], bf16_t* Qo, float* LAM, int wave, int lane) {
    const int c = unit & 31, bh = unit >> 5, h = bh & 7, b = bh >> 3;
    const size_t row0 = (size_t)b * SEQ + (size_t)c * 64;
    const int fr = lane & 15, fq = lane >> 4;
    LAS unsigned char* sb = c2_set(lds, s); LAS unsigned char* LFI = lds + C2_LFI; LAS unsigned char* QI = sb + C2_QI; LAS unsigned char* KI = sb + C2_KI;
    LAS float* BETA = c2_small(lds, s); LAS float* EM = BETA + 128; LAS float* LAM1 = BETA + 256;
    f32x4 bt[4];
#pragma unroll
    for (int tt = 0; tt < 4; ++tt) {
        f32x4 acc = {0.f, 0.f, 0.f, 0.f};
#pragma unroll
        for (int kk = 0; kk < 2; ++kk) if (32 * kk <= 16 * tt + 15) {
            const bf16x8 a = tr_frag(LFI, kk, 16 * wave, fr, fq);
            const int t = 16 * tt + fr, s0 = 32 * kk + 4 * fq;
            bf16x8 tri;
#pragma unroll
            for (int jj = 0; jj < 8; ++jj) tri[jj] = (s0 + (jj < 4 ? jj : 12 + jj)) <= t ? (short)0x3F80 : (short)0;
            acc = MFMA16(a, tri, acc);
        }
        bt[tt] = acc;
    }
    float bmid[4], em[4];
#pragma unroll
    for (int j = 0; j < 4; ++j) {
        bmid[j] = __shfl(bt[1][j], (lane & 48) | 15);
        const float bend = __shfl(bt[3][j], (lane & 48) | 15);
        em[j] = __builtin_amdgcn_exp2f(bmid[j]);
        const float lam = __builtin_amdgcn_exp2f(bend);
        const int d = 16 * wave + 4 * fq + j;
        if (fr == 0) { BETA[d] = __builtin_amdgcn_exp2f(bend - bmid[j]); if (pos > 0) { EM[d] = em[j]; LAM1[d] = lam; } if (pos == 3) LAM[(size_t)(((unit >> 5) << 3) + ((unit & 31) >> 2)) * 128 + d] = lam0[j] * lam; }
        if (pos > 0) { em[j] *= lam0[j]; lam0[j] *= lam; } else lam0[j] = lam;
    }
#pragma unroll
    for (int tt = 0; tt < 4; ++tt) {
        const int ao = (16 * tt + fr) * CP + (16 * wave + 4 * fq) * 2;
        const u32x2 qw = *(const LAS u32x2*)(QI + ao), lw = *(const LAS u32x2*)(LFI + ao);
        const float qf[4] = {bflo(qw.x), bfhi(qw.x), bflo(qw.y), bfhi(qw.y)};
        const float kf[4] = {1.0f - __builtin_amdgcn_exp2f(bflo(lw.x)), 1.0f - __builtin_amdgcn_exp2f(bfhi(lw.x)), 1.0f - __builtin_amdgcn_exp2f(bflo(lw.y)), 1.0f - __builtin_amdgcn_exp2f(bfhi(lw.y))};
        float qt[4], kt[4], qh[4];
#pragma unroll
        for (int j = 0; j < 4; ++j) { const float e1 = __builtin_amdgcn_exp2f(bt[tt][j] - bmid[j]), e2 = __builtin_amdgcn_exp2f(bmid[j] - bt[tt][j]); qt[j] = qf[j] * e1; kt[j] = kf[j] * e2; qh[j] = qt[j] * em[j]; }
        u32x2 w; w.x = pk2(qt[0], qt[1]); w.y = pk2(qt[2], qt[3]); *(LAS u32x2*)(QI + ao) = w;
        w.x = pk2(kt[0], kt[1]); w.y = pk2(kt[2], kt[3]); *(LAS u32x2*)(KI + ao) = w;
        w.x = pk2(qh[0], qh[1]); w.y = pk2(qh[2], qh[3]); *(u32x2*)(Qo + (row0 + 16 * tt + fr) * DM + h * 128 + 16 * wave + 4 * fq) = w;
    }
}
__device__ __forceinline__ void chunk_B(LAS unsigned char* lds, int s, int wave, int lane) {
    const int fr = lane & 15, fq = lane >> 4;
    LAS unsigned char* sb = c2_set(lds, s); LAS unsigned char* QI = sb + C2_QI; LAS unsigned char* KI = sb + C2_KI; LAS bf16_t* AM = (LAS bf16_t*)(sb + C2_AM);
    bf16x8 ka[2][4], qa[2][4];
#pragma unroll
    for (int ii = 0; ii < 2; ++ii) {
        const int idx = 2 * wave + ii, st = idx >> 2, tt = idx & 3;
#pragma unroll
        for (int kk = 0; kk < 4; ++kk) {
            ka[ii][kk] = *(const LAS bf16x8*)(KI + (16 * st + fr) * CP + (32 * kk + 8 * fq) * 2);
            qa[ii][kk] = *(const LAS bf16x8*)(QI + (16 * tt + fr) * CP + (32 * kk + 8 * fq) * 2);
        }
    }
    __builtin_amdgcn_sched_barrier(0);
    f32x4 acc[2] = {{0.f, 0.f, 0.f, 0.f}, {0.f, 0.f, 0.f, 0.f}};
#pragma unroll
    for (int kk = 0; kk < 4; ++kk)
#pragma unroll
        for (int ii = 0; ii < 2; ++ii) acc[ii] = MFMA16(ka[ii][kk], qa[ii][kk], acc[ii]);
#pragma unroll
    for (int ii = 0; ii < 2; ++ii) {
        const int idx = 2 * wave + ii, st = idx >> 2, tt = idx & 3;
        const int t = 16 * tt + fr, s0 = 16 * st + 4 * fq;
        float m0 = (s0 + 0 <= t) ? acc[ii][0] : 0.f, m1 = (s0 + 1 <= t) ? acc[ii][1] : 0.f, m2 = (s0 + 2 <= t) ? acc[ii][2] : 0.f, m3 = (s0 + 3 <= t) ? acc[ii][3] : 0.f;
        u32x2 w; w.x = pk2(m0, m1); w.y = pk2(m2, m3);
        *(LAS u32x2*)(AM + t * C2_AMP + 32 * (st >> 1) + 8 * fq + 4 * (st & 1)) = w;
    }
}
template <int POS>
__device__ __forceinline__ void chunk_C(LAS unsigned char* lds, int s, int unit, f32x4 (&ds0)[8], bf16_t* LFo, bf16_t* DS, int wave, int lane) {
    const int c = unit & 31, bh = unit >> 5, h = bh & 7, b = bh >> 3;
    const size_t row0 = (size_t)b * SEQ + (size_t)c * 64;
    const int fr = lane & 15, fq = lane >> 4;
    LAS unsigned char* sb = c2_set(lds, s); LAS unsigned char* QI = sb + C2_QI; LAS unsigned char* KI = sb + C2_KI; LAS unsigned char* VI = sb + C2_VI; LAS bf16_t* AM = (LAS bf16_t*)(sb + C2_AM);
    LAS float* BETA = c2_small(lds, s); LAS float* EM = BETA + 128; LAS float* LAM1 = BETA + 256;
    bf16x8 va[2];
#pragma unroll
    for (int kk = 0; kk < 2; ++kk) va[kk] = tr_frag(VI, kk, 16 * wave, fr, fq);
    bf16x8 sf[4];
    if constexpr (POS > 0) {
        f32x4 ev[8];
#pragma unroll
        for (int i = 0; i < 8; ++i) ev[i] = *(const LAS f32x4*)(EM + 16 * i + 4 * fq);
#pragma unroll
        for (int kk = 0; kk < 4; ++kk) {
            const f32x4 x0 = ds0[2 * kk] * ev[2 * kk], x1 = ds0[2 * kk + 1] * ev[2 * kk + 1];
            u32x4 w; w.x = pk2(x0[0], x0[1]); w.y = pk2(x0[2], x0[3]); w.z = pk2(x1[0], x1[1]); w.w = pk2(x1[2], x1[3]);
            sf[kk] = __builtin_bit_cast(bf16x8, w);
        }
    }
#pragma unroll
    for (int tp = 0; tp < 2; ++tp) {
        u32x4 qf[2][4], af[2][2];
#pragma unroll
        for (int t2 = 0; t2 < 2; ++t2) {
            const int tt = 2 * tp + t2;
            if constexpr (POS > 0) {
#pragma unroll
                for (int kk = 0; kk < 4; ++kk) {
                    const LAS unsigned char* qp = QI + (16 * tt + fr) * CP + (32 * kk + 4 * fq) * 2;
                    const u32x2 lo = *(const volatile LAS u32x2*)qp, hi = *(const volatile LAS u32x2*)(qp + 32);
                    qf[t2][kk] = (u32x4){lo.x, lo.y, hi.x, hi.y};
                }
            }
#pragma unroll
            for (int kk = 0; kk < 2; ++kk) {
                af[t2][kk] = *(const LAS u32x4*)(AM + (16 * tt + fr) * C2_AMP + 32 * kk + 8 * fq);
            }
        }
        __builtin_amdgcn_sched_barrier(0);
#pragma unroll
        for (int t2 = 0; t2 < 2; ++t2) {
            const int tt = 2 * tp + t2;
            f32x4 acc = {0.f, 0.f, 0.f, 0.f};
            if constexpr (POS > 0) {
#pragma unroll
                for (int kk = 0; kk < 4; ++kk) acc = MFMA16(sf[kk], __builtin_bit_cast(bf16x8, qf[t2][kk]), acc);
            }
#pragma unroll
            for (int kk = 0; kk < 2; ++kk) acc = MFMA16(va[kk], __builtin_bit_cast(bf16x8, af[t2][kk]), acc);
            u32x2 wo; wo.x = pk2(acc[0], acc[1]); wo.y = pk2(acc[2], acc[3]); *(u32x2*)(LFo + (row0 + 16 * tt + fr) * DM + h * 128 + 16 * wave + 4 * fq) = wo;
        }
    }
#pragma unroll
    for (int dq = 0; dq < 2; ++dq) {
        bf16x8 kfr[4][2]; f32x4 be[4], l1[4];
#pragma unroll
        for (int d4 = 0; d4 < 4; ++d4) {
            const int dt = 4 * dq + d4;
#pragma unroll
            for (int kk = 0; kk < 2; ++kk) kfr[d4][kk] = tr_frag(KI, kk, 16 * dt, fr, fq);
            be[d4] = *(const LAS f32x4*)(BETA + 16 * dt + 4 * fq);
            if constexpr (POS > 0) l1[d4] = *(const LAS f32x4*)(LAM1 + 16 * dt + 4 * fq);
        }
        __builtin_amdgcn_sched_barrier(0);
#pragma unroll
        for (int d4 = 0; d4 < 4; ++d4) {
            const int dt = 4 * dq + d4;
            f32x4 acc = {0.f, 0.f, 0.f, 0.f};
#pragma unroll
            for (int kk = 0; kk < 2; ++kk) acc = MFMA16(kfr[d4][kk], va[kk], acc);
            acc *= be[d4];
            if constexpr (POS > 0) acc += ds0[dt] * l1[d4];
            if constexpr (POS == 3) {
                u32x2 w; w.x = pk2(acc[0], acc[1]); w.y = pk2(acc[2], acc[3]);
                *(u32x2*)(DS + (((size_t)(((unit >> 5) << 3) + ((unit & 31) >> 2)) * 64 + dt * 8 + wave) * 64 + lane) * 4) = w;
            } else ds0[dt] = acc;
        }
    }
}

__device__ __forceinline__ void hgrn_scan_phase(const bf16_t* DS, bf16_t* SCo, const float* LAM, float* stp_layer, int gt, int ngt) {
    for (int item = gt; item < 64 * 4096; item += ngt) {
        const int bh = item >> 12, tl = item & 4095, tile = tl >> 6, ln = tl & 63, dt = tile >> 3, et = tile & 7, fq = ln >> 4, fr = ln & 15;
        float S0 = 0.f, S1 = 0.f, S2 = 0.f, S3 = 0.f;
        const size_t boff = ((size_t)bh * 32768 + tile * 64 + ln) * 4;
        const float* lbase = LAM + (size_t)bh * 8 * 128 + 16 * dt + 4 * fq;
#pragma unroll 1
        for (int c0 = 0; c0 < 8; c0 += 8) {
            u32x2 dw[8]; f32x4 lam[8];
#pragma unroll
            for (int j = 0; j < 8; ++j) { dw[j] = *(const u32x2*)(DS + boff + (size_t)(c0 + j) * 16384); lam[j] = *(const f32x4*)(lbase + (c0 + j) * 128); }
#pragma unroll
            for (int j = 0; j < 8; ++j) {
                u32x2 sc; sc.x = pk2(S0, S1); sc.y = pk2(S2, S3); *(u32x2*)(SCo + boff + (size_t)(c0 + j) * 16384) = sc;
                S0 = S0 * lam[j].x + bflo(dw[j].x); S1 = S1 * lam[j].y + bfhi(dw[j].x); S2 = S2 * lam[j].z + bflo(dw[j].y); S3 = S3 * lam[j].w + bfhi(dw[j].y);
            }
        }
        float* o = stp_layer + (size_t)bh * 16384 + (size_t)(16 * dt + 4 * fq) * 128 + 16 * et + fr;
        o[0] = S0; o[128] = S1; o[256] = S2; o[384] = S3;
    }
}

struct InterIn { u32x4 q[2], o[2], g[2]; };
struct InterSc { u32x2 sc[8]; };
__device__ __forceinline__ void inter_load(InterIn& r, int unit, const bf16_t* Q, const bf16_t* OI, const bf16_t* G, const bf16_t* SC, int wave, int lane, const int tid) {
    const int c = unit & 31, bh = unit >> 5, h = bh & 7, b = bh >> 3;
    const size_t g0 = ((size_t)b * SEQ + (size_t)c * 64 + (tid >> 3)) * DM + h * 128 + (tid & 7) * 8;
#pragma unroll
    for (int i = 0; i < 2; ++i) { r.q[i] = *(const u32x4*)(Q + g0 + 64 * i); r.o[i] = *(const u32x4*)(OI + g0 + 64 * i); r.g[i] = *(const u32x4*)(G + g0 + 64 * i); }
}
__device__ __forceinline__ void inter_load_sc(InterSc& s, int unit, const bf16_t* SC, int wave, int lane) {
    const size_t su = (size_t)(((unit >> 5) << 3) + ((unit & 31) >> 2));
#pragma unroll
    for (int dt = 0; dt < 8; ++dt) s.sc[dt] = *(const u32x2*)(SC + ((su * 64 + dt * 8 + wave) * 64 + lane) * 4);
}
__device__ __forceinline__ void quad_prefix(LAS unsigned char* lds, InterSc& sc0, InterSc& sc1, int bh0, int bh1, int qp, const bf16_t* DS, const float* LAM, float* stp_layer, int wave, int lane, const int tid) {
    LAS float* lam_l = (LAS float*)lds;
    const int last_bh = qp == 7 ? bh0 : (qp == 0 ? bh1 : -1);
#define QP_SU(i_) ((i_) < 7 ? ((i_) < qp ? bh0 * 8 + (i_) : bh1 * 8 + (i_) - qp) : (last_bh >= 0 ? last_bh * 8 + 7 : bh1 * 8 + 6 - qp + (qp == 7 ? 8 * (bh0 - bh1) + 7 : 0)))
#pragma unroll
    for (int r = 0; r < 2; ++r) { const int v = tid + 512 * r, i = v >> 7, d = v & 127; lam_l[v] = LAM[(size_t)QP_SU(i) * 128 + d]; }
#define QP_LOAD(dst, i_) do { const size_t su_ = (size_t)QP_SU(i_); _Pragma("unroll") for (int dt = 0; dt < 8; ++dt) dst.sc[dt] = *(const u32x2*)(DS + ((su_ * 64 + dt * 8 + wave) * 64 + lane) * 4); } while (0)
    InterSc dq[8];
#pragma unroll
    for (int i = 0; i < 8; ++i) QP_LOAD(dq[i], i);
    __syncthreads();
    const int fq = lane >> 4, fr = lane & 15;
    f32x4 S[8];
#pragma unroll
    for (int dt = 0; dt < 8; ++dt) { S[dt] = (f32x4){0.f, 0.f, 0.f, 0.f}; sc0.sc[dt].x = 0u; sc0.sc[dt].y = 0u; }
#pragma unroll
    for (int i = 0; i < 7; ++i) {
        if (i == qp) {
#pragma unroll
            for (int dt = 0; dt < 8; ++dt) { sc0.sc[dt].x = pk2(S[dt][0], S[dt][1]); sc0.sc[dt].y = pk2(S[dt][2], S[dt][3]); S[dt] = (f32x4){0.f, 0.f, 0.f, 0.f}; }
        }
#pragma unroll
        for (int dt = 0; dt < 8; ++dt) { const f32x4 lm = *(const LAS f32x4*)(lam_l + i * 128 + 16 * dt + 4 * fq);
            S[dt] = S[dt] * lm + (f32x4){bflo(dq[i].sc[dt].x), bfhi(dq[i].sc[dt].x), bflo(dq[i].sc[dt].y), bfhi(dq[i].sc[dt].y)}; }
    }
#pragma unroll
    for (int dt = 0; dt < 8; ++dt) {
        const unsigned wx = pk2(S[dt][0], S[dt][1]), wy = pk2(S[dt][2], S[dt][3]);
        if (qp == 7) { sc0.sc[dt].x = wx; sc0.sc[dt].y = wy; sc1.sc[dt].x = 0u; sc1.sc[dt].y = 0u; } else { sc1.sc[dt].x = wx; sc1.sc[dt].y = wy; }
    }
    if (last_bh >= 0) {
        float* o = stp_layer + (size_t)last_bh * 16384 + 16 * wave + fr;
#pragma unroll
        for (int dt = 0; dt < 8; ++dt) { const f32x4 lm = *(const LAS f32x4*)(lam_l + 7 * 128 + 16 * dt + 4 * fq);
            const f32x4 e = S[dt] * lm + (f32x4){bflo(dq[7].sc[dt].x), bfhi(dq[7].sc[dt].x), bflo(dq[7].sc[dt].y), bfhi(dq[7].sc[dt].y)};
#pragma unroll
            for (int r = 0; r < 4; ++r) o[(size_t)(16 * dt + 4 * fq + r) * 128] = e[r]; }
    }
#undef QP_SU
#undef QP_LOAD
    __syncthreads();
}
__device__ __forceinline__ void inter_compute(LAS unsigned char* lds, int unit, int par, const InterIn& r, const InterSc& s, bf16_t* Qo, int wave, int lane, const int tid) {
    const int c = unit & 31, bh = unit >> 5, h = bh & 7, b = bh >> 3, fr = lane & 15, fq = lane >> 4;
    LAS bf16_t* QH = (LAS bf16_t*)(lds + par * 52224); LAS bf16_t* OT = QH + 8704; LAS bf16_t* GT = OT + 8704;
    LAS float* red = (LAS float*)(lds + 104448 + par * 2048);
    const int so = (tid >> 3) * 136 + (tid & 7) * 8;
#pragma unroll
    for (int i = 0; i < 2; ++i) { *(LAS u32x4*)(QH + so + 64 * i) = r.q[i]; *(LAS u32x4*)(OT + so + 64 * i) = r.o[i]; *(LAS u32x4*)(GT + so + 64 * i) = r.g[i]; }
    LDS_BARRIER();
    f32x4 o[4];
#pragma unroll
    for (int tt = 0; tt < 4; ++tt) { const u32x2 ow = *(const LAS u32x2*)(OT + (16 * tt + fr) * 136 + 16 * wave + 4 * fq); o[tt] = (f32x4){bflo(ow.x), bfhi(ow.x), bflo(ow.y), bfhi(ow.y)}; }
#pragma unroll
    for (int k2 = 0; k2 < 4; k2 += 2) {
        u32x4 qfr[2][4];
#pragma unroll
        for (int i = 0; i < 2; ++i)
#pragma unroll
            for (int tt = 0; tt < 4; ++tt) {
                const LAS bf16_t* qp = QH + (16 * tt + fr) * 136 + 32 * (k2 + i) + 4 * fq;
                const u32x2 lo = *(const volatile LAS u32x2*)qp, hi = *(const volatile LAS u32x2*)(qp + 16);
                qfr[i][tt] = (u32x4){lo.x, lo.y, hi.x, hi.y};
            }
        __builtin_amdgcn_sched_barrier(0);
#pragma unroll
        for (int i = 0; i < 2; ++i) {
            const int kk = k2 + i;
            u32x4 aw; aw.x = s.sc[2 * kk].x; aw.y = s.sc[2 * kk].y; aw.z = s.sc[2 * kk + 1].x; aw.w = s.sc[2 * kk + 1].y;
            const bf16x8 af = __builtin_bit_cast(bf16x8, aw);
#pragma unroll
            for (int tt = 0; tt < 4; ++tt) o[tt] = MFMA16(af, __builtin_bit_cast(bf16x8, qfr[i][tt]), o[tt]);
        }
        __builtin_amdgcn_sched_barrier(0);
    }
#pragma unroll
    for (int tt = 0; tt < 4; ++tt) {
        float p = (o[tt][0] * o[tt][0] + o[tt][1] * o[tt][1]) + (o[tt][2] * o[tt][2] + o[tt][3] * o[tt][3]);
        p += __shfl_xor(p, 16); p += __shfl_xor(p, 32);
        if (fq == 0) red[wave * 64 + 16 * tt + fr] = p;
    }
    LDS_BARRIER();
#pragma unroll
    for (int tt = 0; tt < 4; ++tt) {
        float tot = 0.f;
#pragma unroll
        for (int w2 = 0; w2 < 8; ++w2) tot += red[w2 * 64 + 16 * tt + fr];
        const float rs = rsqrtf(tot * (1.0f / 128.0f) + NORM_EPS);
        const int po = (16 * tt + fr) * 136 + 16 * wave + 4 * fq;
        const u32x2 gw = *(const LAS u32x2*)(GT + po);
        u32x2 w; w.x = pk2(o[tt][0] * rs * bflo(gw.x), o[tt][1] * rs * bfhi(gw.x)); w.y = pk2(o[tt][2] * rs * bflo(gw.y), o[tt][3] * rs * bfhi(gw.y));
        *(LAS u32x2*)(OT + po) = w;
    }
    LDS_BARRIER();
    const size_t g0 = ((size_t)b * SEQ + (size_t)c * 64 + (tid >> 3)) * DM + h * 128 + (tid & 7) * 8;
#pragma unroll
    for (int i = 0; i < 2; ++i) *(u32x4*)(Qo + g0 + 64 * i) = *(const LAS u32x4*)(OT + so + 64 * i);
}

struct SampleIn { f32x4 sv[4]; u32x2 vw; bf16_t q, lf, g; };
__device__ __forceinline__ void sample_load(SampleIn& r, int unit, int half, const bf16_t* Q, const bf16_t* Kb, const bf16_t* LF, const bf16_t* V, const bf16_t* G, const float* s0, const int tid) {
    const int n = unit >> 3, h = unit & 7;
    const size_t rb = (size_t)(TP + n) * DM + h * 128;
    const int dg = tid >> 5, e4 = (tid & 31) * 4;
#pragma unroll
    for (int dd = 0; dd < 4; ++dd) r.sv[dd] = __builtin_nontemporal_load((const f32x4*)(s0 + (size_t)(dg * 8 + half * 4 + dd) * 128 + e4));
    r.vw = *(const u32x2*)(V + rb + e4);
    const int t7 = tid & 127;
    r.q = Q[rb + t7]; r.lf = LF[rb + t7]; r.g = G[rb + t7];
}
__device__ __forceinline__ void sample_compute(LAS unsigned char* lds, int unit, int half, const SampleIn& r, bf16_t* Qo, float* s1, const int tid) {
    const int n = unit >> 3, h = unit & 7;
    const size_t rb = (size_t)(TP + n) * DM + h * 128;
    LAS float* qs = (LAS float*)lds; LAS float* ks = qs + 128; LAS float* fs = qs + 256; LAS float* part = qs + 384;
    LAS float* redw = qs + 384 + 4096;
    if (half == 0) {
        if (tid < 128) { const float f = __builtin_amdgcn_exp2f(bf1(r.lf)); qs[tid] = bf1(r.q); ks[tid] = 1.0f - f; fs[tid] = f; }
        LDS_BARRIER();
    }
    const int dg = tid >> 5, e4 = (tid & 31) * 4;
    const f32x4 v4 = {bflo(r.vw.x), bfhi(r.vw.x), bflo(r.vw.y), bfhi(r.vw.y)};
    f32x4 o4 = {0.f, 0.f, 0.f, 0.f};
#pragma unroll
    for (int dd = 0; dd < 4; ++dd) {
        const int d = dg * 8 + half * 4 + dd;
        const f32x4 sn = r.sv[dd] * fs[d] + v4 * ks[d];
        __builtin_nontemporal_store(sn, (f32x4*)(s1 + (size_t)d * 128 + e4));
        o4 += sn * qs[d];
    }
    *(LAS f32x4*)(part + (dg * 2 + half) * 128 + e4) = o4;
    if (half == 1) {
        LDS_BARRIER();
        float o = 0.f;
        if (tid < 128) {
#pragma unroll
            for (int i = 0; i < 32; ++i) o += part[i * 128 + tid];
        }
        float sq = wave_sum(o * o);
        if ((tid & 63) == 0) redw[tid >> 6] = sq;
        LDS_BARRIER();
        if (tid < 128) {
            const float tot = redw[0] + redw[1];
            const float rs = rsqrtf(tot * (1.0f / 128.0f) + NORM_EPS);
            Qo[rb + tid] = (bf16_t)f2bf(o * rs * bf1(r.g));
        }
    }
}

__device__ __forceinline__ void sample_rec_units(LAS unsigned char* lds, unsigned char* ws, const float* st_in, float* st_out, int bx, int G, const int tid) {
    const bf16_t* Qp = (const bf16_t*)(ws + WS_Q); const bf16_t* Kp = (const bf16_t*)(ws + WS_K); const bf16_t* Lp = (const bf16_t*)(ws + WS_LF); const bf16_t* Vp = (const bf16_t*)(ws + WS_V); const bf16_t* Gp = (const bf16_t*)(ws + WS_G);
    bf16_t* Qo = (bf16_t*)(ws + WS_Q);
    SampleIn c0, c1, n0, n1;
    sample_load(c0, bx, 0, Qp, Kp, Lp, Vp, Gp, st_in + (size_t)bx * 16384, tid); sample_load(c1, bx, 1, Qp, Kp, Lp, Vp, Gp, st_in + (size_t)bx * 16384, tid);
#pragma unroll 1
    for (int k = 0; k < 4; ++k) {
        const int su = bx + G * k, sn = k < 3 ? su + G : su;
        sample_load(n0, sn, 0, Qp, Kp, Lp, Vp, Gp, st_in + (size_t)sn * 16384, tid); sample_load(n1, sn, 1, Qp, Kp, Lp, Vp, Gp, st_in + (size_t)sn * 16384, tid);
        sample_compute(lds + 112640, su, 0, c0, Qo, st_out + (size_t)su * 16384, tid);
        sample_compute(lds + 112640, su, 1, c1, Qo, st_out + (size_t)su * 16384, tid);
        c0 = n0; c1 = n1;
    }
    __syncthreads();
}

constexpr int KI_OFF = 0, VI_OFF = 40960, KVP = 160;
template <bool MIDFULL>
__device__ __forceinline__ void attn_core(const LAS unsigned char* KI, const LAS unsigned char* VI, int kt0, const bf16x8 (&qf)[2], int jlo, int jhi, float sink, int fr, int fq, f32x4 (&o)[4]) {
    f32x4 s[9];
    const LAS unsigned char* kb = KI + (16 * kt0 + fr) * KVP + 16 * fq;
#pragma unroll
    for (int x3 = 0; x3 < 9; x3 += 3) {
        bf16x8 ka[3][2];
#pragma unroll
        for (int i = 0; i < 3; ++i)
#pragma unroll
            for (int kk = 0; kk < 2; ++kk) ka[i][kk] = *(const LAS bf16x8*)(kb + (x3 + i) * 16 * KVP + kk * 64);
        __builtin_amdgcn_sched_barrier(0);
#pragma unroll
        for (int i = 0; i < 3; ++i) s[x3 + i] = (f32x4){0.f, 0.f, 0.f, 0.f};
#pragma unroll
        for (int kk = 0; kk < 2; ++kk)
#pragma unroll
            for (int i = 0; i < 3; ++i) s[x3 + i] = MFMA16(ka[i][kk], qf[kk], s[x3 + i]);
        __builtin_amdgcn_sched_barrier(0);
    }
    float mx = sink;
    const int j0 = 16 * kt0 + 4 * fq;
#pragma unroll
    for (int x = 0; x < 9; ++x)
#pragma unroll
        for (int r = 0; r < 4; ++r) {
            float sv = s[x][r];
            if (!MIDFULL || x == 0 || x == 8) { const int j = j0 + 16 * x + r; const bool valid = (j >= jlo) && (j <= jhi); sv = valid ? sv : -1e30f; s[x][r] = sv; }
            mx = fmaxf(mx, sv); }
    mx = fmaxf(mx, __shfl_xor(mx, 16)); mx = fmaxf(mx, __shfl_xor(mx, 32));
    float sum = 0.f;
#pragma unroll
    for (int x = 0; x < 9; ++x)
#pragma unroll
        for (int r = 0; r < 4; ++r) { const float p = __builtin_amdgcn_exp2f(s[x][r] - mx); s[x][r] = p; sum += p; }
    sum += __shfl_xor(sum, 16); sum += __shfl_xor(sum, 32);
    const float inv = fast_rcp(sum + __builtin_amdgcn_exp2f(sink - mx));
    bf16x8 pb[5];
#pragma unroll
    for (int y = 0; y < 5; ++y) {
        u32x4 w; w.x = pk2(s[2 * y][0], s[2 * y][1]); w.y = pk2(s[2 * y][2], s[2 * y][3]);
        if (y < 4) { w.z = pk2(s[2 * y + 1][0], s[2 * y + 1][1]); w.w = pk2(s[2 * y + 1][2], s[2 * y + 1][3]); } else { w.z = 0u; w.w = 0u; }
        pb[y] = __builtin_bit_cast(bf16x8, w);
    }
    const LAS unsigned char* vb = VI + (16 * kt0 + 4 * fq + (fr >> 2)) * KVP + 8 * (fr & 3);
#pragma unroll
    for (int d2 = 0; d2 < 4; d2 += 2) {
        s16x4 lo[2][5], hi[2][4];
#pragma unroll
        for (int i = 0; i < 2; ++i)
#pragma unroll
            for (int y = 0; y < 5; ++y) { lo[i][y] = tr_read(vb + (32 * y) * KVP + 32 * (d2 + i)); if (y < 4) hi[i][y] = tr_read(vb + (32 * y + 16) * KVP + 32 * (d2 + i)); }
        __builtin_amdgcn_sched_barrier(0);
        f32x4 acc[2] = {{0.f, 0.f, 0.f, 0.f}, {0.f, 0.f, 0.f, 0.f}};
#pragma unroll
        for (int y = 0; y < 5; ++y)
#pragma unroll
            for (int i = 0; i < 2; ++i) {
                const s16x4 l = lo[i][y]; s16x4 h = {0, 0, 0, 0}; if (y < 4) h = hi[i][y];
                const bf16x8 a = {l[0], l[1], l[2], l[3], h[0], h[1], h[2], h[3]};
                acc[i] = MFMA16(a, pb[y], acc[i]);
            }
        o[d2] = acc[0] * inv; o[d2 + 1] = acc[1] * inv;
        __builtin_amdgcn_sched_barrier(0);
    }
}

__device__ __forceinline__ void swa_prompt_unit(LAS unsigned char* lds, int unit, const bf16_t* QA, bf16_t* QAo, const bf16_t* GA, const bf16_t* KA, const bf16_t* VA, const float* sinks, int wave, int lane, const int tid) {
    const int b = unit >> 5, blk = (unit >> 1) & 15, kvh = unit & 1;
    const int R0 = b * SEQ + blk * 128;
    const int fr = lane & 15, fq = lane >> 4;
    LAS unsigned char* KI = lds + KI_OFF; LAS unsigned char* VI = lds + VI_OFF;
    const int hq = kvh * 8 + wave;
    const size_t qbase = (size_t)(R0 + fr) * DM + hq * 64;
    bf16x8 qf[8][2];
#pragma unroll
    for (int qt = 0; qt < 3; ++qt)
#pragma unroll
        for (int kk = 0; kk < 2; ++kk) qf[qt][kk] = *(const bf16x8*)(QA + qbase + (size_t)qt * 16 * DM + 32 * kk + 8 * fq);
#pragma unroll
    for (int i = 0; i < 4; ++i) {
        const int idx = tid + 512 * i, key = idx >> 3, ch = idx & 7;
        u32x4 kk = {0u, 0u, 0u, 0u}, vv = {0u, 0u, 0u, 0u};
        if (blk > 0 || key >= 128) { const size_t g = (size_t)(R0 - 128 + key) * 128 + kvh * 64 + ch * 8; kk = *(const u32x4*)(KA + g); vv = *(const u32x4*)(VA + g); }
        *(LAS u32x4*)(KI + key * KVP + ch * 16) = kk; *(LAS u32x4*)(VI + key * KVP + ch * 16) = vv;
    }
    const float sink = sinks[hq] * 1.4426950408889634f;
    __syncthreads();
#pragma unroll
    for (int qt = 0; qt < 8; ++qt) {
        const size_t idx0 = qbase + (size_t)qt * 16 * DM + 4 * fq;
        u32x2 gw[4];
#pragma unroll
        for (int dt = 0; dt < 4; ++dt) gw[dt] = *(const u32x2*)(GA + idx0 + 16 * dt);
        const int tq = 16 * qt + fr;
        if (qt + 3 < 8) {
#pragma unroll
            for (int kk = 0; kk < 2; ++kk) qf[qt + 3 < 8 ? qt + 3 : 7][kk] = *(const bf16x8*)(QA + qbase + (size_t)(qt + 3) * 16 * DM + 32 * kk + 8 * fq);
        }
        f32x4 o[4];
        if (blk > 0) attn_core<true>(KI, VI, qt, qf[qt], tq, tq + 128, sink, fr, fq, o);
        else attn_core<false>(KI, VI, qt, qf[qt], tq > 128 ? tq : 128, tq + 128, sink, fr, fq, o);
#pragma unroll
        for (int dt = 0; dt < 4; ++dt) {
            u32x2 w; w.x = pk2(o[dt][0] * bflo(gw[dt].x), o[dt][1] * bfhi(gw[dt].x)); w.y = pk2(o[dt][2] * bflo(gw[dt].y), o[dt][3] * bfhi(gw[dt].y));
            *(u32x2*)(QAo + idx0 + 16 * dt) = w;
        }
    }
    __syncthreads();
}

__device__ __forceinline__ void swa_sample_unit(LAS unsigned char* lds, int unit, const bf16_t* QA, bf16_t* QAo, const bf16_t* GA, const bf16_t* KA, const bf16_t* VA, const float* ck, const float* cv, const float* sinks, int wave, int lane, const int tid) {
    const int n = unit >> 1, kvh = unit & 1;
    const size_t row = (size_t)(TP + n);
    const int fr = lane & 15, fq = lane >> 4;
    LAS unsigned char* KI = lds + KI_OFF; LAS unsigned char* VI = lds + VI_OFF;
    const int hq = kvh * 8 + (fr & 7);
    bf16x8 qf[2];
#pragma unroll
    for (int kk = 0; kk < 2; ++kk) qf[kk] = *(const bf16x8*)(QA + row * DM + hq * 64 + 32 * kk + 8 * fq);
#pragma unroll
    for (int i = 0; i < 3; ++i) {
        const int idx = tid + 512 * i, key = idx >> 3, ch = idx & 7;
        if (key < 144) {
            u32x4 kk = {0u, 0u, 0u, 0u}, vv = {0u, 0u, 0u, 0u};
            if (key < 128) {
                const size_t g = ((size_t)(n * 128 + key) * 2 + kvh) * 64 + ch * 8;
                const f32x4 k0 = *(const f32x4*)(ck + g), k1 = *(const f32x4*)(ck + g + 4), v0 = *(const f32x4*)(cv + g), v1 = *(const f32x4*)(cv + g + 4);
                kk.x = pk2(k0.x, k0.y); kk.y = pk2(k0.z, k0.w); kk.z = pk2(k1.x, k1.y); kk.w = pk2(k1.z, k1.w);
                vv.x = pk2(v0.x, v0.y); vv.y = pk2(v0.z, v0.w); vv.z = pk2(v1.x, v1.y); vv.w = pk2(v1.z, v1.w);
            } else if (key == 128) { const size_t g = row * 128 + kvh * 64 + ch * 8; kk = *(const u32x4*)(KA + g); vv = *(const u32x4*)(VA + g); }
            *(LAS u32x4*)(KI + key * KVP + ch * 16) = kk; *(LAS u32x4*)(VI + key * KVP + ch * 16) = vv;
        }
    }
    const float sink = sinks[hq] * 1.4426950408889634f;
    __syncthreads();
    if (wave == 0) {
        const size_t idx0 = row * DM + hq * 64 + 4 * fq;
        u32x2 gw[4];
#pragma unroll
        for (int dt = 0; dt < 4; ++dt) gw[dt] = *(const u32x2*)(GA + idx0 + 16 * dt);
        f32x4 o[4];
        attn_core<false>(KI, VI, 0, qf, 0, 128, sink, fr, fq, o);
        if (fr < 8) {
#pragma unroll
            for (int dt = 0; dt < 4; ++dt) {
                u32x2 w; w.x = pk2(o[dt][0] * bflo(gw[dt].x), o[dt][1] * bfhi(gw[dt].x)); w.y = pk2(o[dt][2] * bflo(gw[dt].y), o[dt][3] * bfhi(gw[dt].y));
                *(u32x2*)(QAo + idx0 + 16 * dt) = w;
            }
        }
    }
    __syncthreads();
}

__global__ void __launch_bounds__(NWAVES * 64, 2) yoco_fwd(Args args) {
    extern __shared__ __attribute__((aligned(16))) unsigned char lds_raw[];
    LAS unsigned char* lds = (LAS unsigned char*)lds_raw;
    volatile LAS unsigned* MISC = (volatile LAS unsigned*)(lds + MISC_OFF);
    const int G = gridDim.x, bx = blockIdx.x;
    { const int tid = threadIdx.x;
      for (int u = tid; u < (LDS_BYTES - LDSCTL_OFF) / 4; u += NWAVES * 64) ((LAS unsigned*)(lds + LDSCTL_OFF))[u] = 0u; }
    __syncthreads();
    XcdBarrier bar = xcd_barrier_post(g_barrier_words, MISC + 8);
    const int lo = args.ph_lo, hi = args.ph_hi;
#define IN(k) (lo <= (k) && (k) < hi)
#define SEAM(k) do { if (IN(k) && IN((k) + 1)) { for (int rep = 0; rep < NREP(9); ++rep) xcd_barrier(bar); } } while (0)
#define PHASE_LOCALS() KArgPtr ap = kargs(); unsigned char* ws = ap->ws; const int tid = fresh_tid(), lane = tid & 63, wave = __builtin_amdgcn_readfirstlane(tid >> 6); (void)lane; (void)wave; (void)ws

    if (IN(0)) { for (int rep = 0; rep < NREP(0); ++rep) { PHASE_LOCALS(); p0_prologue(ap, lds, wave, lane); } }
    SEAM(0);

#define S_IN_A(l_)  do { EpiHgrnIn Es{ws, (l_), (const LAS float*)(lds + RSTD_OFF)}; const bf16_t* Bs = (const bf16_t*)(ws + ((l_) == 0 ? WS_WIN0 : WS_WIN1)); \
        for (int u = bx; u < 256; u += G) sgemm_unit<64, 32>(lds, (const bf16_t*)(ws + WS_HB) + (size_t)TP * DM, Bs, u, Es, wave, lane, tid); } while (0)
#define S_OUT(WOFF, u0_, ustep_) do { EpiResid Es{ws}; const bf16_t* Bs = (const bf16_t*)(ws + (WOFF)); \
        for (int u = (u0_); u < 256; u += (ustep_)) sgemm_unit<32, 16>(lds, (const bf16_t*)(ws + WS_Q) + (size_t)TP * DM, Bs, u, Es, wave, lane, tid); } while (0)
#define S_STEP(l_)  sample_rec_units(lds, ws, ap->in[2] + (size_t)(l_) * 1024 * 16384, ap->out + O_STS + (size_t)(l_) * 1024 * 16384, bx, G, tid)
#define S_ATTN(j_)  do { const float* sk = ap->in[14] + (j_) * 16; \
        for (int u = bx; u < 256; u += G) swa_sample_unit(lds, u, (const bf16_t*)(ws + WS_Q), (bf16_t*)(ws + WS_Q), (const bf16_t*)(ws + WS_G), (const bf16_t*)(ws + WS_KA), (const bf16_t*)(ws + WS_VA), ap->in[3], ap->in[4], sk, wave, lane, tid); } while (0)

#pragma unroll 1
    for (int l = 0; l < 2; ++l) {
        const int pb = 1 + 5 * l;
        if (IN(pb)) {
            PHASE_LOCALS();
            const bf16_t* Bt = (const bf16_t*)(ws + (l == 0 ? WS_WIN0 : WS_WIN1));
            const int vcu = (bx & 7) * (G >> 3) + (bx >> 3);
            pg8::Gemm g{(const bf16_t*)(ws + WS_HB), Bt, TP, 4096, 1024}; pg8::HeadPairOrder S; S.pm = vcu >> 2; S.hp = vcu & 3; S.rot = (vcu >> 5) & 3; { int n4 = 4; asm volatile("" : "+s"(n4)); S.nu = n4; }
            EpiHgrnIn E{ws, l, (const LAS float*)(lds + RSTD_OFF)};
            stage_row_tables(ws, S.pm, lds, false, tid);
            S_IN_A(l);
            pg8::gemm_phase<EpiHgrnIn, pg8::HeadPairOrder, PG8_ALIGN, PG8_SP2>(lds + RING_OFF, g, S, E, tid);
        }
        if (IN(pb)) {
            PHASE_LOCALS();
            __syncthreads();
            const int vcu = (bx & 7) * (G >> 3) + (bx >> 3);
            const int pm_ = vcu >> 2, hp_ = vcu & 3, bq = pm_ >> 3, c0 = 4 * (pm_ & 7);
            const bf16_t* Qp = (const bf16_t*)(ws + WS_Q); const bf16_t* Kp = (const bf16_t*)(ws + WS_K); const bf16_t* Lp = (const bf16_t*)(ws + WS_LF); const bf16_t* Vp = (const bf16_t*)(ws + WS_V);
            {
                ChunkIn r; f32x4 ds0[8]; float lam0[4] = {0.f, 0.f, 0.f, 0.f};
#pragma unroll
                for (int i = 0; i < 8; ++i) ds0[i] = (f32x4){0.f, 0.f, 0.f, 0.f};
                bf16_t* Qo = (bf16_t*)(ws + WS_Q); bf16_t* LFo = (bf16_t*)(ws + WS_LF); bf16_t* DSp = (bf16_t*)(ws + WS_DS); float* LAMp = (float*)(ws + WS_LAM);
                const int ub = (bq * 8 + 2 * hp_) * 32 + c0;
                chunk_load(r, ub, Qp, Kp, Lp, Vp, tid);
                chunk_A1(lds, 0, r, tid);
                chunk_load(r, ub + 1, Qp, Kp, Lp, Vp, tid);
                LDS_BARRIER();
                chunk_A2(lds, 0, ub, 0, lam0, Qo, LAMp, wave, lane);
                LDS_BARRIER();
#pragma unroll 1
                for (int k = 0; k < 8; ++k) {
                    const int u = ub + (k >> 2) * 32 + (k & 3), s = k & 1;
                    const bool has_next = k < 7;
                    const int k1 = k < 7 ? k + 1 : 7, un = ub + (k1 >> 2) * 32 + (k1 & 3), k2 = k + 2 < 8 ? k + 2 : 7, u2 = ub + (k2 >> 2) * 32 + (k2 & 3);
                    if (has_next) { chunk_A1(lds, s ^ 1, r, tid); chunk_load(r, u2, Qp, Kp, Lp, Vp, tid); }
                    __builtin_amdgcn_sched_barrier(0);
                    chunk_B(lds, s, wave, lane);
                    LDS_BARRIER();
                    if (has_next) chunk_A2(lds, s ^ 1, un, k1 & 3, lam0, Qo, LAMp, wave, lane);
                    __builtin_amdgcn_sched_barrier(0);
                    switch (k & 3) {
                        case 0: chunk_C<0>(lds, s, u, ds0, LFo, DSp, wave, lane); break;
                        case 1: chunk_C<1>(lds, s, u, ds0, LFo, DSp, wave, lane); break;
                        case 2: chunk_C<2>(lds, s, u, ds0, LFo, DSp, wave, lane); break;
                        default: chunk_C<3>(lds, s, u, ds0, LFo, DSp, wave, lane); break;
                    }
                    LDS_BARRIER();
                }
            }
        }
        SEAM(pb);
        if (IN(pb + 3)) {
            PHASE_LOCALS();
            for (int rep = 0; rep < NREP(10); ++rep) {
                bf16_t* qo = (bf16_t*)(ws + (DUMMY(10, rep) ? WS_DUM0 : WS_Q));
                const bf16_t* Qp = (const bf16_t*)(ws + WS_Q); const bf16_t* Op = (const bf16_t*)(ws + WS_LF); const bf16_t* Gp = (const bf16_t*)(ws + WS_G); const bf16_t* Sp = (const bf16_t*)(ws + WS_DS);
                const int vcu = (bx & 7) * (G >> 3) + (bx >> 3), qp = vcu & 7, bh0 = (vcu >> 5) * 8 + ((vcu >> 3) & 3), bh1 = bh0 + 4, qd0 = bh0 * 8 + qp, qd1 = bh1 * 8 + (7 - qp);
                InterIn cur; InterSc sc, sc1;
                quad_prefix(lds, sc, sc1, bh0, bh1, qp, Sp, (const float*)(ws + WS_LAM), ap->out + O_STP + (size_t)l * 64 * 16384, wave, lane, tid);
                inter_load(cur, 4 * qd0, Qp, Op, Gp, Sp, wave, lane, tid);
#pragma unroll 1
                for (int k = 0; k < 2; ++k) {
                    const int qd = k == 0 ? qd0 : qd1, qn = qd1;
#pragma unroll 1
                    for (int jj = 0; jj < 3; ++jj) {
                        InterIn nxt; SampleIn sin;
                        const int su = bx + G * (2 * k + (jj >> 1)), half = jj & 1;
                        inter_load(nxt, 4 * qd + jj + 1, Qp, Op, Gp, Sp, wave, lane, tid);
                        sample_load(sin, su, half, Qp, (const bf16_t*)(ws + WS_K), Op, (const bf16_t*)(ws + WS_V), Gp, ap->in[2] + ((size_t)l * 1024 + su) * 16384, tid);
                        inter_compute(lds, 4 * qd + jj, jj & 1, cur, sc, qo, wave, lane, tid);
                        sample_compute(lds + 112640, su, half, sin, (bf16_t*)(ws + WS_Q), ap->out + O_STS + ((size_t)l * 1024 + su) * 16384, tid);
                        cur = nxt;
                    }
                    InterIn nxt; SampleIn sin;
                    const int su = bx + G * (2 * k + 1);
                    inter_load(nxt, 4 * qn, Qp, Op, Gp, Sp, wave, lane, tid);
                    sample_load(sin, su, 1, Qp, (const bf16_t*)(ws + WS_K), Op, (const bf16_t*)(ws + WS_V), Gp, ap->in[2] + ((size_t)l * 1024 + su) * 16384, tid);
                    inter_compute(lds, 4 * qd + 3, 1, cur, sc, qo, wave, lane, tid);
                    sample_compute(lds + 112640, su, 1, sin, (bf16_t*)(ws + WS_Q), ap->out + O_STS + ((size_t)l * 1024 + su) * 16384, tid);
                    cur = nxt; sc = sc1;
                }
            }
        }
        SEAM(pb + 3);
        if (IN(pb + 4)) {
            PHASE_LOCALS();
            const bf16_t* Bt = (const bf16_t*)(ws + (l == 0 ? WS_WOUT0 : WS_WOUT1));
            pg8::Gemm g{(const bf16_t*)(ws + WS_Q), Bt, TP, 1024, 1024}; pg8::StaticOrder S; S.init(TP, 1024, G, bx);
            EpiResid E{ws};
            S_OUT((l == 0 ? WS_WOUT0 : WS_WOUT1), bx, G);
            pg8::gemm_phase<EpiResid, pg8::StaticOrder, PG8_ALIGN, PG8_SP2>(lds + RING_OFF, g, S, E, tid);
        }
        SEAM(pb + 4);
    }
#pragma unroll 1
    for (int j = 0; j < 2; ++j) {
        const int pb = 11 + 3 * j;
        if (IN(pb)) {
            PHASE_LOCALS();
            const int N = j == 0 ? 2304 : 2048;
            const bf16_t* Bt = (const bf16_t*)(ws + (j == 0 ? WS_WINB0 : WS_WINB1));
            const int vcu = (bx & 7) * (G >> 3) + (bx >> 3);
            pg8::Gemm g{(const bf16_t*)(ws + WS_HB), Bt, TP, N, 1024}; pg8::PmOrder S; S.pm = vcu >> 2; S.q = vcu & 3; S.nN = N >> 8;
            EpiSwaIn E{ws, ap->out, (const LAS float*)(lds + RSTD_OFF), (const LAS float*)(lds + ROPEL_OFF)};
            stage_row_tables(ws, S.pm, lds, true, tid);
            if (j == 0) {
                const int rank = S.q < 2 ? -1 : (S.pm * 2 + S.q - 2), nr = G >> 1;
                if (rank >= 0) for (int u = rank; u < N / 16; u += nr) sgemm_unit<64, 32>(lds, g.A + (size_t)TP * DM, Bt, u, E, wave, lane, tid);
                pg8::gemm_phase<EpiSwaIn, pg8::PmOrder, PG8_ALIGN, PG8_SP2, true>(lds + RING_OFF, g, S, E, tid);
            } else {
                for (int u = bx; u < N / 8; u += G) sgemm_unit<32, 32>(lds, g.A + (size_t)TP * DM, Bt, u, E, wave, lane, tid);
                pg8::gemm_phase<EpiSwaIn, pg8::PmOrder, PG8_ALIGN, PG8_SP2, false>(lds + RING_OFF, g, S, E, tid);
            }
        }
        SEAM(pb);
        if (IN(pb + 1)) {
            PHASE_LOCALS();
            const float* sinks = ap->in[14] + j * 16;
            for (int rep = 0; rep < NREP(6); ++rep) {
            bf16_t* qo = (bf16_t*)(ws + (DUMMY(6, rep) ? WS_DUM0 : WS_Q));
            for (int u = (bx & 7) * (G >> 3) + (bx >> 3); u < 256; u += G) swa_prompt_unit(lds, u, (const bf16_t*)(ws + WS_Q), qo,
            (const bf16_t*)(ws + WS_G), (const bf16_t*)(ws + WS_KA), (const bf16_t*)(ws + WS_VA), sinks, wave, lane, tid);
            }
            S_ATTN(j);
        }
        SEAM(pb + 1);
        if (IN(pb + 2)) {
            PHASE_LOCALS();
            const bf16_t* Bt = (const bf16_t*)(ws + (j == 0 ? WS_WOUTB0 : WS_WOUTB1));
            pg8::Gemm g{(const bf16_t*)(ws + WS_Q), Bt, TP, 1024, 1024}; pg8::StaticOrder S; S.init(TP, 1024, G, bx);
            EpiResid E{ws};
            S_OUT((j == 0 ? WS_WOUTB0 : WS_WOUTB1), bx, G);
            pg8::gemm_phase<EpiResid, pg8::StaticOrder, PG8_ALIGN, PG8_SP2>(lds + RING_OFF, g, S, E, tid);
        }
        SEAM(pb + 2);
    }
    if (IN(17)) {
        PHASE_LOCALS();
        const int gw = bx * NWAVES + wave, NGW = G * NWAVES;
        const f32x4* fn = (const f32x4*)ap->in[16] + lane;
        const float* SSQ = (const float*)(ws + WS_SSQ); const bf16_t* HBf = (const bf16_t*)(ws + WS_HB); float* outp = ap->out;
        f32x4 gn[4];
#pragma unroll
        for (int j = 0; j < 4; ++j) gn[j] = fn[64 * j];
        const int vcu = (bx & 7) * (G >> 3) + (bx >> 3), vw = vcu * NWAVES + wave;
#pragma unroll 1
        for (int ib = 0; ib < 8; ib += 8) {
            f32x4 sq[8]; u32x2 hw[8][4];
#pragma unroll
            for (int r = 0; r < 8; ++r) {
                const int m = (vw >> 8) * SEQ + (vw & 255) + 256 * (ib + r);
                sq[r] = ((const f32x4*)(SSQ + (size_t)m * 16))[lane & 3];
                const u32x2* hr = (const u32x2*)(HBf + (size_t)m * DM) + lane;
#pragma unroll
                for (int j = 0; j < 4; ++j) hw[r][j] = hr[64 * j];
            }
#pragma unroll
            for (int r = 0; r < 8; ++r) {
                const int m = (vw >> 8) * SEQ + (vw & 255) + 256 * (ib + r);
                float s = (sq[r].x + sq[r].y) + (sq[r].z + sq[r].w);
                s += __shfl_xor(s, 1); s += __shfl_xor(s, 2);
                const float rs = rsqrtf(s * (1.0f / DM) + NORM_EPS);
                f32x4* o = (f32x4*)(outp + (size_t)m * DM) + lane;
#pragma unroll
                for (int j = 0; j < 4; ++j) __builtin_nontemporal_store((f32x4){bflo(hw[r][j].x), bfhi(hw[r][j].x), bflo(hw[r][j].y), bfhi(hw[r][j].y)} * rs * gn[j], &o[64 * j]);
            }
        }
        if (vw < TS) {
            const int m = TP + vw;
            const float rs = row_rstd_s((const float*)(ws + WS_SSQS), m - TP);
            const u32x2* hr = (const u32x2*)(HBf + (size_t)m * DM) + lane; f32x4* o = (f32x4*)(outp + (size_t)m * DM) + lane;
#pragma unroll
            for (int j = 0; j < 4; ++j) { const u32x2 h2 = hr[64 * j]; __builtin_nontemporal_store((f32x4){bflo(h2.x), bfhi(h2.x), bflo(h2.y), bfhi(h2.y)} * rs * gn[j], &o[64 * j]); }
        }
    }
    if (threadIdx.x == 0) {
        unsigned* gb = bar.bar;
        const unsigned old = xb_add(&gb[XB_EXIT], 1u);
        if (old + 1u == (unsigned)G) {
#pragma unroll 1
            for (int j = 0; j < 16; ++j) {
                __hip_atomic_store(&gb[XB_XCNT(j)], 0u, __ATOMIC_RELAXED, __HIP_MEMORY_SCOPE_AGENT);
                __hip_atomic_store(&gb[XB_XSUB(j)], 0u, __ATOMIC_RELAXED, __HIP_MEMORY_SCOPE_AGENT);
                __hip_atomic_store(&gb[XB_XGEN(j)], 0u, __ATOMIC_RELAXED, __HIP_MEMORY_SCOPE_AGENT);
            }
            __hip_atomic_store(&gb[XB_TOP], 0u, __ATOMIC_RELAXED, __HIP_MEMORY_SCOPE_AGENT);
            __hip_atomic_store(&gb[XB_TOPGEN], 0u, __ATOMIC_RELAXED, __HIP_MEMORY_SCOPE_AGENT);
            __hip_atomic_store(&gb[XB_TMO], 0u, __ATOMIC_RELAXED, __HIP_MEMORY_SCOPE_AGENT);
            __hip_atomic_store(&gb[XB_EXIT], 0u, __ATOMIC_RELAXED, __HIP_MEMORY_SCOPE_AGENT);
        }
    }
#undef S_IN_A
#undef S_OUT
#undef S_STEP
#undef S_ATTN
#undef IN
#undef SEAM
#undef PHASE_LOCALS
}

#ifndef MK_PER_PHASE
#define MK_PER_PHASE 0
#endif
extern "C" void kernel_launch(void* const* d_in, const int* in_sizes, int n_in, void* d_out, int out_size, void* d_ws, size_t ws_size, hipStream_t stream) {
    static int grid = 0;
    if (grid == 0) {
        if (n_in != 17 || ws_size < WS_END) { fprintf(stderr, "kernel_launch: unexpected inputs (n_in %d, ws %zu)\n", n_in, ws_size); grid = -1; return; }
        int dev = 0, cus = 0;
        if (hipGetDevice(&dev) != hipSuccess || hipDeviceGetAttribute(&cus, hipDeviceAttributeMultiprocessorCount, dev) != hipSuccess) { grid = -1; return; }
        if (hipFuncSetAttribute((const void*)yoco_fwd, hipFuncAttributeMaxDynamicSharedMemorySize, LDS_BYTES) != hipSuccess) { grid = -1; return; }
        (void)hipGetLastError();
        grid = cus;
    }
    if (grid < 0) return;
    Args a{};
    for (int i = 0; i < 17; ++i) a.in[i] = (const float*)d_in[i];
    a.out = (float*)d_out; a.ws = (unsigned char*)d_ws;
#if MK_PER_PHASE
    for (int p = 0; p < 18; ++p) { a.ph_lo = p; a.ph_hi = p + 1; hipLaunchKernelGGL(yoco_fwd, dim3(grid), dim3(NWAVES * 64), LDS_BYTES, stream, a); }
#else
    a.ph_lo = 0; a.ph_hi = 18;
    hipLaunchKernelGGL(yoco_fwd, dim3(grid), dim3(NWAVES * 64), LDS_BYTES, stream, a);
#endif
}
```
